# Optimizing an MI355X kernel written in HIP

```python
import math
import jax
import jax.numpy as jnp
from jax import lax
import numpy as np

D_MODEL = 1024
BATCH = 1
SEQ = 16384
DEPTH = 2
DEC_BATCH = 8
DEC_SEQ = 16
PAST_LEN = 4096

CHUNK = 64
ATT_HEADS = 8
ATT_HEAD_DIM = 64
ATT_V_DIM = 2 * ATT_HEAD_DIM
ATT_WIDTH = ATT_HEADS * ATT_V_DIM
Q_DIM = ATT_HEADS * 2 * ATT_HEAD_DIM
ATT_Q_BLOCK = 128
ATT_SUBLN_EPS = 1e-5
SSM_EXPAND = 2
D_INNER = SSM_EXPAND * D_MODEL
SSM_HEAD_DIM = 64
SSM_HEADS = D_INNER // SSM_HEAD_DIM
SSM_GROUPS = 8
SSM_HEADS_PER_GROUP = SSM_HEADS // SSM_GROUPS
SSM_STATE = 128
CONV_WIDTH = 4
CONV_DIM = D_INNER + 2 * SSM_GROUPS * SSM_STATE
SSM_NORM_EPS = 1e-5
D_FF = -(-8 * D_MODEL // (3 * 256)) * 256
RMS_EPS = 1e-6
IN_SIZES = (Q_DIM, Q_DIM, ATT_WIDTH, D_INNER, CONV_DIM, SSM_HEADS, 2 * D_MODEL)
IN_DIM = sum(IN_SIZES)
SPLIT_POINTS = tuple(sum(IN_SIZES[:i + 1]) for i in range(len(IN_SIZES) - 1))

kernel_name = "hybrid_diffattn_mamba2_streaming_step"


def rmsnorm(x, w, eps=RMS_EPS):
    xf = x.astype(jnp.float32)
    y = xf * lax.rsqrt(jnp.mean(xf * xf, axis=-1, keepdims=True) + eps)
    return (y * w.astype(jnp.float32)).astype(x.dtype)


def diff_attention(q, k, v, lam, q_pos0):
    b, lq = q.shape[0], q.shape[1]
    lk = k.shape[1]
    blk = min(ATT_Q_BLOCK, lq)
    nblk = lq // blk
    scale = ATT_HEAD_DIM ** -0.5
    k_chunk = jnp.arange(lk) // CHUNK
    qb = q.reshape(b, nblk, blk, ATT_HEADS, 2, ATT_HEAD_DIM).swapaxes(0, 1)

    def one_block(args):
        q_blk, i = args
        s = jnp.einsum("bqhmd,bkhmd->bhmqk", q_blk, k, preferred_element_type=jnp.float32) * scale
        q_chunk = (q_pos0 + i * blk + jnp.arange(blk)) // CHUNK
        mask = k_chunk[None, :] <= q_chunk[:, None]
        s = jnp.where(mask, s, -jnp.inf)
        p = jax.nn.softmax(s, axis=-1)
        a = p[:, :, 0] - lam * p[:, :, 1]
        return jnp.einsum("bhqk,bkhe->bqhe", a.astype(v.dtype), v)

    out = lax.map(one_block, (qb, jnp.arange(nblk)))
    return out.swapaxes(0, 1).reshape(b, lq, ATT_HEADS, ATT_V_DIM)


def ssd_scan(x, a, bm, cm, init_state):
    b, L = x.shape[0], x.shape[1]
    cl = min(CHUNK, L)
    nc = L // cl
    f32 = jnp.float32
    x = x.astype(f32).reshape(b, nc, cl, SSM_GROUPS, SSM_HEADS_PER_GROUP, SSM_HEAD_DIM)
    a = a.astype(f32).reshape(b, nc, cl, SSM_GROUPS, SSM_HEADS_PER_GROUP)
    bm = bm.astype(f32).reshape(b, nc, cl, SSM_GROUPS, SSM_STATE)
    cm = cm.astype(f32).reshape(b, nc, cl, SSM_GROUPS, SSM_STATE)
    a_cs = jnp.cumsum(a, axis=2)
    seg = a_cs[:, :, :, None] - a_cs[:, :, None, :]
    causal = jnp.tril(jnp.ones((cl, cl), dtype=bool))[None, None, :, :, None, None]
    decay = jnp.exp(jnp.where(causal, seg, -jnp.inf))
    cb = jnp.einsum("bclgn,bcsgn->bclsg", cm, bm)
    y_diag = jnp.einsum("bclsg,bclsgr,bcsgrp->bclgrp", cb, decay, x)
    decay_to_end = jnp.exp(a_cs[:, :, -1:] - a_cs)
    chunk_states = jnp.einsum("bclgn,bclgr,bclgrp->bcgrpn", bm, decay_to_end, x)
    chunk_decay = jnp.exp(a_cs[:, :, -1])

    def step(state, inp):
        cs, dec = inp
        return dec[..., None, None] * state + cs, state

    final, prev = lax.scan(step, init_state.astype(f32),
                           (chunk_states.swapaxes(0, 1), chunk_decay.swapaxes(0, 1)))
    prev = prev.swapaxes(0, 1)
    y_off = jnp.einsum("bclgn,bcgrpn,bclgr->bclgrp", cm, prev, jnp.exp(a_cs))
    y = (y_diag + y_off).reshape(b, L, SSM_GROUPS, SSM_HEADS_PER_GROUP, SSM_HEAD_DIM)
    return y, final


def ssd_branch(z, xbc, dt_raw, conv_buf, ssm_state, p):
    b, L = xbc.shape[0], xbc.shape[1]
    xpad = jnp.concatenate([conv_buf.astype(xbc.dtype), xbc], axis=1)
    new_conv = xpad[:, -(CONV_WIDTH - 1):]
    conv = p["conv_b"] + sum(p["conv_w"][j] * xpad[:, j:j + L] for j in range(CONV_WIDTH))
    xbc_act = jax.nn.silu(conv)
    xs, bm, cm = jnp.split(xbc_act, (D_INNER, D_INNER + SSM_GROUPS * SSM_STATE), axis=-1)
    xs = xs.reshape(b, L, SSM_GROUPS, SSM_HEADS_PER_GROUP, SSM_HEAD_DIM).astype(jnp.float32)
    bm = bm.reshape(b, L, SSM_GROUPS, SSM_STATE)
    cm = cm.reshape(b, L, SSM_GROUPS, SSM_STATE)
    dt = jax.nn.softplus(dt_raw.astype(jnp.float32) + p["dt_bias"].astype(jnp.float32))
    dt = dt.reshape(b, L, SSM_GROUPS, SSM_HEADS_PER_GROUP)
    a_neg = -jnp.exp(p["a_log"].astype(jnp.float32)).reshape(SSM_GROUPS, SSM_HEADS_PER_GROUP)
    y, final = ssd_scan(xs * dt[..., None], dt * a_neg, bm, cm, ssm_state)
    y = y + p["d_skip"].astype(jnp.float32).reshape(SSM_GROUPS, SSM_HEADS_PER_GROUP)[:, :, None] * xs
    y = y.reshape(b, L, D_INNER) * jax.nn.silu(z.astype(jnp.float32))
    yg = y.reshape(b, L, SSM_GROUPS, D_INNER // SSM_GROUPS)
    yg = yg * lax.rsqrt(jnp.mean(yg * yg, axis=-1, keepdims=True) + SSM_NORM_EPS)
    y = yg.reshape(b, L, D_INNER) * p["ssm_norm"].astype(jnp.float32)
    return y.astype(xbc.dtype), new_conv, final


def trunk_layer(x, pos0, past_k, past_v, conv_buf, ssm_state, lam_init, p):
    b, L, _ = x.shape
    h = rmsnorm(x, p["norm_mix"])
    proj = h @ p["w_in"]
    q, k, v, z, xbc, dt_raw, gate_logits = jnp.split(proj, SPLIT_POINTS, axis=-1)
    q = q.reshape(b, L, ATT_HEADS, 2, ATT_HEAD_DIM)
    k = k.reshape(b, L, ATT_HEADS, 2, ATT_HEAD_DIM)
    v = v.reshape(b, L, ATT_HEADS, ATT_V_DIM)
    if past_k is None:
        k_all, v_all = k, v
    else:
        k_all = jnp.concatenate([past_k.astype(k.dtype), k], axis=1)
        v_all = jnp.concatenate([past_v.astype(v.dtype), v], axis=1)
    lam = (jnp.exp(jnp.sum(p["lambda_q1"] * p["lambda_k1"]).astype(jnp.float32))
           - jnp.exp(jnp.sum(p["lambda_q2"] * p["lambda_k2"]).astype(jnp.float32)) + lam_init)
    att = diff_attention(q, k_all, v_all, lam, pos0)
    att = rmsnorm(att, p["attn_subln"], eps=ATT_SUBLN_EPS) * (1.0 - lam_init)
    att = att.reshape(b, L, ATT_WIDTH)
    y_ssd, new_conv, new_ssm = ssd_branch(z, xbc, dt_raw, conv_buf, ssm_state, p)
    g_att, g_ssd = jnp.split(jax.nn.sigmoid(gate_logits), 2, axis=-1)
    merged = g_att * (att @ p["w_branch_att"]) + g_ssd * (y_ssd @ p["w_branch_ssd"])
    x = x + merged @ p["w_out"]
    h2 = rmsnorm(x, p["norm_ffn"])
    gt, up = jnp.split(h2 @ p["w_gate_up"], 2, axis=-1)
    x = x + (jax.nn.silu(gt) * up) @ p["w_down"]
    return x, k, v, new_conv, new_ssm


def setup_inputs(seed: int = 0) -> dict:
    key = jax.random.key(seed)
    ks = jax.random.split(key, 32)
    f32 = jnp.float32
    nrm = lambda k, shape, s: jax.random.normal(k, shape, f32) * s
    dt0 = jnp.exp(jax.random.uniform(ks[14], (DEPTH, SSM_HEADS), f32,
                                     minval=math.log(1e-3), maxval=math.log(1e-1)))
    return {
        "x_prompt": nrm(ks[0], (BATCH, SEQ, D_MODEL), 1.0),
        "x_sample": nrm(ks[1], (DEC_BATCH, DEC_SEQ, D_MODEL), 1.0),
        "cache_k": nrm(ks[2], (DEPTH, DEC_BATCH, PAST_LEN, ATT_HEADS, 2, ATT_HEAD_DIM), 1.0),
        "cache_v": nrm(ks[3], (DEPTH, DEC_BATCH, PAST_LEN, ATT_HEADS, ATT_V_DIM), 1.0),
        "state_conv": nrm(ks[4], (DEPTH, DEC_BATCH, CONV_WIDTH - 1, CONV_DIM), 1.0),
        "state_ssm": nrm(ks[5], (DEPTH, DEC_BATCH, SSM_GROUPS, SSM_HEADS_PER_GROUP,
                                 SSM_HEAD_DIM, SSM_STATE), 0.1),
        "norm_mix": 1.0 + nrm(ks[6], (DEPTH, D_MODEL), 0.01),
        "w_in": nrm(ks[7], (DEPTH, D_MODEL, IN_DIM), D_MODEL ** -0.5),
        "lambda_q1": nrm(ks[8], (DEPTH, ATT_HEAD_DIM), 0.1),
        "lambda_k1": nrm(ks[9], (DEPTH, ATT_HEAD_DIM), 0.1),
        "lambda_q2": nrm(ks[10], (DEPTH, ATT_HEAD_DIM), 0.1),
        "lambda_k2": nrm(ks[11], (DEPTH, ATT_HEAD_DIM), 0.1),
        "attn_subln": 1.0 + nrm(ks[12], (DEPTH, ATT_V_DIM), 0.01),
        "conv_w": nrm(ks[13], (DEPTH, CONV_WIDTH, CONV_DIM), CONV_WIDTH ** -0.5),
        "conv_b": nrm(ks[15], (DEPTH, CONV_DIM), 0.01),
        "dt_bias": dt0 + jnp.log(-jnp.expm1(-dt0)),
        "a_log": jnp.log(jax.random.uniform(ks[16], (DEPTH, SSM_HEADS), f32, minval=1.0, maxval=16.0)),
        "d_skip": 1.0 + nrm(ks[17], (DEPTH, SSM_HEADS), 0.01),
        "ssm_norm": 1.0 + nrm(ks[18], (DEPTH, D_INNER), 0.01),
        "w_branch_att": nrm(ks[19], (DEPTH, ATT_WIDTH, D_MODEL), ATT_WIDTH ** -0.5),
        "w_branch_ssd": nrm(ks[20], (DEPTH, D_INNER, D_MODEL), D_INNER ** -0.5),
        "w_out": nrm(ks[21], (DEPTH, D_MODEL, D_MODEL), D_MODEL ** -0.5),
        "norm_ffn": 1.0 + nrm(ks[22], (DEPTH, D_MODEL), 0.01),
        "w_gate_up": nrm(ks[23], (DEPTH, D_MODEL, 2 * D_FF), D_MODEL ** -0.5),
        "w_down": nrm(ks[24], (DEPTH, D_FF, D_MODEL), D_FF ** -0.5),
        "norm_final": 1.0 + nrm(ks[25], (D_MODEL,), 0.01),
    }


def reference(x_prompt, x_sample, cache_k, cache_v, state_conv, state_ssm,
              norm_mix, w_in, lambda_q1, lambda_k1, lambda_q2, lambda_k2, attn_subln,
              conv_w, conv_b, dt_bias, a_log, d_skip, ssm_norm,
              w_branch_att, w_branch_ssd, w_out, norm_ffn, w_gate_up, w_down, norm_final):
    xp, xs = x_prompt, x_sample
    kp, vp, cp, sp = [], [], [], []
    kd, vd, cd, sd = [], [], [], []
    conv0 = jnp.zeros((xp.shape[0], CONV_WIDTH - 1, CONV_DIM), xp.dtype)
    ssm0 = jnp.zeros((xp.shape[0], SSM_GROUPS, SSM_HEADS_PER_GROUP, SSM_HEAD_DIM, SSM_STATE), jnp.float32)
    for l in range(DEPTH):
        p = {
            "norm_mix": norm_mix[l], "w_in": w_in[l],
            "lambda_q1": lambda_q1[l], "lambda_k1": lambda_k1[l],
            "lambda_q2": lambda_q2[l], "lambda_k2": lambda_k2[l],
            "attn_subln": attn_subln[l], "conv_w": conv_w[l], "conv_b": conv_b[l],
            "dt_bias": dt_bias[l], "a_log": a_log[l], "d_skip": d_skip[l], "ssm_norm": ssm_norm[l],
            "w_branch_att": w_branch_att[l], "w_branch_ssd": w_branch_ssd[l], "w_out": w_out[l],
            "norm_ffn": norm_ffn[l], "w_gate_up": w_gate_up[l], "w_down": w_down[l],
        }
        lam_init = 0.8 - 0.6 * math.exp(-0.3 * l)
        xp, k_new, v_new, c_new, s_new = trunk_layer(xp, 0, None, None, conv0, ssm0, lam_init, p)
        kp.append(k_new); vp.append(v_new); cp.append(c_new); sp.append(s_new)
        xs, k_new, v_new, c_new, s_new = trunk_layer(xs, PAST_LEN, cache_k[l], cache_v[l],
                                                     state_conv[l], state_ssm[l], lam_init, p)
        kd.append(k_new); vd.append(v_new); cd.append(c_new); sd.append(s_new)
    y_prompt = rmsnorm(xp, norm_final)
    y_sample = rmsnorm(xs, norm_final)
    return (y_prompt, y_sample,
            jnp.stack(kp), jnp.stack(vp), jnp.stack(cp), jnp.stack(sp),
            jnp.stack(kd), jnp.stack(vd), jnp.stack(cd), jnp.stack(sd))
```

```cpp
#include <hip/hip_runtime.h>
#include <hip/hip_cooperative_groups.h>
#include <cstdio>
#include <cstdint>
#include <cmath>
namespace cg = cooperative_groups;
#ifndef MK_MULTI
#define MK_MULTI 0
#endif
#ifndef MK_SKIP
#define MK_SKIP 0
#endif
#ifndef MK_PROBE
#define MK_PROBE 0
#endif
#ifndef MK_SGB
#define MK_SGB 1
#endif
namespace pg8 {
#define PG8_LAS __attribute__((address_space(3)))
typedef unsigned short bf16_t;
typedef short bf16x8 __attribute__((ext_vector_type(8)));
typedef float f32x4 __attribute__((ext_vector_type(4)));
typedef unsigned u32x4 __attribute__((ext_vector_type(4)));
constexpr int BM = 256, BK = 64, HALF = 128, HTB = HALF * BK * 2  , STAGE_BYTES = 8 * HTB, NXCD = 8, WGM = 8;

__host__ __device__ __forceinline__ int lds_byte(int r, int c) { const int st = (r >> 4) * 2 + (c >> 5), rr = r & 15, cc = c & 31, ob = rr * 64 + cc * 2; return st * 1024 + (ob ^ (((ob >> 9) & 1) << 5)); }
__host__ __device__ __forceinline__ void stage_rc(int b, int& R, int& C) { const int st = b / 1024, sb = b % 1024, swz = sb ^ (((sb >> 9) & 1) << 5); R = (st >> 1) * 16 + swz / 64; C = (st & 1) * 32 + (swz % 64) / 2; }
__host__ __device__ __forceinline__ int perm32(int rho) { const int n = rho >> 4, i = rho & 15; return 8 * (i >> 2) + 4 * n + (i & 3); }

struct Unit { int pm, pn; };
struct Gemm { const bf16_t* A; const bf16_t* Bt; int M, N, K; };

struct StaticOrder {
    int nM, nN, nwg, G, c;
    __host__ __device__ void init(int M, int N, int G_, int c_) { nM = M / BM; nN = N / BM; nwg = nM * nN; G = G_; c = c_; }
    __host__ __device__ bool next(int i, Unit& u) const {
        const long L = (long)i * G + c; if (L >= nwg) return false;
        int wgid = (int)L; { const int q = nwg / NXCD, r = nwg % NXCD, xcd = wgid % NXCD, off = wgid / NXCD; wgid = (xcd < r ? xcd * (q + 1) : r * (q + 1) + (xcd - r) * q) + off; }
        const int nig = WGM * nN, gid = wgid / nig, fm = gid * WGM, gsz = (nM - fm) < WGM ? (nM - fm) : WGM;
        u.pm = fm + ((wgid % nig) % gsz); u.pn = (wgid % nig) / gsz; return true;
    }
    __device__ __forceinline__ void a_ready(const Unit&) const {}
    __device__ __forceinline__ void done(const Unit&) const {}
};

template <class Epi, class Sched, bool ALIGN_EPI = false, bool SP2 = false>
__device__ __forceinline__ void gemm_phase(PG8_LAS unsigned char* lds, const Gemm g, const Sched& S, const Epi& E) {
    int tid_ = threadIdx.x; asm volatile("" : "+v"(tid_)); const int tid = tid_, wid = __builtin_amdgcn_readfirstlane(tid >> 6), lane = tid & 63, wr = wid >> 2, wc = wid & 3, fr = lane & 15, fq = lane >> 4;
    const int K = g.K, nt = K / BK;
    unsigned voffA[2], voffB[2];
#pragma unroll
    for (int i = 0; i < 2; ++i) { int R, C; stage_rc(tid * 16 + i * 8192, R, C); const int Rb = Epi::PERM ? ((R & ~31) + perm32(R & 31)) : R;
        voffA[i] = (unsigned)(R * K + C) * 2u; voffB[i] = (unsigned)(Rb * K + C) * 2u; }
    const size_t kstep = (size_t)(BK * 2);
    const size_t hstep = (size_t)HALF * K * 2;
    const size_t tstep = 2 * hstep;
    const unsigned ldsw = (unsigned)wid * 1024u;
    const int aoff = lds_byte(wr * 64 + fr, fq * 8), boff = lds_byte(wc * 32 + fr, fq * 8);
#define PG8_SA(b, h) (((b) * 2 + (h)) * HTB)
#define PG8_SB(b, h) ((4 + (b) * 2 + (h)) * HTB)
#define PG8_STAGE(bufoff, gbase, voff) do { _Pragma("unroll") for (int _i = 0; _i < 2; ++_i) \
        __builtin_amdgcn_global_load_lds((const unsigned*)((const char*)(gbase) + (voff)[_i]), (PG8_LAS unsigned*)(lds + (bufoff) + ldsw + _i * 8192), 16, 0, 0); } while (0)
#define PG8_LDA(dst, b, h) do { _Pragma("unroll") for (int m = 0; m < 4; ++m) _Pragma("unroll") for (int k = 0; k < 2; ++k) dst[m][k] = *(const PG8_LAS bf16x8*)(lds + PG8_SA(b, h) + aoff + m * 2048 + k * 1024); } while (0)
#define PG8_LDB(dst, b, h) do { _Pragma("unroll") for (int n = 0; n < 2; ++n) _Pragma("unroll") for (int k = 0; k < 2; ++k) dst[n][k] = *(const PG8_LAS bf16x8*)(lds + PG8_SB(b, h) + boff + n * 2048 + k * 1024); } while (0)
#define PG8_MMA(ai, bj, At, Bt) do { __builtin_amdgcn_s_setprio(1); _Pragma("unroll") for (int m = 0; m < 4; ++m) _Pragma("unroll") for (int n = 0; n < 2; ++n) _Pragma("unroll") for (int k = 0; k < 2; ++k) \
        acc[ai][bj][m][n] = __builtin_amdgcn_mfma_f32_16x16x32_bf16(Bt[n][k], At[m][k], acc[ai][bj][m][n], 0, 0, 0); __builtin_amdgcn_s_setprio(0); } while (0)
#define PG8_WAIT_V(n) asm volatile("s_waitcnt vmcnt(" #n ")" ::: "memory")
#define PG8_WAIT_L(n) asm volatile("s_waitcnt lgkmcnt(" #n ")" ::: "memory")
#define PG8_BAR __builtin_amdgcn_s_barrier()
#define PG8_SCHED __builtin_amdgcn_sched_barrier(0)
    Unit cur, nxt; int ui = 0;
    if (!S.next(0, cur)) return;
    f32x4 acc[2][2][4][2];
#pragma unroll
    for (int a = 0; a < 2; ++a)
#pragma unroll
        for (int b = 0; b < 2; ++b)
#pragma unroll
            for (int m = 0; m < 4; ++m)
#pragma unroll
                for (int n = 0; n < 2; ++n) acc[a][b][m][n] = (f32x4){0.f, 0.f, 0.f, 0.f};
    bf16x8 At[4][2], B0[2][2], B1[2][2];
    const char* cA = (const char*)g.A + (size_t)cur.pm * tstep; const char* cB = (const char*)g.Bt + (size_t)cur.pn * tstep;
    S.a_ready(cur);
    if constexpr (SP2) {
        PG8_STAGE(PG8_SB(0, 0), cB, voffB); PG8_STAGE(PG8_SB(0, 1), cB + hstep, voffB); PG8_STAGE(PG8_SA(0, 0), cA, voffA); PG8_STAGE(PG8_SA(0, 1), cA + hstep, voffA);
        if (wr == 1) PG8_BAR;
        PG8_WAIT_V(2); PG8_BAR;
        PG8_STAGE(PG8_SB(1, 0), cB + kstep, voffB); PG8_STAGE(PG8_SA(1, 0), cA + kstep, voffA); PG8_STAGE(PG8_SB(1, 1), cB + hstep + kstep, voffB);
        PG8_WAIT_V(6); PG8_BAR;
    } else {
        PG8_STAGE(PG8_SB(0, 0), cB, voffB); PG8_STAGE(PG8_SA(0, 0), cA, voffA); PG8_STAGE(PG8_SB(0, 1), cB + hstep, voffB); PG8_STAGE(PG8_SA(0, 1), cA + hstep, voffA);
        if (wr == 1) PG8_BAR;
        PG8_WAIT_V(4); PG8_BAR;
        PG8_STAGE(PG8_SB(1, 0), cB + kstep, voffB); PG8_STAGE(PG8_SA(1, 0), cA + kstep, voffA); PG8_STAGE(PG8_SB(1, 1), cB + hstep + kstep, voffB);
        PG8_WAIT_V(6); PG8_BAR;
    }
    for (;;) {
        const bool has_next = S.next(ui + 1, nxt);
        const char* nA = has_next ? (const char*)g.A + (size_t)nxt.pm * tstep : cA; const char* nB = has_next ? (const char*)g.Bt + (size_t)nxt.pn * tstep : cB;
        for (int t = 0; t < nt; t += 2) {
            const bool last = (t == nt - 2);
            const char* a1 = cA + (size_t)(t + 1) * kstep;
            const char* a2 = last ? nA : cA + (size_t)(t + 2) * kstep; const char* b2 = last ? nB : cB + (size_t)(t + 2) * kstep;
            const char* a3 = a2 + kstep; const char* b3 = b2 + kstep;
            if (last && has_next) S.a_ready(nxt);
            if constexpr (SP2) {
            PG8_LDB(B0, 0, 0); PG8_LDB(B1, 0, 1); PG8_SCHED; PG8_LDA(At, 0, 0); PG8_STAGE(PG8_SA(1, 1), a1 + hstep, voffA);
            PG8_WAIT_V(8); PG8_WAIT_L(0); PG8_BAR; PG8_MMA(0, 0, At, B0); PG8_MMA(0, 1, At, B1); PG8_BAR; PG8_SCHED;
            PG8_LDA(At, 0, 1); PG8_STAGE(PG8_SB(0, 0), b2, voffB); PG8_STAGE(PG8_SB(0, 1), b2 + hstep, voffB); PG8_STAGE(PG8_SA(0, 0), a2, voffA);
            PG8_WAIT_V(8); PG8_WAIT_L(0); PG8_BAR; PG8_MMA(1, 0, At, B0); PG8_MMA(1, 1, At, B1); PG8_BAR; PG8_SCHED;
            PG8_LDB(B0, 1, 0); PG8_LDB(B1, 1, 1); PG8_SCHED; PG8_LDA(At, 1, 0); PG8_STAGE(PG8_SA(0, 1), a2 + hstep, voffA);
            PG8_WAIT_V(8); PG8_WAIT_L(0); PG8_BAR; PG8_MMA(0, 0, At, B0); PG8_MMA(0, 1, At, B1); PG8_BAR; PG8_SCHED;
            PG8_LDA(At, 1, 1); PG8_STAGE(PG8_SB(1, 0), b3, voffB); PG8_STAGE(PG8_SB(1, 1), b3 + hstep, voffB); PG8_STAGE(PG8_SA(1, 0), a3, voffA);
            PG8_WAIT_V(8); PG8_WAIT_L(0); PG8_BAR; PG8_MMA(1, 0, At, B0); PG8_MMA(1, 1, At, B1); PG8_BAR; PG8_SCHED;
            } else {
            PG8_LDB(B0, 0, 0); PG8_SCHED; PG8_LDA(At, 0, 0); PG8_STAGE(PG8_SA(1, 1), a1 + hstep, voffA);
            PG8_WAIT_L(8); PG8_BAR; PG8_WAIT_L(0); PG8_MMA(0, 0, At, B0); PG8_BAR; PG8_SCHED;
            PG8_LDB(B1, 0, 1); PG8_STAGE(PG8_SB(0, 0), b2, voffB);
            PG8_BAR; PG8_WAIT_L(0); PG8_MMA(0, 1, At, B1); PG8_BAR;
            PG8_LDA(At, 0, 1); PG8_STAGE(PG8_SA(0, 0), a2, voffA);
            PG8_BAR; PG8_WAIT_L(0); PG8_MMA(1, 0, At, B0); PG8_BAR; PG8_SCHED;
            PG8_STAGE(PG8_SB(0, 1), b2 + hstep, voffB);
            PG8_WAIT_V(6); PG8_BAR; PG8_MMA(1, 1, At, B1); PG8_BAR;
            PG8_LDB(B0, 1, 0); PG8_SCHED; PG8_LDA(At, 1, 0); PG8_STAGE(PG8_SA(0, 1), a2 + hstep, voffA);
            PG8_WAIT_L(8); PG8_BAR; PG8_WAIT_L(0); PG8_MMA(0, 0, At, B0); PG8_BAR; PG8_SCHED;
            PG8_LDB(B1, 1, 1); PG8_STAGE(PG8_SB(1, 0), b3, voffB);
            PG8_BAR; PG8_WAIT_L(0); PG8_MMA(0, 1, At, B1); PG8_BAR;
            PG8_LDA(At, 1, 1); PG8_STAGE(PG8_SA(1, 0), a3, voffA);
            PG8_BAR; PG8_WAIT_L(0); PG8_MMA(1, 0, At, B0); PG8_BAR; PG8_SCHED;
            PG8_STAGE(PG8_SB(1, 1), b3 + hstep, voffB);
            PG8_WAIT_V(6); PG8_BAR; PG8_MMA(1, 1, At, B1); PG8_BAR;
            }
        }
        if constexpr (ALIGN_EPI) { if (wr == 0) PG8_BAR; }
        if constexpr (!Epi::AFTER_DRAIN) { E(acc, cur, wr, wc, fr, fq); S.done(cur); }
        if (!has_next) break;
#pragma unroll
        for (int a = 0; a < 2; ++a)
#pragma unroll
            for (int b = 0; b < 2; ++b)
#pragma unroll
                for (int m = 0; m < 4; ++m)
#pragma unroll
                    for (int n = 0; n < 2; ++n) acc[a][b][m][n] = (f32x4){0.f, 0.f, 0.f, 0.f};
        cur = nxt; cA = nA; cB = nB; ++ui;
        if constexpr (ALIGN_EPI) { if (wr == 1) PG8_BAR; }
    }
    PG8_WAIT_V(0);
    if constexpr (!ALIGN_EPI) { if (wr == 0) PG8_BAR; }
    PG8_BAR;
    if constexpr (Epi::AFTER_DRAIN) { E.fused(acc, cur, wr, wc, fr, fq, lds, wid, lane); S.done(cur); }
#undef PG8_SA
#undef PG8_SB
#undef PG8_STAGE
#undef PG8_LDA
#undef PG8_LDB
#undef PG8_MMA
#undef PG8_WAIT_V
#undef PG8_WAIT_L
#undef PG8_BAR
#undef PG8_SCHED
}
}

#define LAS __attribute__((address_space(3)))
typedef unsigned short bf16_t;
typedef short bf16x8 __attribute__((ext_vector_type(8)));
typedef float f32x4 __attribute__((ext_vector_type(4)));
typedef float f32x16 __attribute__((ext_vector_type(16)));
typedef unsigned u32x4 __attribute__((ext_vector_type(4)));
typedef unsigned u32x2 __attribute__((ext_vector_type(2)));

constexpr int DM = 1024, SEQ = 16384, NSMP = 128, MV = SEQ + NSMP, MT = 16640;
constexpr int NIN = 11296, NINP = 11520, DFF = 2816, DIN = 2048, CONVD = 4096;
constexpr int NCHUNK = 264;
constexpr size_t HPN = 32 * 64 * 128;
constexpr int PAST = 4096;

constexpr size_t O_YP = 0, O_YS = O_YP + (size_t)SEQ * DM, O_KP = O_YS + (size_t)NSMP * DM, O_VP = O_KP + 2ull * SEQ * DM,
                 O_CP = O_VP + 2ull * SEQ * DM, O_SP = O_CP + 2ull * 3 * CONVD, O_KS = O_SP + 2ull * HPN, O_VS = O_KS + 2ull * NSMP * DM,
                 O_CS = O_VS + 2ull * NSMP * DM, O_SS = O_CS + 2ull * 8 * 3 * CONVD, O_END = O_SS + 2ull * 8 * HPN;

constexpr size_t MiB = 1ull << 20;
constexpr size_t SZ_WIN = (size_t)NINP * 1024 * 2, SZ_WBA = 1024ull * 1024 * 2, SZ_WBS = 1024ull * 2048 * 2, SZ_WOUT = SZ_WBA,
                 SZ_WGU = 5632ull * 1024 * 2, SZ_WD = 1024ull * DFF * 2;
constexpr size_t WS_CTL = 0, CTL_BYTES = 65536;
constexpr size_t WS_WIN = 1 * MiB, WS_WBA = WS_WIN + 2 * SZ_WIN, WS_WBS = WS_WBA + 2 * SZ_WBA, WS_WOUT = WS_WBS + 2 * SZ_WBS,
                 WS_WGU = WS_WOUT + 2 * SZ_WOUT, WS_WD = WS_WGU + 2 * SZ_WGU, WS_WEND = WS_WD + 2 * SZ_WD;
constexpr size_t WS_KC = (WS_WEND + MiB - 1) / MiB * MiB;
constexpr size_t WS_VTC = WS_KC + 8ull * PAST * 1024 * 2;
constexpr size_t WS_X = WS_VTC + 8ull * PAST * 1024 * 2;
constexpr size_t WS_XB = WS_X + (size_t)MT * 1024 * 4;
constexpr size_t WS_PART = WS_XB + (size_t)MT * 1024 * 2;
constexpr size_t WS_Q = WS_PART + (size_t)MT * 16 * 4;
constexpr size_t WS_K = WS_Q + (size_t)MT * 1024 * 2;
constexpr size_t WS_VT = WS_K + (size_t)MT * 1024 * 2;
constexpr size_t WS_Z = WS_VT + (size_t)MT * 1024 * 2;
constexpr size_t WS_XBC = WS_Z + (size_t)MT * 2048 * 2;
constexpr size_t WS_G = WS_XBC + (size_t)MT * 4096 * 2;
constexpr size_t WS_DT = WS_G + (size_t)MT * 2048 * 2;
constexpr size_t WS_CS = WS_DT + (size_t)MT * 32 * 4;
constexpr size_t WS_CDEC = WS_CS + (size_t)NCHUNK * HPN * 2;
constexpr size_t WS_ATT = WS_CDEC + 65536;
constexpr size_t WS_YSSD = WS_ATT + (size_t)MT * 1024 * 2;
constexpr size_t WS_HIST = WS_YSSD + (size_t)MT * 2048 * 2;
constexpr size_t WS_XTG = WS_HIST + 256ull * 3 * 4096 * 2;
constexpr size_t WS_BTG = WS_XTG + (size_t)NCHUNK * 2048 * 64 * 2;
constexpr size_t WS_ACTS = WS_BTG + (size_t)NCHUNK * 1024 * 64 * 2;
constexpr size_t WS_DTA = WS_ACTS + 256ull * DFF * 2;
constexpr size_t WS_ACSG = WS_DTA + (size_t)NCHUNK * 32 * 64 * 4;
constexpr size_t WS_END = WS_ACSG + (size_t)NCHUNK * 32 * 64 * 4;
static_assert(WS_END <= 1024ull * MiB, "workspace map must fit 1 GiB");

constexpr int LDS_CTL = 131072, LDS_BYTES = 131072 + 1024;
constexpr int AT_KROW = 272, AT_VROW = 144, AT_KSZ = 64 * AT_KROW, AT_VSZ = 128 * AT_VROW, AT_STAGE = AT_KSZ + AT_VSZ;
constexpr int SD_DT = 0, SD_ACS = 1024, SD_RS = 2048, SD_BT = 4096, SD_XT = SD_BT + 128 * 144, SD_CM = SD_XT + 256 * 144, SD_BM = SD_CM + 64 * 272, SD_END = SD_BM + 64 * 272;
static_assert(SD_END <= 131072 && 2 * AT_STAGE <= 131072, "lds");

struct Args { const float* in[26]; float* out; unsigned char* ws; int ph_lo, ph_hi; };

__device__ __forceinline__ unsigned pk_bf16(float lo, float hi) {
    typedef float f2 __attribute__((ext_vector_type(2))); typedef __bf16 b2 __attribute__((ext_vector_type(2)));
    f2 v = {lo, hi}; b2 b = __builtin_convertvector(v, b2); return __builtin_bit_cast(unsigned, b);
}
__device__ __forceinline__ float bf_lo(unsigned u) { return __uint_as_float(u << 16); }
__device__ __forceinline__ float bf_hi(unsigned u) { return __uint_as_float(u & 0xffff0000u); }
__device__ __forceinline__ float fexp2(float x) { return __builtin_amdgcn_exp2f(x); }
__device__ __forceinline__ float fexp(float x) { return __builtin_amdgcn_exp2f(x * 1.4426950408889634f); }
__device__ __forceinline__ float frcp(float x) { return __builtin_amdgcn_rcpf(x); }
__device__ __forceinline__ float silu_f(float x) { return x * frcp(1.0f + fexp(-x)); }
__device__ __forceinline__ float sigmoid_f(float x) { return frcp(1.0f + fexp(-x)); }
__device__ __forceinline__ float wave_sum(float v) {
#pragma unroll
    for (int o = 1; o < 64; o <<= 1) v += __shfl_xor(v, o);
    return v;
}
__device__ __forceinline__ int sig5(int i) { return (i & ~12) | ((i & 4) << 1) | ((i & 8) >> 1); }
__device__ __forceinline__ float rstd1(const float* rss, int row, float eps) { return 1.0f / sqrtf(rss[row] * (1.0f / 1024.0f) + eps); }
__device__ __forceinline__ float rstd_row(const float* part, int row, float eps) {
    const f32x4* p = (const f32x4*)(part + (size_t)row * 16);
    const f32x4 a = p[0], b = p[1], c = p[2], d = p[3];
    const float s = ((a.x + a.y) + (a.z + a.w)) + ((b.x + b.y) + (b.z + b.w)) + ((c.x + c.y) + (c.z + c.w)) + ((d.x + d.y) + (d.z + d.w));
    return 1.0f / sqrtf(s * (1.0f / 1024.0f) + eps);
}
__device__ __forceinline__ float max3f(float a, float b, float c) { float r; asm("v_max3_f32 %0, %1, %2, %3" : "=v"(r) : "v"(a), "v"(b), "v"(c)); return r; }
#define MFMA32(a, b, c) __builtin_amdgcn_mfma_f32_32x32x16_bf16((a), (b), (c), 0, 0, 0)

#define EPI_LOOP_ROWS _Pragma("unroll") for (int ai = 0; ai < 2; ++ai) _Pragma("unroll") for (int m = 0; m < 4; ++m)
#define EPI_LOOP_COLS _Pragma("unroll") for (int bj = 0; bj < 2; ++bj) _Pragma("unroll") for (int n = 0; n < 2; ++n)

struct EpiIn {
    static constexpr bool PERM = true, AFTER_DRAIN = false;
    const float* part; bf16_t *Q, *K, *VT, *Z, *XBC, *G; float* DT; float* out; int layer; bf16_t* HIST;
    __device__ __forceinline__ void operator()(const pg8::f32x4 (&acc)[2][2][4][2], const pg8::Unit& u, int wr, int wc, int fr, int fq) const {
        const int pn = u.pn; const int cb = pn * 256 + wc * 32 + 8 * fq;
        float rsv[2][4];
#pragma unroll
        for (int ai = 0; ai < 2; ++ai)
#pragma unroll
            for (int m = 0; m < 4; ++m) rsv[ai][m] = part[u.pm * 256 + ai * 128 + wr * 64 + m * 16 + fr];
#pragma unroll
        for (int ai = 0; ai < 2; ++ai)
#pragma unroll
            for (int m = 0; m < 4; ++m) rsv[ai][m] = 1.0f / sqrtf(rsv[ai][m] * (1.0f / 1024.0f) + 1e-6f);
        EPI_LOOP_ROWS {
            const int row = u.pm * 256 + ai * 128 + wr * 64 + m * 16 + fr;
            const float rs = rsv[ai][m];
#pragma unroll
            for (int bj = 0; bj < 2; ++bj) {
                const pg8::f32x4 v0 = acc[ai][bj][m][0] * rs, v1 = acc[ai][bj][m][1] * rs; const int col = cb + bj * 128;
                if (pn < 4) {
                    const float sc = 0.125f * 1.4426950408889634f;
                    u32x4 w; w.x = pk_bf16(v0[0] * sc, v0[1] * sc); w.y = pk_bf16(v0[2] * sc, v0[3] * sc); w.z = pk_bf16(v1[0] * sc, v1[1] * sc); w.w = pk_bf16(v1[2] * sc, v1[3] * sc);
                    *(u32x4*)(Q + (size_t)row * 1024 + col) = w;
                } else if (pn < 8) {
                    const int c = col - 1024; u32x4 w; w.x = pk_bf16(v0[0], v0[1]); w.y = pk_bf16(v0[2], v0[3]); w.z = pk_bf16(v1[0], v1[1]); w.w = pk_bf16(v1[2], v1[3]);
                    *(u32x4*)(K + (size_t)row * 1024 + c) = w;
                    float* o = nullptr;
                    if (row < SEQ) o = out + O_KP + ((size_t)layer * SEQ + row) * 1024 + c; else if (row < MV) o = out + O_KS + ((size_t)layer * NSMP + (row - SEQ)) * 1024 + c;
                    if (o) { *(pg8::f32x4*)o = v0; *(pg8::f32x4*)(o + 4) = v1; }
                } else if (pn < 12) {
                    const int c = col - 2048;
                    const unsigned w0 = pk_bf16(v0[0], v0[1]), w1 = pk_bf16(v0[2], v0[3]), w2 = pk_bf16(v1[0], v1[1]), w3 = pk_bf16(v1[2], v1[3]);
                    VT[(size_t)(c + 0) * MT + row] = (bf16_t)(w0 & 0xffffu); VT[(size_t)(c + 1) * MT + row] = (bf16_t)(w0 >> 16);
                    VT[(size_t)(c + 2) * MT + row] = (bf16_t)(w1 & 0xffffu); VT[(size_t)(c + 3) * MT + row] = (bf16_t)(w1 >> 16);
                    VT[(size_t)(c + 4) * MT + row] = (bf16_t)(w2 & 0xffffu); VT[(size_t)(c + 5) * MT + row] = (bf16_t)(w2 >> 16);
                    VT[(size_t)(c + 6) * MT + row] = (bf16_t)(w3 & 0xffffu); VT[(size_t)(c + 7) * MT + row] = (bf16_t)(w3 >> 16);
                    float* o = nullptr;
                    if (row < SEQ) o = out + O_VP + ((size_t)layer * SEQ + row) * 1024 + c; else if (row < MV) o = out + O_VS + ((size_t)layer * NSMP + (row - SEQ)) * 1024 + c;
                    if (o) { *(pg8::f32x4*)o = v0; *(pg8::f32x4*)(o + 4) = v1; }
                } else if (pn < 20) {
                    const int c = col - 3072; u32x4 w; w.x = pk_bf16(v0[0], v0[1]); w.y = pk_bf16(v0[2], v0[3]); w.z = pk_bf16(v1[0], v1[1]); w.w = pk_bf16(v1[2], v1[3]);
                    *(u32x4*)(Z + (size_t)row * 2048 + c) = w;
                } else if (pn < 36) {
                    const int c = col - 5120; u32x4 w; w.x = pk_bf16(v0[0], v0[1]); w.y = pk_bf16(v0[2], v0[3]); w.z = pk_bf16(v1[0], v1[1]); w.w = pk_bf16(v1[2], v1[3]);
                    *(u32x4*)(XBC + (size_t)row * 4096 + c) = w;
                    if (row < SEQ && (row & 63) >= 61) *(u32x4*)(HIST + ((size_t)(row >> 6) * 3 + ((row & 63) - 61)) * 4096 + c) = w;
                    float* o = nullptr;
                    if (row >= SEQ - 3 && row < SEQ) o = out + O_CP + ((size_t)layer * 3 + (row - (SEQ - 3))) * 4096 + c;
                    else if (row >= SEQ && row < MV) { const int s = row - SEQ, t = s & 15; if (t >= 13) o = out + O_CS + (((size_t)layer * 8 + (s >> 4)) * 3 + (t - 13)) * 4096 + c; }
                    if (o) { *(pg8::f32x4*)o = v0; *(pg8::f32x4*)(o + 4) = v1; }
                } else if (pn < 44) {
                    const int c = col - 9216; u32x4 w; w.x = pk_bf16(sigmoid_f(v0[0]), sigmoid_f(v0[1])); w.y = pk_bf16(sigmoid_f(v0[2]), sigmoid_f(v0[3]));
                    w.z = pk_bf16(sigmoid_f(v1[0]), sigmoid_f(v1[1])); w.w = pk_bf16(sigmoid_f(v1[2]), sigmoid_f(v1[3]));
                    *(u32x4*)(G + (size_t)row * 2048 + c) = w;
                } else {
                    const int c = col - 11264;
                    if (c < 32) { *(pg8::f32x4*)(DT + (size_t)row * 32 + c) = v0; *(pg8::f32x4*)(DT + (size_t)row * 32 + c + 4) = v1; }
                }
            }
        }
    }
};

struct EpiNull {
    static constexpr bool PERM = false, AFTER_DRAIN = false; float* sink;
    __device__ __forceinline__ void operator()(const pg8::f32x4 (&acc)[2][2][4][2], const pg8::Unit& u, int wr, int wc, int fr, int fq) const {
        pg8::f32x4 s = acc[0][0][0][0];
        EPI_LOOP_ROWS { EPI_LOOP_COLS { s += acc[ai][bj][m][n]; } }
        if (s[0] == 123456.789f) sink[0] = s[1] + s[2] + s[3];
    }
};
struct EpiBrA {
    static constexpr bool PERM = false, AFTER_DRAIN = false;
    const bf16_t* G; float* MF; int row0;
    __device__ __forceinline__ void operator()(const pg8::f32x4 (&acc)[2][2][4][2], const pg8::Unit& u, int wr, int wc, int fr, int fq) const {
        const int cb = u.pn * 256 + wc * 32 + 4 * fq;
        EPI_LOOP_ROWS { const int row = row0 + u.pm * 256 + ai * 128 + wr * 64 + m * 16 + fr;
            EPI_LOOP_COLS { const int col = cb + bj * 128 + n * 16; const u32x2 g = *(const u32x2*)(G + (size_t)row * 2048 + col);
                pg8::f32x4 v = acc[ai][bj][m][n]; v[0] *= bf_lo(g.x); v[1] *= bf_hi(g.x); v[2] *= bf_lo(g.y); v[3] *= bf_hi(g.y);
                *(pg8::f32x4*)(MF + (size_t)row * 1024 + col) = v; } }
    }
};
struct EpiBrB {
    static constexpr bool PERM = false, AFTER_DRAIN = false;
    const bf16_t* G; const float* MF; bf16_t* MB; int row0;
    __device__ __forceinline__ void operator()(const pg8::f32x4 (&acc)[2][2][4][2], const pg8::Unit& u, int wr, int wc, int fr, int fq) const {
        const int cb = u.pn * 256 + wc * 32 + 4 * fq;
        EPI_LOOP_ROWS { const int row = row0 + u.pm * 256 + ai * 128 + wr * 64 + m * 16 + fr;
            EPI_LOOP_COLS { const int col = cb + bj * 128 + n * 16; const u32x2 g = *(const u32x2*)(G + (size_t)row * 2048 + 1024 + col);
                const pg8::f32x4 a = acc[ai][bj][m][n]; const pg8::f32x4 o = *(const pg8::f32x4*)(MF + (size_t)row * 1024 + col);
                u32x2 w; w.x = pk_bf16(o[0] + a[0] * bf_lo(g.x), o[1] + a[1] * bf_hi(g.x)); w.y = pk_bf16(o[2] + a[2] * bf_lo(g.y), o[3] + a[3] * bf_hi(g.y));
                *(u32x2*)(MB + (size_t)row * 1024 + col) = w; } }
    }
};
struct EpiRes {
    static constexpr bool PERM = false, AFTER_DRAIN = false;
    float* X; bf16_t* XB; float* part; int row0;
    __device__ __forceinline__ void operator()(const pg8::f32x4 (&acc)[2][2][4][2], const pg8::Unit& u, int wr, int wc, int fr, int fq) const {
        const int cb = u.pn * 256 + wc * 32 + 4 * fq;
        EPI_LOOP_ROWS { const int row = row0 + u.pm * 256 + ai * 128 + wr * 64 + m * 16 + fr; float ss = 0.f;
            EPI_LOOP_COLS { const int col = cb + bj * 128 + n * 16; float* xp = X + (size_t)row * 1024 + col;
                const pg8::f32x4 x = *(const pg8::f32x4*)xp + acc[ai][bj][m][n];
                *(pg8::f32x4*)xp = x; u32x2 w; w.x = pk_bf16(x[0], x[1]); w.y = pk_bf16(x[2], x[3]); *(u32x2*)(XB + (size_t)row * 1024 + col) = w;
                ss += (x[0] * x[0] + x[1] * x[1]) + (x[2] * x[2] + x[3] * x[3]); }
            ss += __shfl_xor(ss, 16); ss += __shfl_xor(ss, 32);
            if (fq == 0) atomicAdd(part + row, ss); }
    }
};
struct EpiGU {
    static constexpr bool PERM = true, AFTER_DRAIN = false;
    const float* part; bf16_t* ACT; int row0; int act_sub;
    __device__ __forceinline__ void operator()(const pg8::f32x4 (&acc)[2][2][4][2], const pg8::Unit& u, int wr, int wc, int fr, int fq) const {
        const int cb = u.pn * 128 + wc * 32 + 8 * fq;
        float rsv[2][4];
#pragma unroll
        for (int ai = 0; ai < 2; ++ai)
#pragma unroll
            for (int m = 0; m < 4; ++m) rsv[ai][m] = part[row0 + u.pm * 256 + ai * 128 + wr * 64 + m * 16 + fr];
#pragma unroll
        for (int ai = 0; ai < 2; ++ai)
#pragma unroll
            for (int m = 0; m < 4; ++m) rsv[ai][m] = 1.0f / sqrtf(rsv[ai][m] * (1.0f / 1024.0f) + 1e-6f);
        EPI_LOOP_ROWS { const int row = row0 - act_sub + u.pm * 256 + ai * 128 + wr * 64 + m * 16 + fr; const float rs = rsv[ai][m];
            const pg8::f32x4 g0 = acc[ai][0][m][0] * rs, g1 = acc[ai][0][m][1] * rs, u0 = acc[ai][1][m][0] * rs, u1 = acc[ai][1][m][1] * rs;
            u32x4 w; w.x = pk_bf16(silu_f(g0[0]) * u0[0], silu_f(g0[1]) * u0[1]); w.y = pk_bf16(silu_f(g0[2]) * u0[2], silu_f(g0[3]) * u0[3]);
            w.z = pk_bf16(silu_f(g1[0]) * u1[0], silu_f(g1[1]) * u1[1]); w.w = pk_bf16(silu_f(g1[2]) * u1[2], silu_f(g1[3]) * u1[3]);
            *(u32x4*)(ACT + (size_t)row * DFF + cb) = w; }
    }
};

struct Ctx {
    LAS unsigned char* lds; int tid, lane, wid, G, bid;
    const float* in[26]; float* out; unsigned char* ws;
};
#define WSP(T, off) ((T*)(C.ws + (off)))

struct TItem { const float* W; int N, k0, n0; bf16_t* WT; size_t dst_row0; int Kd; const float* kscale; };
struct TRegs { float tv[32]; f32x4 s0, s1; };
__device__ __forceinline__ void tr_load(const TItem& t, TRegs& r, int lane) {
#pragma unroll
    for (int i = 0; i < 32; ++i) r.tv[i] = t.W[(size_t)(t.k0 + 2 * i + (lane >> 5)) * t.N + t.n0 + (lane & 31)];
    if (t.kscale) { r.s0 = *(const f32x4*)(t.kscale + t.k0 + 8 * (lane & 7)); r.s1 = *(const f32x4*)(t.kscale + t.k0 + 8 * (lane & 7) + 4); }
    else { r.s0 = (f32x4){1.f, 1.f, 1.f, 1.f}; r.s1 = r.s0; }
}
__device__ __forceinline__ void tr_finish(const TItem& t, const TRegs& r, LAS float* scr, int lane) {
#pragma unroll
    for (int i = 0; i < 32; ++i) scr[(2 * i + (lane >> 5)) * 33 + (lane & 31)] = r.tv[i];
    asm volatile("s_waitcnt lgkmcnt(0)" ::: "memory");
    const int c = lane & 7;
#pragma unroll
    for (int j = 0; j < 4; ++j) { const int n = (lane >> 3) + 8 * j; const LAS float* s = scr + (8 * c) * 33 + n;
        u32x4 o; o.x = pk_bf16(s[0 * 33] * r.s0.x, s[1 * 33] * r.s0.y); o.y = pk_bf16(s[2 * 33] * r.s0.z, s[3 * 33] * r.s0.w);
        o.z = pk_bf16(s[4 * 33] * r.s1.x, s[5 * 33] * r.s1.y); o.w = pk_bf16(s[6 * 33] * r.s1.z, s[7 * 33] * r.s1.w);
        *(u32x4*)(t.WT + (t.dst_row0 + n) * (size_t)t.Kd + t.k0 + 8 * c) = o; }
    asm volatile("s_waitcnt lgkmcnt(0)" ::: "memory");
}
__device__ __forceinline__ bool p0_item(const Ctx& C, int it, TItem& t) {
    constexpr int I_IN = 16 * 353, I_BA = 16 * 32, I_BS = 32 * 32, I_OUT = 16 * 32, I_GU = 16 * 176, I_D = 44 * 32, I_L = I_IN + I_BA + I_BS + I_OUT + I_GU + I_D;
    if (it >= 2 * I_L) return false;
    const int L = it / I_L; int r = it % I_L; t.kscale = nullptr;
    if (r < I_IN) { const int kb = r / 353, nb = r % 353, n0 = 32 * nb;
        t.W = C.in[7] + (size_t)L * 1024 * NIN; t.N = NIN; t.k0 = 64 * kb; t.n0 = n0; t.WT = WSP(bf16_t, WS_WIN + L * SZ_WIN);
        t.dst_row0 = n0 < 9216 ? n0 : (n0 < 9248 ? 11264 + (n0 - 9216) : 9216 + (n0 - 9248)); t.Kd = 1024; t.kscale = C.in[6] + L * 1024; return true; }
    r -= I_IN;
    if (r < I_BA) { t.W = C.in[19] + (size_t)L * 1024 * 1024; t.N = 1024; t.k0 = 64 * (r / 32); t.n0 = 32 * (r % 32); t.WT = WSP(bf16_t, WS_WBA + L * SZ_WBA); t.dst_row0 = t.n0; t.Kd = 1024; return true; }
    r -= I_BA;
    if (r < I_BS) { t.W = C.in[20] + (size_t)L * 2048 * 1024; t.N = 1024; t.k0 = 64 * (r / 32); t.n0 = 32 * (r % 32); t.WT = WSP(bf16_t, WS_WBS + L * SZ_WBS); t.dst_row0 = t.n0; t.Kd = 2048; return true; }
    r -= I_BS;
    if (r < I_OUT) { t.W = C.in[21] + (size_t)L * 1024 * 1024; t.N = 1024; t.k0 = 64 * (r / 32); t.n0 = 32 * (r % 32); t.WT = WSP(bf16_t, WS_WOUT + L * SZ_WOUT); t.dst_row0 = t.n0; t.Kd = 1024; return true; }
    r -= I_OUT;
    if (r < I_GU) { const int kb = r / 176, nb = r % 176, n0 = 32 * nb; const int ch = n0 % DFF;
        t.W = C.in[23] + (size_t)L * 1024 * 5632; t.N = 5632; t.k0 = 64 * kb; t.n0 = n0; t.WT = WSP(bf16_t, WS_WGU + L * SZ_WGU);
        t.dst_row0 = 256 * (ch / 128) + (ch % 128) + (n0 >= DFF ? 128 : 0); t.Kd = 1024; t.kscale = C.in[22] + L * 1024; return true; }
    r -= I_GU;
    t.W = C.in[24] + (size_t)L * DFF * 1024; t.N = 1024; t.k0 = 64 * (r / 32); t.n0 = 32 * (r % 32); t.WT = WSP(bf16_t, WS_WD + L * SZ_WD); t.dst_row0 = t.n0; t.Kd = DFF; return true;
}

__device__ __forceinline__ void phase_p0(Ctx& C) {
    LAS float* scr = (LAS float*)(C.lds + C.wid * 8704);
    const int gw = C.bid * 8 + C.wid, NGW = C.G * 8;
    {   TItem cur, nxt; TRegs ra, rb; int it = gw;
        bool have = p0_item(C, it, cur); if (have) tr_load(cur, ra, C.lane);
        while (have) { it += NGW; const bool hn = p0_item(C, it, nxt); if (hn) tr_load(nxt, rb, C.lane);
            tr_finish(cur, ra, scr, C.lane); cur = nxt; ra = rb; have = hn; } }
    {   const int nz = 2 * (NINP - NIN) * 1024 / 8;
        for (int i = C.bid * 512 + C.tid; i < nz; i += C.G * 512) { const int L = i / ((NINP - NIN) * 128), r = i % ((NINP - NIN) * 128);
            *(u32x4*)(WSP(bf16_t, WS_WIN + L * SZ_WIN) + (size_t)NIN * 1024 + (size_t)r * 8) = (u32x4){0u, 0u, 0u, 0u}; } }
    float* X = WSP(float, WS_X); bf16_t* XB = WSP(bf16_t, WS_XB); float* PART = WSP(float, WS_PART);
    for (int mrow = gw; mrow < MT; mrow += NGW) {
        f32x4 v[4]; float ss = 0.f;
#pragma unroll
        for (int j = 0; j < 4; ++j) {
            if (mrow < SEQ) v[j] = *(const f32x4*)(C.in[0] + (size_t)mrow * 1024 + 4 * C.lane + 256 * j);
            else if (mrow < MV) v[j] = *(const f32x4*)(C.in[1] + (size_t)(mrow - SEQ) * 1024 + 4 * C.lane + 256 * j);
            else v[j] = (f32x4){0.f, 0.f, 0.f, 0.f};
            ss += (v[j].x * v[j].x + v[j].y * v[j].y) + (v[j].z * v[j].z + v[j].w * v[j].w);
            *(f32x4*)(X + (size_t)mrow * 1024 + 4 * C.lane + 256 * j) = v[j];
            u32x2 w; w.x = pk_bf16(v[j].x, v[j].y); w.y = pk_bf16(v[j].z, v[j].w);
            *(u32x2*)(XB + (size_t)mrow * 1024 + 4 * C.lane + 256 * j) = w;
        }
        ss = wave_sum(ss);
        if (C.lane < 5) PART[(size_t)C.lane * MT + mrow] = (C.lane == 0) ? ss : 0.f;
    }
}

__device__ __forceinline__ void cache_convert(Ctx& C, int L) {
    const float* ck = C.in[2] + (size_t)L * 8 * PAST * 1024; bf16_t* KC = WSP(bf16_t, WS_KC);
    const int ntask = 8 * PAST * 1024 / 8;
    {   const int stride = C.G * 512;
        for (int i0 = C.bid * 512 + C.tid; i0 < ntask; i0 += 4 * stride) { f32x4 a[4], b[4];
#pragma unroll
            for (int j = 0; j < 4; ++j) { const int i = i0 + j * stride; if (i < ntask) { a[j] = *(const f32x4*)(ck + (size_t)i * 8); b[j] = *(const f32x4*)(ck + (size_t)i * 8 + 4); } }
#pragma unroll
            for (int j = 0; j < 4; ++j) { const int i = i0 + j * stride; if (i < ntask) { u32x4 o; o.x = pk_bf16(a[j].x, a[j].y); o.y = pk_bf16(a[j].z, a[j].w); o.z = pk_bf16(b[j].x, b[j].y); o.w = pk_bf16(b[j].z, b[j].w);
                *(u32x4*)(KC + (size_t)i * 8) = o; } } } }
    LAS float* scr = (LAS float*)(C.lds + C.wid * 8704);
    const int gw = C.bid * 8 + C.wid, NGW = C.G * 8;
    {   TItem cur, nxt; TRegs ra, rb; int it = gw;
#define CV_ITEM(IT, T) ((IT) < 8 * 2048 ? ((T).W = C.in[3] + ((size_t)L * 8 + (IT) / 2048) * PAST * 1024, (T).N = 1024, (T).k0 = 64 * (((IT) % 2048) / 32), (T).n0 = 32 * ((IT) % 32), \
            (T).WT = WSP(bf16_t, WS_VTC) + (size_t)((IT) / 2048) * 1024 * PAST, (T).dst_row0 = (size_t)(T).n0, (T).Kd = PAST, (T).kscale = nullptr, true) : false)
        bool have = CV_ITEM(it, cur); if (have) tr_load(cur, ra, C.lane);
        while (have) { it += NGW; const bool hn = CV_ITEM(it, nxt); if (hn) tr_load(nxt, rb, C.lane);
            tr_finish(cur, ra, scr, C.lane); cur = nxt; ra = rb; have = hn; }
#undef CV_ITEM
    }
}

struct ChunkInfo { int base, Lc, mode; const float* hist; };
__device__ __forceinline__ ChunkInfo chunk_info(const Ctx& C, int L, int c) {
    ChunkInfo ci;
    if (c < 256) { ci.base = 64 * c; ci.Lc = 64; ci.mode = (c == 0) ? 1 : 0; ci.hist = nullptr; }
    else { const int b = c - 256; ci.base = SEQ + 16 * b; ci.Lc = 16; ci.mode = 2; ci.hist = C.in[4] + ((size_t)L * 8 + b) * 3 * CONVD; }
    return ci;
}
__device__ __forceinline__ void conv_t8(const bf16_t* XBC, const ChunkInfo& ci, const float* cw, const float* cbias, int col, int l0, float (&o0)[8], float (&o1)[8]) {
    float i0[11], i1[11];
#pragma unroll
    for (int i = 0; i < 11; ++i) { const int rr = l0 - 3 + i;
        if (rr >= 0 || ci.mode == 0) { const unsigned v = *(const unsigned*)(XBC + (size_t)(ci.base + rr) * 4096 + col); i0[i] = bf_lo(v); i1[i] = bf_hi(v); }
        else if (ci.mode == 1) { i0[i] = 0.f; i1[i] = 0.f; }
        else { const float* hp = ci.hist + (size_t)(3 + rr) * 4096 + col; i0[i] = hp[0]; i1[i] = hp[1]; } }
    float w0[4], w1[4];
#pragma unroll
    for (int j = 0; j < 4; ++j) { w0[j] = cw[j * 4096 + col]; w1[j] = cw[j * 4096 + col + 1]; }
    const float b0 = cbias[col], b1 = cbias[col + 1];
#pragma unroll
    for (int k = 0; k < 8; ++k) { float a0 = b0, a1 = b1;
#pragma unroll
        for (int j = 0; j < 4; ++j) { a0 += w0[j] * i0[k + j]; a1 += w1[j] * i1[k + j]; }
        o0[k] = silu_f(a0); o1[k] = silu_f(a1); }
}
__device__ __forceinline__ void conv_n8(const bf16_t* XBC, const ChunkInfo& ci, const float* cw, const float* cbias, int col, int l, float (&o)[8]) {
    { const f32x4 b0 = *(const f32x4*)(cbias + col), b1 = *(const f32x4*)(cbias + col + 4);
      o[0] = b0.x; o[1] = b0.y; o[2] = b0.z; o[3] = b0.w; o[4] = b1.x; o[5] = b1.y; o[6] = b1.z; o[7] = b1.w; }
#pragma unroll
    for (int j = 0; j < 4; ++j) { const int rr = l - 3 + j; float x[8];
        if (rr >= 0 || ci.mode == 0) { const u32x4 v = *(const u32x4*)(XBC + (size_t)(ci.base + rr) * 4096 + col);
            x[0] = bf_lo(v.x); x[1] = bf_hi(v.x); x[2] = bf_lo(v.y); x[3] = bf_hi(v.y); x[4] = bf_lo(v.z); x[5] = bf_hi(v.z); x[6] = bf_lo(v.w); x[7] = bf_hi(v.w); }
        else if (ci.mode == 1) {
#pragma unroll
            for (int q = 0; q < 8; ++q) x[q] = 0.f; }
        else { const float* hp = ci.hist + (size_t)(3 + rr) * 4096 + col; const f32x4 h0 = *(const f32x4*)hp, h1 = *(const f32x4*)(hp + 4);
            x[0] = h0.x; x[1] = h0.y; x[2] = h0.z; x[3] = h0.w; x[4] = h1.x; x[5] = h1.y; x[6] = h1.z; x[7] = h1.w; }
        const f32x4 wa = *(const f32x4*)(cw + j * 4096 + col), wb = *(const f32x4*)(cw + j * 4096 + col + 4);
        o[0] += wa.x * x[0]; o[1] += wa.y * x[1]; o[2] += wa.z * x[2]; o[3] += wa.w * x[3]; o[4] += wb.x * x[4]; o[5] += wb.y * x[5]; o[6] += wb.z * x[6]; o[7] += wb.w * x[7]; }
#pragma unroll
    for (int q = 0; q < 8; ++q) o[q] = silu_f(o[q]);
}
__device__ __forceinline__ void ssd_dt_acs(Ctx& C, int L, const ChunkInfo& ci, int c, int g, bool write_cdec) {
    if (C.wid < 4) { const int h = 4 * g + C.wid, l = C.lane;
        const float raw = WSP(const float, WS_DT)[(size_t)(ci.base + l) * 32 + h] + C.in[15][L * 32 + h];
        float dt = raw > 20.f ? raw : log1pf(expf(raw)); if (l >= ci.Lc) dt = 0.f;
        const float A = -expf(C.in[16][L * 32 + h]); float a = dt * A;
#pragma unroll
        for (int o = 1; o < 64; o <<= 1) { const float t = __shfl_up(a, o); if (l >= o) a += t; }
        ((LAS float*)(C.lds + SD_DT))[C.wid * 64 + l] = dt; ((LAS float*)(C.lds + SD_ACS))[C.wid * 64 + l] = a;
        if (write_cdec && l == 63) WSP(float, WS_CDEC)[c * 32 + h] = expf(a);
    }
}
__device__ __forceinline__ void st8_bf16(LAS unsigned char* p, const float (&o)[8]) {
    u32x4 w; w.x = pk_bf16(o[0], o[1]); w.y = pk_bf16(o[2], o[3]); w.z = pk_bf16(o[4], o[5]); w.w = pk_bf16(o[6], o[7]); *(LAS u32x4*)p = w;
}

__device__ __forceinline__ void conv_unit(Ctx& C, int L, int c, int slab) {
    const ChunkInfo ci = chunk_info(C, L, c);
    bf16_t* XBC = WSP(bf16_t, WS_XBC); const bf16_t* HIST = WSP(const bf16_t, WS_HIST);
    const float* cw = C.in[13] + (size_t)L * 4 * CONVD; const float* cbias = C.in[14] + (size_t)L * CONVD;
    const int col0 = slab * 512;
    {   u32x4 v[8];
#pragma unroll
        for (int k = 0; k < 8; ++k) { const int idx = C.tid + 512 * k; v[k] = *(const u32x4*)(XBC + (size_t)(ci.base + (idx >> 6)) * 4096 + col0 + (idx & 63) * 8); }
        if (C.tid < 192) { const int r = C.tid >> 6, c16 = C.tid & 63; u32x4 hv;
            if (ci.mode == 1) hv = (u32x4){0u, 0u, 0u, 0u};
            else if (ci.mode == 0) hv = *(const u32x4*)(HIST + ((size_t)(c - 1) * 3 + r) * 4096 + col0 + c16 * 8);
            else { const float* hp = ci.hist + (size_t)r * 4096 + col0 + c16 * 8; const f32x4 a = *(const f32x4*)hp, b = *(const f32x4*)(hp + 4);
                hv.x = pk_bf16(a.x, a.y); hv.y = pk_bf16(a.z, a.w); hv.z = pk_bf16(b.x, b.y); hv.w = pk_bf16(b.z, b.w); }
            *(LAS u32x4*)(C.lds + r * 1024 + c16 * 16) = hv; }
#pragma unroll
        for (int k = 0; k < 8; ++k) { const int idx = C.tid + 512 * k; *(LAS u32x4*)(C.lds + (3 + (idx >> 6)) * 1024 + (idx & 63) * 16) = v[k]; }
    }
    __syncthreads();
#pragma unroll 1
    for (int i = 0; i < 4; ++i) { const int task = C.tid + 512 * i, p = task & 255, lb = task >> 8, l0 = 8 * lb, col = col0 + 2 * p;
        float i0[11], i1[11];
#pragma unroll
        for (int k = 0; k < 11; ++k) { const unsigned v = *(const LAS unsigned*)(C.lds + (l0 + k) * 1024 + p * 4); i0[k] = bf_lo(v); i1[k] = bf_hi(v); }
        float w0[4], w1[4];
#pragma unroll
        for (int j = 0; j < 4; ++j) { const float2 w = *(const float2*)(cw + j * 4096 + col); w0[j] = w.x; w1[j] = w.y; }
        const float2 bb = *(const float2*)(cbias + col);
        float o0[8], o1[8];
#pragma unroll
        for (int k = 0; k < 8; ++k) { float a0 = bb.x, a1 = bb.y;
#pragma unroll
            for (int j = 0; j < 4; ++j) { a0 += w0[j] * i0[k + j]; a1 += w1[j] * i1[k + j]; }
            o0[k] = silu_f(a0); o1[k] = silu_f(a1); }
        if (slab < 6) {
            bf16_t* dst = (slab < 4) ? WSP(bf16_t, WS_XTG) + ((size_t)c * 2048 + col) * 64 + l0 : WSP(bf16_t, WS_BTG) + ((size_t)c * 1024 + (col - 2048)) * 64 + l0;
            u32x4 w; w.x = pk_bf16(o0[0], o0[1]); w.y = pk_bf16(o0[2], o0[3]); w.z = pk_bf16(o0[4], o0[5]); w.w = pk_bf16(o0[6], o0[7]); *(u32x4*)dst = w;
            w.x = pk_bf16(o1[0], o1[1]); w.y = pk_bf16(o1[2], o1[3]); w.z = pk_bf16(o1[4], o1[5]); w.w = pk_bf16(o1[6], o1[7]); *(u32x4*)(dst + 64) = w;
        }
        if (slab >= 4) {
#pragma unroll
            for (int k = 0; k < 8; ++k) if (l0 + k < ci.Lc) *(unsigned*)(XBC + (size_t)(ci.base + l0 + k) * 4096 + col) = pk_bf16(o0[k], o1[k]);
        }
    }
    __syncthreads();
}

__device__ __forceinline__ void ssd_s1_wave(Ctx& C, int L, int c, int h) {
    const ChunkInfo ci = chunk_info(C, L, c);
    const int l = C.lane, q32 = C.lane & 31, hi = C.lane >> 5, g = h >> 2;
    const float raw = WSP(const float, WS_DT)[(size_t)(ci.base + l) * 32 + h] + C.in[15][L * 32 + h];
    float dt = raw > 20.f ? raw : log1pf(expf(raw)); if (l >= ci.Lc) dt = 0.f;
    const float A = -expf(C.in[16][L * 32 + h]); float a = dt * A;
#pragma unroll
    for (int o = 1; o < 64; o <<= 1) { const float t = __shfl_up(a, o); if (l >= o) a += t; }
    WSP(float, WS_DTA)[((size_t)c * 32 + h) * 64 + l] = dt; WSP(float, WS_ACSG)[((size_t)c * 32 + h) * 64 + l] = a;
    const float aend = __shfl(a, 63);
    const float w = dt * fexp(aend - a);
    if (l == 63) WSP(float, WS_CDEC)[c * 32 + h] = expf(a);
    const bf16_t* xt = WSP(const bf16_t, WS_XTG) + ((size_t)c * 2048 + h * 64 + q32) * 64 + hi * 8;
    const bf16_t* bt = WSP(const bf16_t, WS_BTG) + ((size_t)c * 1024 + g * 128 + q32) * 64 + hi * 8;
    f32x16 acc[2][4];
#pragma unroll
    for (int ph = 0; ph < 2; ++ph)
#pragma unroll
        for (int nt = 0; nt < 4; ++nt) acc[ph][nt] = (f32x16){};
#pragma unroll
    for (int ks = 0; ks < 4; ++ks) {
        float wv[8];
#pragma unroll
        for (int j = 0; j < 8; ++j) wv[j] = __shfl(w, 16 * ks + 8 * hi + j);
        bf16x8 bfr[2];
#pragma unroll
        for (int ph = 0; ph < 2; ++ph) { const u32x4 r = *(const u32x4*)(xt + (size_t)ph * 32 * 64 + ks * 16);
            u32x4 o; o.x = pk_bf16(bf_lo(r.x) * wv[0], bf_hi(r.x) * wv[1]); o.y = pk_bf16(bf_lo(r.y) * wv[2], bf_hi(r.y) * wv[3]);
            o.z = pk_bf16(bf_lo(r.z) * wv[4], bf_hi(r.z) * wv[5]); o.w = pk_bf16(bf_lo(r.w) * wv[6], bf_hi(r.w) * wv[7]); bfr[ph] = __builtin_bit_cast(bf16x8, o); }
#pragma unroll
        for (int nt = 0; nt < 4; ++nt) { const bf16x8 afr = *(const bf16x8*)(bt + (size_t)nt * 32 * 64 + ks * 16);
            acc[0][nt] = MFMA32(afr, bfr[0], acc[0][nt]); acc[1][nt] = MFMA32(afr, bfr[1], acc[1][nt]); }
    }
#pragma unroll
    for (int ph = 0; ph < 2; ++ph) { bf16_t* dst = WSP(bf16_t, WS_CS) + (((size_t)c * 32 + h) * 64 + ph * 32 + q32) * 128;
#pragma unroll
        for (int nt = 0; nt < 4; ++nt)
#pragma unroll
            for (int rq = 0; rq < 4; ++rq) { u32x2 o; o.x = pk_bf16(acc[ph][nt][4 * rq], acc[ph][nt][4 * rq + 1]); o.y = pk_bf16(acc[ph][nt][4 * rq + 2], acc[ph][nt][4 * rq + 3]);
                *(u32x2*)(dst + 32 * nt + 8 * rq + 4 * hi) = o; } }
}

__device__ __forceinline__ void ssd_s1_unit(Ctx& C, int L, int c, int g) {
    const ChunkInfo ci = chunk_info(C, L, c);
    const bf16_t* XBC = WSP(const bf16_t, WS_XBC); const float* cw = C.in[13] + (size_t)L * 4 * CONVD; const float* cbias = C.in[14] + (size_t)L * CONVD;
    ssd_dt_acs(C, L, ci, c, g, true);
    __syncthreads();
    {
        const int cp = C.tid & 63, lb = C.tid >> 6; float o0[8], o1[8];
        conv_t8(XBC, ci, cw, cbias, 2048 + g * 128 + 2 * cp, 8 * lb, o0, o1);
        st8_bf16(C.lds + SD_BT + (2 * cp) * 144 + lb * 16, o0); st8_bf16(C.lds + SD_BT + (2 * cp + 1) * 144 + lb * 16, o1);
    }
#pragma unroll 1
    for (int i = 0; i < 2; ++i) {
        const int task = C.tid + 512 * i, cp = task & 127, lb = task >> 7, hh = cp >> 5; float o0[8], o1[8];
        conv_t8(XBC, ci, cw, cbias, g * 256 + 2 * cp, 8 * lb, o0, o1);
        const LAS float* dts = (const LAS float*)(C.lds + SD_DT) + hh * 64 + 8 * lb; const LAS float* acs = (const LAS float*)(C.lds + SD_ACS) + hh * 64;
        const float aend = acs[63];
#pragma unroll
        for (int k = 0; k < 8; ++k) { const float w = dts[k] * fexp(aend - acs[8 * lb + k]); o0[k] *= w; o1[k] *= w; }
        st8_bf16(C.lds + SD_XT + (2 * cp) * 144 + lb * 16, o0); st8_bf16(C.lds + SD_XT + (2 * cp + 1) * 144 + lb * 16, o1);
    }
    __syncthreads();
    {   const int hh = C.wid >> 1, ph = C.wid & 1, q32 = C.lane & 31, hi = C.lane >> 5, h = 4 * g + hh;
        f32x16 acc[4];
#pragma unroll
        for (int nt = 0; nt < 4; ++nt) acc[nt] = (f32x16){};
#pragma unroll
        for (int ks = 0; ks < 4; ++ks) { const bf16x8 bfr = *(const LAS bf16x8*)(C.lds + SD_XT + (hh * 64 + ph * 32 + q32) * 144 + ks * 32 + hi * 16);
#pragma unroll
            for (int nt = 0; nt < 4; ++nt) { const bf16x8 afr = *(const LAS bf16x8*)(C.lds + SD_BT + (nt * 32 + q32) * 144 + ks * 32 + hi * 16); acc[nt] = MFMA32(afr, bfr, acc[nt]); } }
        bf16_t* dst = WSP(bf16_t, WS_CS) + (((size_t)c * 32 + h) * 64 + ph * 32 + q32) * 128;
#pragma unroll
        for (int nt = 0; nt < 4; ++nt)
#pragma unroll
            for (int rq = 0; rq < 4; ++rq) { u32x2 w; w.x = pk_bf16(acc[nt][4 * rq], acc[nt][4 * rq + 1]); w.y = pk_bf16(acc[nt][4 * rq + 2], acc[nt][4 * rq + 3]);
                *(u32x2*)(dst + 32 * nt + 8 * rq + 4 * hi) = w; }
    }
    __syncthreads();
}

__device__ __forceinline__ void ssd_scan(Ctx& C, int L) {
    bf16_t* CS = WSP(bf16_t, WS_CS); const float* CDEC = WSP(const float, WS_CDEC);
    for (int gid = C.bid * 512 + C.tid; gid < (int)(HPN / 2); gid += C.G * 512) {
        const int h = gid >> 12; float s0 = 0.f, s1 = 0.f; unsigned* p = (unsigned*)CS + gid;
#pragma unroll 1
        for (int c0 = 0; c0 < 256; c0 += 16) { unsigned v[16]; float d[16];
#pragma unroll
            for (int j = 0; j < 16; ++j) { v[j] = p[(size_t)(c0 + j) * (HPN / 2)]; d[j] = CDEC[(c0 + j) * 32 + h]; }
#pragma unroll
            for (int j = 0; j < 16; ++j) { p[(size_t)(c0 + j) * (HPN / 2)] = pk_bf16(s0, s1); s0 = d[j] * s0 + bf_lo(v[j]); s1 = d[j] * s1 + bf_hi(v[j]); } }
        float* o = C.out + O_SP + (size_t)L * HPN + 2 * (size_t)gid; o[0] = s0; o[1] = s1;
#pragma unroll
        for (int b = 0; b < 8; ++b) { const float* ip = C.in[5] + ((size_t)L * 8 + b) * HPN + 2 * (size_t)gid; const float i0 = ip[0], i1 = ip[1];
            unsigned* q = p + (size_t)(256 + b) * (HPN / 2); const unsigned v = *q; const float d = CDEC[(256 + b) * 32 + h];
            *q = pk_bf16(i0, i1);
            float* os = C.out + O_SS + ((size_t)L * 8 + b) * HPN + 2 * (size_t)gid; os[0] = d * i0 + bf_lo(v); os[1] = d * i1 + bf_hi(v); }
    }
}

__device__ __forceinline__ void ssd_s3_unit(Ctx& C, int L, int c, int g) {
    const ChunkInfo ci = chunk_info(C, L, c);
    const bf16_t* XBC = WSP(const bf16_t, WS_XBC); const float* cw = C.in[13] + (size_t)L * 4 * CONVD; const float* cbias = C.in[14] + (size_t)L * CONVD;
    const int hh = C.wid >> 1, ph = C.wid & 1, q32 = C.lane & 31, hi = C.lane >> 5, h = 4 * g + hh;
    const int chb = h * 64 + ph * 32 + 4 * hi;
    bf16x8 pf[8], xf[3][2]; u32x2 zf[2][4];
    {   const bf16_t* prev = WSP(const bf16_t, WS_CS) + (((size_t)c * 32 + h) * 64 + ph * 32 + q32) * 128 + hi * 8;
#pragma unroll
        for (int ks = 0; ks < 8; ++ks) pf[ks] = *(const bf16x8*)(prev + ks * 16);
#pragma unroll
        for (int tile = 0; tile < 3; ++tile)
#pragma unroll
            for (int sp = 0; sp < 2; ++sp) xf[tile][sp] = *(const bf16x8*)(WSP(const bf16_t, WS_XTG) + ((size_t)c * 2048 + h * 64 + ph * 32 + q32) * 64 + (tile >> 1) * 32 + sp * 16 + hi * 8);
#pragma unroll
        for (int lh = 0; lh < 2; ++lh)
#pragma unroll
            for (int rq = 0; rq < 4; ++rq) zf[lh][rq] = *(const u32x2*)(WSP(const bf16_t, WS_Z) + (size_t)(ci.base + lh * 32 + q32) * 2048 + chb + 8 * rq);
    }
    if (C.tid < 256) { const size_t o = ((size_t)c * 32 + 4 * g + (C.tid >> 6)) * 64 + (C.tid & 63); const float dtv = WSP(const float, WS_DTA)[o], av = WSP(const float, WS_ACSG)[o];
        ((LAS float*)(C.lds + SD_DT))[C.tid] = dtv; ((LAS float*)(C.lds + SD_ACS))[C.tid] = av; }
#pragma unroll
    for (int i = 0; i < 2; ++i) {
        const int task = C.tid + 512 * i, c8 = task & 15, l = task >> 4;
        const u32x4 vc = *(const u32x4*)(XBC + (size_t)(ci.base + l) * 4096 + 3072 + g * 128 + c8 * 8), vb = *(const u32x4*)(XBC + (size_t)(ci.base + l) * 4096 + 2048 + g * 128 + c8 * 8);
        *(LAS u32x4*)(C.lds + SD_CM + l * 272 + c8 * 16) = vc; *(LAS u32x4*)(C.lds + SD_BM + ((l & 32) | sig5(l & 31)) * 272 + c8 * 16) = vb;
    }
    __syncthreads();
    const LAS float* dts = (const LAS float*)(C.lds + SD_DT) + hh * 64; const LAS float* acs = (const LAS float*)(C.lds + SD_ACS) + hh * 64;
    f32x16 acc[2]; acc[0] = (f32x16){}; acc[1] = (f32x16){};
    {
#pragma unroll
        for (int ks = 0; ks < 8; ++ks) { const bf16x8 afr = pf[ks];
#pragma unroll
            for (int lh = 0; lh < 2; ++lh) { const bf16x8 bfr = *(const LAS bf16x8*)(C.lds + SD_CM + (lh * 32 + q32) * 272 + ks * 32 + hi * 16); acc[lh] = MFMA32(afr, bfr, acc[lh]); } }
#pragma unroll
        for (int lh = 0; lh < 2; ++lh) { const float e = fexp(acs[lh * 32 + q32]);
#pragma unroll
            for (int r = 0; r < 16; ++r) acc[lh][r] *= e; }
    }
    const float Dh = C.in[17][L * 32 + h];
#pragma unroll
    for (int tile = 0; tile < 3; ++tile) {
        const int sh = tile >> 1, lh = (tile + 1) >> 1;
        f32x16 T = (f32x16){};
#pragma unroll
        for (int ks = 0; ks < 8; ++ks) { const bf16x8 afr = *(const LAS bf16x8*)(C.lds + SD_BM + (sh * 32 + q32) * 272 + ks * 32 + hi * 16);
            const bf16x8 bfr = *(const LAS bf16x8*)(C.lds + SD_CM + (lh * 32 + q32) * 272 + ks * 32 + hi * 16); T = MFMA32(afr, bfr, T); }
        const int l = lh * 32 + q32; const float al = acs[l];
        unsigned pk[8];
#pragma unroll
        for (int r2 = 0; r2 < 8; ++r2) { float mv[2];
#pragma unroll
            for (int q = 0; q < 2; ++q) { const int r = 2 * r2 + q; const int s = sh * 32 + 16 * (r >> 3) + 8 * hi + (r & 7);
                float w = 0.f; if (s <= l) w = fexp(al - acs[s]) * dts[s];
                mv[q] = T[r] * w + ((s == l) ? Dh : 0.f); }
            pk[r2] = pk_bf16(mv[0], mv[1]); }
#pragma unroll
        for (int sp = 0; sp < 2; ++sp) { const bf16x8 afr = xf[tile][sp];
            const u32x4 bw = {pk[4 * sp], pk[4 * sp + 1], pk[4 * sp + 2], pk[4 * sp + 3]};
            acc[lh] = MFMA32(afr, __builtin_bit_cast(bf16x8, bw), acc[lh]); }
    }
#pragma unroll
    for (int lh = 0; lh < 2; ++lh) { const int l = lh * 32 + q32; float ss = 0.f;
#pragma unroll
        for (int rq = 0; rq < 4; ++rq) { const u32x2 z = zf[lh][rq];
            acc[lh][4 * rq + 0] *= silu_f(bf_lo(z.x)); acc[lh][4 * rq + 1] *= silu_f(bf_hi(z.x)); acc[lh][4 * rq + 2] *= silu_f(bf_lo(z.y)); acc[lh][4 * rq + 3] *= silu_f(bf_hi(z.y));
#pragma unroll
            for (int q = 0; q < 4; ++q) ss += acc[lh][4 * rq + q] * acc[lh][4 * rq + q]; }
        ss += __shfl_xor(ss, 32);
        if (hi == 0) ((LAS float*)(C.lds + SD_RS))[C.wid * 64 + l] = ss; }
    __syncthreads();
    const float* nw = C.in[18] + (size_t)L * DIN; bf16_t* Y = WSP(bf16_t, WS_YSSD);
#pragma unroll
    for (int lh = 0; lh < 2; ++lh) { const int l = lh * 32 + q32; float tot = 0.f;
#pragma unroll
        for (int w = 0; w < 8; ++w) tot += ((const LAS float*)(C.lds + SD_RS))[w * 64 + l];
        const float rs = 1.0f / sqrtf(tot * (1.0f / 256.0f) + 1e-5f);
        if (l < ci.Lc) {
#pragma unroll
            for (int rq = 0; rq < 4; ++rq) { const f32x4 wv = *(const f32x4*)(nw + chb + 8 * rq);
                u32x2 o; o.x = pk_bf16(acc[lh][4 * rq] * rs * wv.x, acc[lh][4 * rq + 1] * rs * wv.y); o.y = pk_bf16(acc[lh][4 * rq + 2] * rs * wv.z, acc[lh][4 * rq + 3] * rs * wv.w);
                *(u32x2*)(Y + (size_t)(ci.base + l) * 2048 + chb + 8 * rq) = o; } } }
    __syncthreads();
}

struct AttnUnit { int qrow0, h, NT, ncache, krow0, kvalid, b, nt_base, sample; };
constexpr int AT_ST = 32768;
__device__ __forceinline__ void attn_unit(Ctx& C, int L, const AttnUnit u, const int rep) {
    const int mp = C.wid >> 2, wq = C.wid & 3, q32 = C.lane & 31, hi = C.lane >> 5;
    const bf16_t* Qb = WSP(const bf16_t, WS_Q); const bf16_t* Kb = WSP(const bf16_t, WS_K); const bf16_t* VT = WSP(const bf16_t, WS_VT);
    const bf16_t* KC = WSP(const bf16_t, WS_KC); const bf16_t* VTC = WSP(const bf16_t, WS_VTC);
    float lam; const float lam_init = (L == 0) ? 0.2f : 0.35550906f;
    { const float s1 = wave_sum(C.in[8][L * 64 + C.lane] * C.in[9][L * 64 + C.lane]), s2 = wave_sum(C.in[10][L * 64 + C.lane] * C.in[11][L * 64 + C.lane]);
      lam = expf(s1) - expf(s2) + lam_init; }
    const bool active = u.sample ? (wq == 0) : true;
    const int ntw = u.sample ? u.NT : (u.nt_base + (wq >> 1));
    bf16x8 qf[4];
    { const bf16_t* qp = Qb + (size_t)(u.qrow0 + 32 * wq + q32) * 1024 + u.h * 128 + mp * 64 + hi * 8;
#pragma unroll
      for (int ds = 0; ds < 4; ++ds) qf[ds] = *(const bf16x8*)(qp + ds * 16); }
    asm volatile("" : "+v"(qf[0]), "+v"(qf[1]), "+v"(qf[2]), "+v"(qf[3]));
    f32x16 O[4];
#pragma unroll
    for (int eb = 0; eb < 4; ++eb) O[eb] = (f32x16){};
    float m_run = 0.f, l_run = 0.f; f32x16 negm = (f32x16){};
    int koff[2], ve[2], vc[2];
#pragma unroll
    for (int i = 0; i < 2; ++i) { const int j = C.wid + 8 * i;
        const int r = 4 * j + (C.lane >> 4), c = (C.lane & 15) ^ (r & 15); koff[i] = ((r & 32) | sig5(r & 31)) * 1024 + c * 8;
        const int e = 8 * j + (C.lane >> 3), cv = (C.lane & 7) ^ ((e >> 1) & 7); ve[i] = e; vc[i] = cv * 8; }
    int kso[4], vso[4];
#pragma unroll
    for (int ds = 0; ds < 4; ++ds) { kso[ds] = ((mp * 8 + ds * 2 + hi) ^ (q32 & 15)) * 16; vso[ds] = ((ds * 2 + hi) ^ ((q32 >> 1) & 7)) * 16; }
#define AT_ISSUE(t, st) do { const int t_ = (t); \
        const bf16_t* kp_ = (t_ < u.ncache) ? KC + ((size_t)u.b * PAST + 64 * t_) * 1024 + u.h * 128 : Kb + ((size_t)u.krow0 + 64 * (t_ - u.ncache)) * 1024 + u.h * 128; \
        const bf16_t* vp_; int vs_; \
        if (t_ < u.ncache) { vp_ = VTC + ((size_t)u.b * 1024 + u.h * 128) * PAST + 64 * t_; vs_ = PAST; } else { vp_ = VT + (size_t)(u.h * 128) * MT + u.krow0 + 64 * (t_ - u.ncache); vs_ = MT; } \
        _Pragma("unroll") for (int i_ = 0; i_ < 2; ++i_) { \
            __builtin_amdgcn_global_load_lds((const unsigned*)(kp_ + koff[i_]), (LAS unsigned*)(C.lds + (st) * AT_ST + (C.wid + 8 * i_) * 1024), 16, 0, 0); \
            __builtin_amdgcn_global_load_lds((const unsigned*)(vp_ + (size_t)ve[i_] * vs_ + vc[i_]), (LAS unsigned*)(C.lds + (st) * AT_ST + 16384 + (C.wid + 8 * i_) * 1024), 16, 0, 0); } } while (0)
    AT_ISSUE(0, 0); AT_ISSUE(1, 1);
    int st_cur = 0, st_nxt2 = 2;
#pragma unroll 1
    for (int t = 0; t < u.NT; ++t) {
        if (t + 1 < u.NT) asm volatile("s_waitcnt vmcnt(4)\n\ts_barrier" ::: "memory");
        else asm volatile("s_waitcnt vmcnt(0)\n\ts_barrier" ::: "memory");
        if (t + 2 < u.NT) AT_ISSUE(t + 2, st_nxt2);
        if (active && t < ntw) {
            const LAS unsigned char* kb = C.lds + st_cur * AT_ST + q32 * 256;
            const LAS unsigned char* vb = C.lds + st_cur * AT_ST + 16384 + q32 * 128;
            bf16x8 ka[8];
#pragma unroll
            for (int ds = 0; ds < 4; ++ds) { ka[ds] = *(const LAS bf16x8*)(kb + kso[ds]); ka[4 + ds] = *(const LAS bf16x8*)(kb + 8192 + kso[ds]); }
            f32x16 S0 = MFMA32(ka[0], qf[0], negm);
#pragma unroll
            for (int ds = 1; ds < 4; ++ds) S0 = MFMA32(ka[ds], qf[ds], S0);
            f32x16 S1 = MFMA32(ka[4], qf[0], negm);
#pragma unroll
            for (int ds = 1; ds < 4; ++ds) S1 = MFMA32(ka[4 + ds], qf[ds], S1);
            bf16x8 va[4];
#pragma unroll
            for (int eb = 0; eb < 4; ++eb) va[eb] = *(const LAS bf16x8*)(vb + eb * 4096 + vso[0]);
            float mx = max3f(S0[0], S0[1], S0[2]);
#pragma unroll
            for (int r = 3; r < 15; r += 2) mx = max3f(mx, S0[r], S0[r + 1]);
            mx = max3f(mx, S0[15], S0[15]);
#pragma unroll
            for (int r = 0; r < 16; ++r) S0[r] = fexp2(S0[r]);
            float mx1 = max3f(S1[0], S1[1], S1[2]);
#pragma unroll
            for (int r = 3; r < 15; r += 2) mx1 = max3f(mx1, S1[r], S1[r + 1]);
            mx = max3f(mx, mx1, S1[15]);
            mx = max3f(mx, __shfl_xor(mx, 32), mx);
            if (t == 0 || __any(mx > 8.0f)) {
                const float dl = (t == 0) ? mx : fmaxf(mx, 0.f);
                m_run += dl;
                const float f = fexp2(-dl); l_run *= f;
#pragma unroll
                for (int r = 0; r < 16; ++r) { S0[r] *= f; S1[r] -= dl; negm[r] = -m_run; }
#pragma unroll
                for (int eb = 0; eb < 4; ++eb)
#pragma unroll
                    for (int r = 0; r < 16; ++r) O[eb][r] *= f;
            }
            if (t == u.NT - 1 && u.kvalid < 64) {
#pragma unroll
                for (int r = 0; r < 16; ++r) { const int kv = 16 * (r >> 3) + 8 * hi + (r & 7); if (kv >= u.kvalid) S0[r] = 0.f; if (kv + 32 >= u.kvalid) S1[r] = -INFINITY; } }
            u32x4 pk[4];
#pragma unroll
            for (int sp = 0; sp < 2; ++sp)
                pk[sp] = (u32x4){pk_bf16(S0[8 * sp], S0[8 * sp + 1]), pk_bf16(S0[8 * sp + 2], S0[8 * sp + 3]), pk_bf16(S0[8 * sp + 4], S0[8 * sp + 5]), pk_bf16(S0[8 * sp + 6], S0[8 * sp + 7])};
#pragma unroll
            for (int eb = 0; eb < 4; ++eb) O[eb] = MFMA32(va[eb], __builtin_bit_cast(bf16x8, pk[0]), O[eb]);
#pragma unroll
            for (int eb = 0; eb < 4; ++eb) va[eb] = *(const LAS bf16x8*)(vb + eb * 4096 + vso[1]);
#pragma unroll
            for (int r = 0; r < 16; ++r) S1[r] = fexp2(S1[r]);
#pragma unroll
            for (int eb = 0; eb < 4; ++eb) O[eb] = MFMA32(va[eb], __builtin_bit_cast(bf16x8, pk[1]), O[eb]);
#pragma unroll
            for (int eb = 0; eb < 4; ++eb) va[eb] = *(const LAS bf16x8*)(vb + eb * 4096 + vso[2]);
#pragma unroll
            for (int sp = 0; sp < 2; ++sp)
                pk[2 + sp] = (u32x4){pk_bf16(S1[8 * sp], S1[8 * sp + 1]), pk_bf16(S1[8 * sp + 2], S1[8 * sp + 3]), pk_bf16(S1[8 * sp + 4], S1[8 * sp + 5]), pk_bf16(S1[8 * sp + 6], S1[8 * sp + 7])};
#pragma unroll
            for (int eb = 0; eb < 4; ++eb) O[eb] = MFMA32(va[eb], __builtin_bit_cast(bf16x8, pk[2]), O[eb]);
#pragma unroll
            for (int eb = 0; eb < 4; ++eb) va[eb] = *(const LAS bf16x8*)(vb + eb * 4096 + vso[3]);
            float sum = 0.f, sum2 = 0.f;
#pragma unroll
            for (int r = 0; r < 16; ++r) { sum += S0[r]; sum2 += S1[r]; }
            l_run += sum + sum2;
#pragma unroll
            for (int eb = 0; eb < 4; ++eb) O[eb] = MFMA32(va[eb], __builtin_bit_cast(bf16x8, pk[3]), O[eb]);
#if MK_SGB
#pragma unroll
            for (int i_ = 0; i_ < 16; ++i_) { __builtin_amdgcn_sched_group_barrier(0x008, 1, 0); __builtin_amdgcn_sched_group_barrier(0x100, 1, 0); __builtin_amdgcn_sched_group_barrier(0x002, 5, 0); }
#endif
        }
        st_cur = (st_cur == 2) ? 0 : st_cur + 1; st_nxt2 = (st_nxt2 == 2) ? 0 : st_nxt2 + 1;
    }
#undef AT_ISSUE
    asm volatile("s_waitcnt lgkmcnt(0)\n\ts_barrier" ::: "memory");
    const float ltot = l_run + __shfl_xor(l_run, 32); const float inv = 1.0f / ltot;
    LAS float* EX = (LAS float*)C.lds + wq * 4096;
    if (mp == 1 && active) {
#pragma unroll
        for (int eb = 0; eb < 4; ++eb)
#pragma unroll
            for (int r = 0; r < 16; ++r) EX[(32 * eb + 8 * (r >> 2) + 4 * hi + (r & 3)) * 32 + q32] = O[eb][r] * inv;
    }
    __syncthreads();
    if (mp == 0 && active) {
        float ss = 0.f;
#pragma unroll
        for (int eb = 0; eb < 4; ++eb)
#pragma unroll
            for (int r = 0; r < 16; ++r) { const float d = O[eb][r] * inv - lam * EX[(32 * eb + 8 * (r >> 2) + 4 * hi + (r & 3)) * 32 + q32]; O[eb][r] = d; ss += d * d; }
        ss += __shfl_xor(ss, 32);
        const float rs = (1.0f / sqrtf(ss * (1.0f / 128.0f) + 1e-5f)) * (1.0f - lam_init);
        const float* sw = C.in[12] + L * 128;
        if (!u.sample || q32 < 16) {
            bf16_t* dst = WSP(bf16_t, WS_ATT) + (size_t)(u.qrow0 + 32 * wq + q32) * 1024 + u.h * 128 + 4 * hi;
#pragma unroll
            for (int eb = 0; eb < 4; ++eb)
#pragma unroll
                for (int rq = 0; rq < 4; ++rq) { const f32x4 wv = *(const f32x4*)(sw + 32 * eb + 8 * rq + 4 * hi);
                    u32x2 o; o.x = pk_bf16(O[eb][4 * rq] * rs * wv.x, O[eb][4 * rq + 1] * rs * wv.y); o.y = pk_bf16(O[eb][4 * rq + 2] * rs * wv.z, O[eb][4 * rq + 3] * rs * wv.w);
                    *(u32x2*)(dst + 32 * eb + 8 * rq) = o; }
        }
    }
    __syncthreads();
}

struct OneUnit { int pm, pn;
    __device__ __forceinline__ bool next(int i, pg8::Unit& u) const { if (i) return false; u.pm = pm; u.pn = pn; return true; }
    __device__ __forceinline__ void a_ready(const pg8::Unit&) const {}
    __device__ __forceinline__ void done(const pg8::Unit&) const {} };
__device__ __forceinline__ void flag_publish(unsigned* cnt, int tid) {
    asm volatile("s_waitcnt vmcnt(0)" ::: "memory"); __syncthreads();
    if (tid == 0) { __builtin_amdgcn_fence(__ATOMIC_RELEASE, "agent"); asm volatile("s_waitcnt vmcnt(0)" ::: "memory"); __hip_atomic_fetch_add(cnt, 1u, __ATOMIC_RELAXED, __HIP_MEMORY_SCOPE_AGENT); }
}
__device__ __forceinline__ void flag_wait(unsigned* cnt, unsigned target, int tid) {
    if (tid == 0) { unsigned sp = 0; while (__hip_atomic_load(cnt, __ATOMIC_RELAXED, __HIP_MEMORY_SCOPE_AGENT) < target) { __builtin_amdgcn_s_sleep(16); if (++sp > (1u << 24)) break; } }
    __syncthreads();
    __builtin_amdgcn_fence(__ATOMIC_ACQUIRE, "agent"); asm volatile("s_waitcnt vmcnt(0)" ::: "memory");
    __syncthreads();
}
__device__ __forceinline__ void chain_item(Ctx& C, int L, int kind, int idx) {
    unsigned* cnt = WSP(unsigned, WS_CTL) + 64 * (20 + 4 * L);
    if (kind == 0) {
        flag_wait(cnt, 128u, C.tid);
        OneUnit S{0, idx};
        { pg8::Gemm g{WSP(const bf16_t, WS_ATT) + (size_t)SEQ * 1024, WSP(const bf16_t, WS_WBA + L * SZ_WBA), 256, 1024, 1024}; EpiBrA E{WSP(const bf16_t, WS_G), WSP(float, WS_Z), SEQ};
          pg8::gemm_phase<EpiBrA, OneUnit, true, true>(C.lds, g, S, E); }
        { pg8::Gemm g{WSP(const bf16_t, WS_YSSD) + (size_t)SEQ * 2048, WSP(const bf16_t, WS_WBS + L * SZ_WBS), 256, 1024, 2048}; EpiBrB E{WSP(const bf16_t, WS_G), WSP(const float, WS_Z), WSP(bf16_t, WS_Q), SEQ};
          pg8::gemm_phase<EpiBrB, OneUnit, true, true>(C.lds, g, S, E); }
        flag_publish(cnt + 64, C.tid);
    } else if (kind == 1) {
        flag_wait(cnt + 64, 4u, C.tid);
        OneUnit S{0, idx};
        pg8::Gemm g{WSP(const bf16_t, WS_Q) + (size_t)SEQ * 1024, WSP(const bf16_t, WS_WOUT + L * SZ_WOUT), 256, 1024, 1024};
        EpiRes E{WSP(float, WS_X), WSP(bf16_t, WS_XB), WSP(float, WS_PART) + (size_t)(2 * L + 1) * MT, SEQ};
        pg8::gemm_phase<EpiRes, OneUnit, true, true>(C.lds, g, S, E);
        flag_publish(cnt + 128, C.tid);
    } else if (kind == 2) {
        flag_wait(cnt + 128, 4u, C.tid);
        OneUnit S{0, idx};
        pg8::Gemm g{WSP(const bf16_t, WS_XB) + (size_t)SEQ * 1024, WSP(const bf16_t, WS_WGU + L * SZ_WGU), 256, 5632, 1024};
        EpiGU E{WSP(const float, WS_PART) + (size_t)(2 * L + 1) * MT, WSP(bf16_t, WS_ACTS), SEQ, SEQ};
        pg8::gemm_phase<EpiGU, OneUnit, true, true>(C.lds, g, S, E);
        flag_publish(cnt + 192, C.tid);
    } else {
        flag_wait(cnt + 192, 22u, C.tid);
        OneUnit S{0, idx};
        pg8::Gemm g{WSP(const bf16_t, WS_ACTS), WSP(const bf16_t, WS_WD + L * SZ_WD), 256, 1024, DFF};
        EpiRes E{WSP(float, WS_X), WSP(bf16_t, WS_XB), WSP(float, WS_PART) + (size_t)(2 * L + 2) * MT, SEQ};
        pg8::gemm_phase<EpiRes, OneUnit, true, true>(C.lds, g, S, E);
    }
    __syncthreads();
}

__device__ __forceinline__ void phase_mix(Ctx& C, int L, int rep) {
    unsigned* counter = WSP(unsigned, WS_CTL) + 64 * (1 + L + 4 * rep);
    unsigned* cntA = WSP(unsigned, WS_CTL) + 64 * (20 + 4 * L);
    volatile LAS int* slot = (volatile LAS int*)(C.lds + LDS_CTL);
    constexpr int N_SMP = 64, N_S3S = 64, N_MID = 1024 + 34, N_S3 = 2048, N_ALL = N_SMP + N_S3S + N_MID + N_S3;
    for (;;) {
        __syncthreads();
        if (C.tid == 0) slot[0] = (int)atomicAdd(counter, 1u);
        __syncthreads();
        const int item = slot[0];
        if (item >= N_ALL) break;
        { int t_ = threadIdx.x; asm volatile("" : "+v"(t_)); C.tid = t_; C.lane = t_ & 63; C.wid = __builtin_amdgcn_readfirstlane(t_ >> 6); }
        if (item < N_SMP) { AttnUnit u; u.sample = 1; u.b = item >> 3; u.h = item & 7; u.qrow0 = SEQ + 16 * u.b; u.NT = 65; u.ncache = 64; u.krow0 = SEQ + 16 * u.b; u.kvalid = 16; u.nt_base = 65;
            attn_unit(C, L, u, rep); flag_publish(cntA, C.tid); }
        else if (item < N_SMP + N_S3S) { const int j = 2048 + (item - N_SMP); ssd_s3_unit(C, L, j >> 3, j & 7); flag_publish(cntA, C.tid); }
        else if (item < N_SMP + N_S3S + N_MID) { const int mi = item - N_SMP - N_S3S; int j = -1, kind = -1, idx = 0;
            if (mi < 400) j = mi; else if (mi < 404) { kind = 0; idx = mi - 400; } else if (mi < 560) j = mi - 4; else if (mi < 564) { kind = 1; idx = mi - 560; }
            else if (mi < 720) j = mi - 8; else if (mi < 742) { kind = 2; idx = mi - 720; } else if (mi < 880) j = mi - 30; else if (mi < 884) { kind = 3; idx = mi - 880; } else j = mi - 34;
            if (kind >= 0) chain_item(C, L, kind, idx);
            else { const int qb = 127 - (j >> 3); AttnUnit u; u.sample = 0; u.b = 0; u.h = j & 7; u.qrow0 = 128 * qb; u.NT = 2 * qb + 2; u.ncache = 0; u.krow0 = 0; u.kvalid = 64; u.nt_base = 2 * qb + 1; attn_unit(C, L, u, rep); } }
        else { const int j = item - N_SMP - N_S3S - N_MID; ssd_s3_unit(C, L, j >> 3, j & 7); }
    }
}

__device__ __forceinline__ void phase_final(Ctx& C) {
    const float* X = WSP(const float, WS_X); const float* PART = WSP(const float, WS_PART); const float* nw = C.in[25];
    const int gw = C.bid * 8 + C.wid, NGW = C.G * 8;
    for (int row = gw; row < MV; row += NGW) { const float rs = rstd1(PART + 4 * MT, row, 1e-6f);
#pragma unroll
        for (int j = 0; j < 4; ++j) { const int col = 4 * C.lane + 256 * j; const f32x4 x = *(const f32x4*)(X + (size_t)row * 1024 + col); const f32x4 w = *(const f32x4*)(nw + col);
            *(f32x4*)(C.out + O_YP + (size_t)row * 1024 + col) = (x * rs) * w; } }
}

#define XB_TMO      128
#define XB_XCNT(j)  (256  + 64 * (j))
#define XB_XSUB(j)  (1280 + 64 * (j))
#define XB_XGEN(j)  (2304 + 64 * (j))
#define XB_TOP      3328
#define XB_TOPGEN   3392
#define XCD_BAR_WORDS 3456
#define XB_SPIN_CAP (1u << 23)

__device__ __forceinline__ unsigned xb_ld(unsigned* p)              { return __hip_atomic_load(p, __ATOMIC_RELAXED, __HIP_MEMORY_SCOPE_AGENT); }
__device__ __forceinline__ unsigned xb_add(unsigned* p, unsigned v) { return __hip_atomic_fetch_add(p, v, __ATOMIC_RELAXED, __HIP_MEMORY_SCOPE_AGENT); }
__device__ __forceinline__ unsigned xb_xcc_id() { return (unsigned)__builtin_amdgcn_s_getreg((3 << 11) | 20) & 0xFu; }
#define XB_SPIN(cond, bar) do { unsigned _sp = 0; while (cond) { __builtin_amdgcn_s_sleep(1); \
    if ((++_sp & 255u) == 0u) { if (xb_ld(&(bar)[XB_TMO])) break; if (_sp > XB_SPIN_CAP) { atomicAdd(&(bar)[XB_TMO], 1u); break; } } } } while (0)

struct XcdBarrier {
    unsigned* bar; unsigned x;
    volatile LAS unsigned* st;
};

__device__ __forceinline__ XcdBarrier xcd_barrier_post(unsigned* bar, volatile LAS unsigned* st) {
    XcdBarrier b; b.bar = bar; b.x = xb_xcc_id(); b.st = st;
    if (threadIdx.x == 0) (void)xb_add(&bar[XB_XCNT(b.x)], 1u);
    return b;
}
__device__ __forceinline__ void xcd_barrier_complete(unsigned* bar, unsigned x, unsigned& nloc, unsigned& nx) {
    const unsigned G = gridDim.x * gridDim.y * gridDim.z;
    unsigned sum, cnt, mine, sp = 0u;
    for (;;) {
        sum = 0u; cnt = 0u; mine = 0u;
#pragma unroll
        for (unsigned j = 0; j < 16; ++j) { const unsigned c = xb_ld(&bar[XB_XCNT(j)]); sum += c; cnt += (c > 0u) ? 1u : 0u; mine = (j == x) ? c : mine; }
        if (sum == G) break;
        __builtin_amdgcn_s_sleep(1);
        if ((++sp & 255u) == 0u) { if (xb_ld(&bar[XB_TMO])) break; if (sp > XB_SPIN_CAP) { atomicAdd(&bar[XB_TMO], 1u); break; } }
    }
    nloc = mine > 0u ? mine : 1u; nx = cnt > 0u ? cnt : 1u;
}

__device__ __forceinline__ void xcd_barrier(const XcdBarrier& b) {
    asm volatile("s_waitcnt vmcnt(0)" ::: "memory");
    __syncthreads();
    if (threadIdx.x == 0) {
        unsigned* bar = b.bar;
        __builtin_amdgcn_s_waitcnt(0);
        unsigned nloc = b.st[0], nx = b.st[1];
        if (nloc == 0u) { xcd_barrier_complete(bar, b.x, nloc, nx); b.st[0] = nloc; b.st[1] = nx; }
        const unsigned old = xb_add(&bar[XB_XSUB(b.x)], 1u);
        const unsigned gen = old / nloc;
        if (old + 1u == (gen + 1u) * nloc) {
            __builtin_amdgcn_fence(__ATOMIC_RELEASE, "agent");
            asm volatile("s_waitcnt vmcnt(0)" ::: "memory");
            const unsigned og = xb_add(&bar[XB_TOP], 1u);
            const unsigned tg = og / nx;
            if (og + 1u == (tg + 1u) * nx) xb_add(&bar[XB_TOPGEN], 1u);
            else XB_SPIN(xb_ld(&bar[XB_TOPGEN]) == tg, bar);
            __builtin_amdgcn_fence(__ATOMIC_ACQUIRE, "agent");
            xb_add(&bar[XB_XGEN(b.x)], 1u);
            asm volatile("s_waitcnt vmcnt(0)" ::: "memory");
        } else {
            XB_SPIN(xb_ld(&bar[XB_XGEN(b.x)]) == gen, bar);
            __builtin_amdgcn_fence(__ATOMIC_ACQUIRE, "agent");
            asm volatile("s_waitcnt vmcnt(0)" ::: "memory");
        }
    }
    __syncthreads();
}

constexpr int N_PHASES = 18;
__global__ void __launch_bounds__(512, 2) mk_fwd(Args a) {
    extern __shared__ __attribute__((aligned(16))) unsigned char lds_raw[];
    Ctx C;
    C.lds = (LAS unsigned char*)lds_raw; C.G = gridDim.x; C.bid = blockIdx.x;
#pragma unroll
    for (int i = 0; i < 26; ++i) C.in[i] = a.in[i];
    C.out = a.out; C.ws = a.ws;
    cg::grid_group grid = cg::this_grid();
    if (threadIdx.x < 64) ((LAS unsigned*)(C.lds + LDS_CTL))[threadIdx.x] = 0u;
    __syncthreads();
    XcdBarrier xbar = xcd_barrier_post(WSP(unsigned, WS_CTL) + 4096, (volatile LAS unsigned*)(C.lds + LDS_CTL + 32));
#pragma unroll 1
    for (int ph = a.ph_lo; ph < a.ph_hi; ++ph) {
        if (ph == a.ph_lo + 1) { grid.sync(); } else if (ph > a.ph_lo) { xcd_barrier(xbar); }
        { int t_ = threadIdx.x; asm volatile("" : "+v"(t_)); C.tid = t_; C.lane = t_ & 63; C.wid = __builtin_amdgcn_readfirstlane(t_ >> 6); }
        if (ph == 0) { if (!(MK_SKIP & 1024)) phase_p0(C); continue; }
        if (ph == N_PHASES - 1) { phase_final(C); continue; }
        const int L = (ph - 1) >> 3, sub = (ph - 1) & 7;
        if (sub == 0) {
            pg8::Gemm g{WSP(const bf16_t, WS_XB), WSP(const bf16_t, WS_WIN + L * SZ_WIN), MT, NINP, 1024}; pg8::StaticOrder S; S.init(MT, NINP, C.G, C.bid);
            EpiIn E{WSP(const float, WS_PART) + (size_t)(2 * L) * MT, WSP(bf16_t, WS_Q), WSP(bf16_t, WS_K), WSP(bf16_t, WS_VT), WSP(bf16_t, WS_Z), WSP(bf16_t, WS_XBC), WSP(bf16_t, WS_G), WSP(float, WS_DT), C.out, L, WSP(bf16_t, WS_HIST)};
            if (!(MK_SKIP & 1)) pg8::gemm_phase<EpiIn, pg8::StaticOrder, true, true>(C.lds, g, S, E);
            if (MK_PROBE & 2) { grid.sync(); pg8::gemm_phase<EpiIn, pg8::StaticOrder, true, true>(C.lds, g, S, E); }
            if (MK_PROBE & 1024) { grid.sync(); EpiNull EN{WSP(float, WS_END - 64)}; pg8::gemm_phase<EpiNull, pg8::StaticOrder, true, true>(C.lds, g, S, EN); }
        } else if (sub == 1) {
            for (int uidx = C.bid; uidx < NCHUNK * 8; uidx += C.G) { { int t_ = threadIdx.x; asm volatile("" : "+v"(t_)); C.tid = t_; C.lane = t_ & 63; C.wid = __builtin_amdgcn_readfirstlane(t_ >> 6); } conv_unit(C, L, uidx >> 3, uidx & 7); }
            if (!(MK_SKIP & 4)) cache_convert(C, L);
            xcd_barrier(xbar);
            for (int uidx = C.bid * 8 + C.wid; uidx < NCHUNK * 32; uidx += C.G * 8) { { int t_ = threadIdx.x; asm volatile("" : "+v"(t_)); C.tid = t_; C.lane = t_ & 63; C.wid = __builtin_amdgcn_readfirstlane(t_ >> 6); } ssd_s1_wave(C, L, uidx >> 5, uidx & 31); }
            if (MK_PROBE & 512) { grid.sync(); for (int uidx = C.bid * 8 + C.wid; uidx < NCHUNK * 32; uidx += C.G * 8) { { int t_ = threadIdx.x; asm volatile("" : "+v"(t_)); C.tid = t_; C.lane = t_ & 63; C.wid = __builtin_amdgcn_readfirstlane(t_ >> 6); } ssd_s1_wave(C, L, uidx >> 5, uidx & 31); } }
        } else if (sub == 2) {
            if (!(MK_SKIP & 8)) ssd_scan(C, L);
        } else if (sub == 3) {
            phase_mix(C, L, 0);
            if (MK_PROBE & 1) { grid.sync(); phase_mix(C, L, 1); }
        } else if (sub == 4) {
            pg8::StaticOrder S; S.init(SEQ, 1024, C.G, C.bid);
            { pg8::Gemm g{WSP(const bf16_t, WS_ATT), WSP(const bf16_t, WS_WBA + L * SZ_WBA), SEQ, 1024, 1024}; EpiBrA E{WSP(const bf16_t, WS_G), WSP(float, WS_Z), 0};
              if (!(MK_SKIP & 64)) pg8::gemm_phase<EpiBrA, pg8::StaticOrder, true, true>(C.lds, g, S, E); }
            { pg8::Gemm g{WSP(const bf16_t, WS_YSSD), WSP(const bf16_t, WS_WBS + L * SZ_WBS), SEQ, 1024, 2048}; EpiBrB E{WSP(const bf16_t, WS_G), WSP(const float, WS_Z), WSP(bf16_t, WS_Q), 0};
              if (!(MK_SKIP & 128)) pg8::gemm_phase<EpiBrB, pg8::StaticOrder, true, true>(C.lds, g, S, E); }
        } else if (sub == 5) {
            pg8::Gemm g{WSP(const bf16_t, WS_Q), WSP(const bf16_t, WS_WOUT + L * SZ_WOUT), SEQ, 1024, 1024}; pg8::StaticOrder S; S.init(SEQ, 1024, C.G, C.bid);
            EpiRes E{WSP(float, WS_X), WSP(bf16_t, WS_XB), WSP(float, WS_PART) + (size_t)(2 * L + 1) * MT, 0};
            if (!(MK_SKIP & 256)) pg8::gemm_phase<EpiRes, pg8::StaticOrder, true, true>(C.lds, g, S, E);
        } else if (sub == 6) {
            pg8::Gemm g{WSP(const bf16_t, WS_XB), WSP(const bf16_t, WS_WGU + L * SZ_WGU), SEQ, 5632, 1024}; pg8::StaticOrder S; S.init(SEQ, 5632, C.G, C.bid);
            EpiGU E{WSP(const float, WS_PART) + (size_t)(2 * L + 1) * MT, WSP(bf16_t, WS_XBC), 0, 0};
            if (!(MK_SKIP & 512)) pg8::gemm_phase<EpiGU, pg8::StaticOrder, true, true>(C.lds, g, S, E);
            if (MK_PROBE & 4) { grid.sync(); pg8::gemm_phase<EpiGU, pg8::StaticOrder, true, true>(C.lds, g, S, E); }
        } else {
            pg8::Gemm g{WSP(const bf16_t, WS_XBC), WSP(const bf16_t, WS_WD + L * SZ_WD), SEQ, 1024, DFF}; pg8::StaticOrder S; S.init(SEQ, 1024, C.G, C.bid);
            EpiRes E{WSP(float, WS_X), WSP(bf16_t, WS_XB), WSP(float, WS_PART) + (size_t)(2 * L + 2) * MT, 0};
            if (!(MK_SKIP & 256)) pg8::gemm_phase<EpiRes, pg8::StaticOrder, true, true>(C.lds, g, S, E);
        }
    }
}

extern "C" void kernel_launch(void* const* d_in, const int* in_sizes, int n_in, void* d_out, int out_size, void* d_ws, size_t ws_size, hipStream_t stream) {
    static int grid = 0;
    if (grid == 0) {
        if (n_in != 26 || (size_t)out_size != O_END || ws_size < WS_END) { fprintf(stderr, "kernel_launch: unexpected shapes (n_in %d, out %d, ws %zu)\n", n_in, out_size, ws_size); grid = -1; return; }
        int dev = 0, cus = 0, per_cu = 0;
        hipGetDevice(&dev); hipDeviceGetAttribute(&cus, hipDeviceAttributeMultiprocessorCount, dev);
        if (hipFuncSetAttribute((const void*)mk_fwd, hipFuncAttributeMaxDynamicSharedMemorySize, LDS_BYTES) != hipSuccess) { fprintf(stderr, "kernel_launch: hipFuncSetAttribute failed\n"); grid = -1; return; }
        if (hipOccupancyMaxActiveBlocksPerMultiprocessor(&per_cu, (const void*)mk_fwd, 512, LDS_BYTES) != hipSuccess || per_cu < 1) per_cu = 1;
        (void)hipGetLastError();
        grid = cus * per_cu;
    }
    if (grid < 0) return;
    hipMemsetAsync((char*)d_ws + WS_CTL, 0, CTL_BYTES, stream);
    Args a{};
    for (int i = 0; i < 26; ++i) a.in[i] = (const float*)d_in[i];
    a.out = (float*)d_out; a.ws = (unsigned char*)d_ws;
#if MK_MULTI
    for (int ph = 0; ph < N_PHASES; ++ph) { a.ph_lo = ph; a.ph_hi = ph + 1; hipLaunchKernelGGL(mk_fwd, dim3(grid), dim3(512), LDS_BYTES, stream, a); }
#else
    a.ph_lo = 0; a.ph_hi = N_PHASES;
    void* args[] = {&a};
    hipError_t e = hipLaunchCooperativeKernel((const void*)mk_fwd, dim3(grid), dim3(512), args, LDS_BYTES, stream);
    if (e != hipSuccess) fprintf(stderr, "cooperative launch failed: %s (grid %d)\n", hipGetErrorString(e), grid);
#endif
}
```

```cpp
#include <hip/hip_runtime.h>
#include <hip/hip_cooperative_groups.h>
#include <cstdio>
#include <cstdint>
#include <cmath>
namespace cg = cooperative_groups;
#ifndef MK_MULTI
#define MK_MULTI 0
#endif
#ifndef MK_SKIP
#define MK_SKIP 0
#endif
#ifndef MK_PROBE
#define MK_PROBE 0
#endif
#ifndef MK_SGB
#define MK_SGB 1
#endif
namespace pg8 {
#define PG8_LAS __attribute__((address_space(3)))
typedef unsigned short bf16_t;
typedef short bf16x8 __attribute__((ext_vector_type(8)));
typedef float f32x4 __attribute__((ext_vector_type(4)));
typedef unsigned u32x4 __attribute__((ext_vector_type(4)));
constexpr int BM = 256, BK = 64, HALF = 128, HTB = HALF * BK * 2  , STAGE_BYTES = 8 * HTB, NXCD = 8, WGM = 8;

__host__ __device__ __forceinline__ int lds_byte(int r, int c) { const int st = (r >> 4) * 2 + (c >> 5), rr = r & 15, cc = c & 31, ob = rr * 64 + cc * 2; return st * 1024 + (ob ^ (((ob >> 9) & 1) << 5)); }
__host__ __device__ __forceinline__ void stage_rc(int b, int& R, int& C) { const int st = b / 1024, sb = b % 1024, swz = sb ^ (((sb >> 9) & 1) << 5); R = (st >> 1) * 16 + swz / 64; C = (st & 1) * 32 + (swz % 64) / 2; }
__host__ __device__ __forceinline__ int perm32(int rho) { const int n = rho >> 4, i = rho & 15; return 8 * (i >> 2) + 4 * n + (i & 3); }

struct Unit { int pm, pn; };
struct Gemm { const bf16_t* A; const bf16_t* Bt; int M, N, K; };

struct StaticOrder {
    int nM, nN, nwg, G, c;
    __host__ __device__ void init(int M, int N, int G_, int c_) { nM = M / BM; nN = N / BM; nwg = nM * nN; G = G_; c = c_; }
    __host__ __device__ bool next(int i, Unit& u) const {
        const long L = (long)i * G + c; if (L >= nwg) return false;
        int wgid = (int)L; { const int q = nwg / NXCD, r = nwg % NXCD, xcd = wgid % NXCD, off = wgid / NXCD; wgid = (xcd < r ? xcd * (q + 1) : r * (q + 1) + (xcd - r) * q) + off; }
        const int nig = WGM * nN, gid = wgid / nig, fm = gid * WGM, gsz = (nM - fm) < WGM ? (nM - fm) : WGM;
        u.pm = fm + ((wgid % nig) % gsz); u.pn = (wgid % nig) / gsz; return true;
    }
    __device__ __forceinline__ void a_ready(const Unit&) const {}
    __device__ __forceinline__ void done(const Unit&) const {}
};

template <class Epi, class Sched, bool ALIGN_EPI = false, bool SP2 = false>
__device__ __forceinline__ void gemm_phase(PG8_LAS unsigned char* lds, const Gemm g, const Sched& S, const Epi& E) {
    int tid_ = threadIdx.x; asm volatile("" : "+v"(tid_)); const int tid = tid_, wid = __builtin_amdgcn_readfirstlane(tid >> 6), lane = tid & 63, wr = wid >> 2, wc = wid & 3, fr = lane & 15, fq = lane >> 4;
    const int K = g.K, nt = K / BK;
    unsigned voffA[2], voffB[2];
#pragma unroll
    for (int i = 0; i < 2; ++i) { int R, C; stage_rc(tid * 16 + i * 8192, R, C); const int Rb = Epi::PERM ? ((R & ~31) + perm32(R & 31)) : R;
        voffA[i] = (unsigned)(R * K + C) * 2u; voffB[i] = (unsigned)(Rb * K + C) * 2u; }
    const size_t kstep = (size_t)(BK * 2);
    const size_t hstep = (size_t)HALF * K * 2;
    const size_t tstep = 2 * hstep;
    const unsigned ldsw = (unsigned)wid * 1024u;
    const int aoff = lds_byte(wr * 64 + fr, fq * 8), boff = lds_byte(wc * 32 + fr, fq * 8);
#define PG8_SA(b, h) (((b) * 2 + (h)) * HTB)
#define PG8_SB(b, h) ((4 + (b) * 2 + (h)) * HTB)
#define PG8_STAGE(bufoff, gbase, voff) do { _Pragma("unroll") for (int _i = 0; _i < 2; ++_i) \
        __builtin_amdgcn_global_load_lds((const unsigned*)((const char*)(gbase) + (voff)[_i]), (PG8_LAS unsigned*)(lds + (bufoff) + ldsw + _i * 8192), 16, 0, 0); } while (0)
#define PG8_LDA(dst, b, h) do { _Pragma("unroll") for (int m = 0; m < 4; ++m) _Pragma("unroll") for (int k = 0; k < 2; ++k) dst[m][k] = *(const PG8_LAS bf16x8*)(lds + PG8_SA(b, h) + aoff + m * 2048 + k * 1024); } while (0)
#define PG8_LDB(dst, b, h) do { _Pragma("unroll") for (int n = 0; n < 2; ++n) _Pragma("unroll") for (int k = 0; k < 2; ++k) dst[n][k] = *(const PG8_LAS bf16x8*)(lds + PG8_SB(b, h) + boff + n * 2048 + k * 1024); } while (0)
#define PG8_MMA(ai, bj, At, Bt) do { __builtin_amdgcn_s_setprio(1); _Pragma("unroll") for (int m = 0; m < 4; ++m) _Pragma("unroll") for (int n = 0; n < 2; ++n) _Pragma("unroll") for (int k = 0; k < 2; ++k) \
        acc[ai][bj][m][n] = __builtin_amdgcn_mfma_f32_16x16x32_bf16(Bt[n][k], At[m][k], acc[ai][bj][m][n], 0, 0, 0); __builtin_amdgcn_s_setprio(0); } while (0)
#define PG8_WAIT_V(n) asm volatile("s_waitcnt vmcnt(" #n ")" ::: "memory")
#define PG8_WAIT_L(n) asm volatile("s_waitcnt lgkmcnt(" #n ")" ::: "memory")
#define PG8_BAR __builtin_amdgcn_s_barrier()
#define PG8_SCHED __builtin_amdgcn_sched_barrier(0)
    Unit cur, nxt; int ui = 0;
    if (!S.next(0, cur)) return;
    f32x4 acc[2][2][4][2];
#pragma unroll
    for (int a = 0; a < 2; ++a)
#pragma unroll
        for (int b = 0; b < 2; ++b)
#pragma unroll
            for (int m = 0; m < 4; ++m)
#pragma unroll
                for (int n = 0; n < 2; ++n) acc[a][b][m][n] = (f32x4){0.f, 0.f, 0.f, 0.f};
    bf16x8 At[4][2], B0[2][2], B1[2][2];
    const char* cA = (const char*)g.A + (size_t)cur.pm * tstep; const char* cB = (const char*)g.Bt + (size_t)cur.pn * tstep;
    S.a_ready(cur);
    if constexpr (SP2) {
        PG8_STAGE(PG8_SB(0, 0), cB, voffB); PG8_STAGE(PG8_SB(0, 1), cB + hstep, voffB); PG8_STAGE(PG8_SA(0, 0), cA, voffA); PG8_STAGE(PG8_SA(0, 1), cA + hstep, voffA);
        if (wr == 1) PG8_BAR;
        PG8_WAIT_V(2); PG8_BAR;
        PG8_STAGE(PG8_SB(1, 0), cB + kstep, voffB); PG8_STAGE(PG8_SA(1, 0), cA + kstep, voffA); PG8_STAGE(PG8_SB(1, 1), cB + hstep + kstep, voffB);
        PG8_WAIT_V(6); PG8_BAR;
    } else {
        PG8_STAGE(PG8_SB(0, 0), cB, voffB); PG8_STAGE(PG8_SA(0, 0), cA, voffA); PG8_STAGE(PG8_SB(0, 1), cB + hstep, voffB); PG8_STAGE(PG8_SA(0, 1), cA + hstep, voffA);
        if (wr == 1) PG8_BAR;
        PG8_WAIT_V(4); PG8_BAR;
        PG8_STAGE(PG8_SB(1, 0), cB + kstep, voffB); PG8_STAGE(PG8_SA(1, 0), cA + kstep, voffA); PG8_STAGE(PG8_SB(1, 1), cB + hstep + kstep, voffB);
        PG8_WAIT_V(6); PG8_BAR;
    }
    for (;;) {
        const bool has_next = S.next(ui + 1, nxt);
        const char* nA = has_next ? (const char*)g.A + (size_t)nxt.pm * tstep : cA; const char* nB = has_next ? (const char*)g.Bt + (size_t)nxt.pn * tstep : cB;
        for (int t = 0; t < nt; t += 2) {
            const bool last = (t == nt - 2);
            const char* a1 = cA + (size_t)(t + 1) * kstep;
            const char* a2 = last ? nA : cA + (size_t)(t + 2) * kstep; const char* b2 = last ? nB : cB + (size_t)(t + 2) * kstep;
            const char* a3 = a2 + kstep; const char* b3 = b2 + kstep;
            if (last && has_next) S.a_ready(nxt);
            if constexpr (SP2) {
            PG8_LDB(B0, 0, 0); PG8_LDB(B1, 0, 1); PG8_SCHED; PG8_LDA(At, 0, 0); PG8_STAGE(PG8_SA(1, 1), a1 + hstep, voffA);
            PG8_WAIT_V(8); PG8_WAIT_L(0); PG8_BAR; PG8_MMA(0, 0, At, B0); PG8_MMA(0, 1, At, B1); PG8_BAR; PG8_SCHED;
            PG8_LDA(At, 0, 1); PG8_STAGE(PG8_SB(0, 0), b2, voffB); PG8_STAGE(PG8_SB(0, 1), b2 + hstep, voffB); PG8_STAGE(PG8_SA(0, 0), a2, voffA);
            PG8_WAIT_V(8); PG8_WAIT_L(0); PG8_BAR; PG8_MMA(1, 0, At, B0); PG8_MMA(1, 1, At, B1); PG8_BAR; PG8_SCHED;
            PG8_LDB(B0, 1, 0); PG8_LDB(B1, 1, 1); PG8_SCHED; PG8_LDA(At, 1, 0); PG8_STAGE(PG8_SA(0, 1), a2 + hstep, voffA);
            PG8_WAIT_V(8); PG8_WAIT_L(0); PG8_BAR; PG8_MMA(0, 0, At, B0); PG8_MMA(0, 1, At, B1); PG8_BAR; PG8_SCHED;
            PG8_LDA(At, 1, 1); PG8_STAGE(PG8_SB(1, 0), b3, voffB); PG8_STAGE(PG8_SB(1, 1), b3 + hstep, voffB); PG8_STAGE(PG8_SA(1, 0), a3, voffA);
            PG8_WAIT_V(8); PG8_WAIT_L(0); PG8_BAR; PG8_MMA(1, 0, At, B0); PG8_MMA(1, 1, At, B1); PG8_BAR; PG8_SCHED;
            } else {
            PG8_LDB(B0, 0, 0); PG8_SCHED; PG8_LDA(At, 0, 0); PG8_STAGE(PG8_SA(1, 1), a1 + hstep, voffA);
            PG8_WAIT_L(8); PG8_BAR; PG8_WAIT_L(0); PG8_MMA(0, 0, At, B0); PG8_BAR; PG8_SCHED;
            PG8_LDB(B1, 0, 1); PG8_STAGE(PG8_SB(0, 0), b2, voffB);
            PG8_BAR; PG8_WAIT_L(0); PG8_MMA(0, 1, At, B1); PG8_BAR;
            PG8_LDA(At, 0, 1); PG8_STAGE(PG8_SA(0, 0), a2, voffA);
            PG8_BAR; PG8_WAIT_L(0); PG8_MMA(1, 0, At, B0); PG8_BAR; PG8_SCHED;
            PG8_STAGE(PG8_SB(0, 1), b2 + hstep, voffB);
            PG8_WAIT_V(6); PG8_BAR; PG8_MMA(1, 1, At, B1); PG8_BAR;
            PG8_LDB(B0, 1, 0); PG8_SCHED; PG8_LDA(At, 1, 0); PG8_STAGE(PG8_SA(0, 1), a2 + hstep, voffA);
            PG8_WAIT_L(8); PG8_BAR; PG8_WAIT_L(0); PG8_MMA(0, 0, At, B0); PG8_BAR; PG8_SCHED;
            PG8_LDB(B1, 1, 1); PG8_STAGE(PG8_SB(1, 0), b3, voffB);
            PG8_BAR; PG8_WAIT_L(0); PG8_MMA(0, 1, At, B1); PG8_BAR;
            PG8_LDA(At, 1, 1); PG8_STAGE(PG8_SA(1, 0), a3, voffA);
            PG8_BAR; PG8_WAIT_L(0); PG8_MMA(1, 0, At, B0); PG8_BAR; PG8_SCHED;
            PG8_STAGE(PG8_SB(1, 1), b3 + hstep, voffB);
            PG8_WAIT_V(6); PG8_BAR; PG8_MMA(1, 1, At, B1); PG8_BAR;
            }
        }
        if constexpr (ALIGN_EPI) { if (wr == 0) PG8_BAR; }
        if constexpr (!Epi::AFTER_DRAIN) { E(acc, cur, wr, wc, fr, fq); S.done(cur); }
        if (!has_next) break;
#pragma unroll
        for (int a = 0; a < 2; ++a)
#pragma unroll
            for (int b = 0; b < 2; ++b)
#pragma unroll
                for (int m = 0; m < 4; ++m)
#pragma unroll
                    for (int n = 0; n < 2; ++n) acc[a][b][m][n] = (f32x4){0.f, 0.f, 0.f, 0.f};
        cur = nxt; cA = nA; cB = nB; ++ui;
        if constexpr (ALIGN_EPI) { if (wr == 1) PG8_BAR; }
    }
    PG8_WAIT_V(0);
    if constexpr (!ALIGN_EPI) { if (wr == 0) PG8_BAR; }
    PG8_BAR;
    if constexpr (Epi::AFTER_DRAIN) { E.fused(acc, cur, wr, wc, fr, fq, lds, wid, lane); S.done(cur); }
#undef PG8_SA
#undef PG8_SB
#undef PG8_STAGE
#undef PG8_LDA
#undef PG8_LDB
#undef PG8_MMA
#undef PG8_WAIT_V
#undef PG8_WAIT_L
#undef PG8_BAR
#undef PG8_SCHED
}
}

#define LAS __attribute__((address_space(3)))
typedef unsigned short bf16_t;
typedef short bf16x8 __attribute__((ext_vector_type(8)));
typedef float f32x4 __attribute__((ext_vector_type(4)));
typedef float f32x16 __attribute__((ext_vector_type(16)));
typedef unsigned u32x4 __attribute__((ext_vector_type(4)));
typedef unsigned u32x2 __attribute__((ext_vector_type(2)));

constexpr int DM = 1024, SEQ = 16384, NSMP = 128, MV = SEQ + NSMP, MT = 16640;
constexpr int NIN = 11296, NINP = 11520, DFF = 2816, DIN = 2048, CONVD = 4096;
constexpr int NCHUNK = 264;
constexpr size_t HPN = 32 * 64 * 128;
constexpr int PAST = 4096;

constexpr size_t O_YP = 0, O_YS = O_YP + (size_t)SEQ * DM, O_KP = O_YS + (size_t)NSMP * DM, O_VP = O_KP + 2ull * SEQ * DM,
                 O_CP = O_VP + 2ull * SEQ * DM, O_SP = O_CP + 2ull * 3 * CONVD, O_KS = O_SP + 2ull * HPN, O_VS = O_KS + 2ull * NSMP * DM,
                 O_CS = O_VS + 2ull * NSMP * DM, O_SS = O_CS + 2ull * 8 * 3 * CONVD, O_END = O_SS + 2ull * 8 * HPN;

constexpr size_t MiB = 1ull << 20;
constexpr size_t SZ_WIN = (size_t)NINP * 1024 * 2, SZ_WBA = 1024ull * 1024 * 2, SZ_WBS = 1024ull * 2048 * 2, SZ_WOUT = SZ_WBA,
                 SZ_WGU = 5632ull * 1024 * 2, SZ_WD = 1024ull * DFF * 2;
constexpr size_t WS_CTL = 0, CTL_BYTES = 65536;
constexpr size_t WS_WIN = 1 * MiB, WS_WBA = WS_WIN + 2 * SZ_WIN, WS_WBS = WS_WBA + 2 * SZ_WBA, WS_WOUT = WS_WBS + 2 * SZ_WBS,
                 WS_WGU = WS_WOUT + 2 * SZ_WOUT, WS_WD = WS_WGU + 2 * SZ_WGU, WS_WEND = WS_WD + 2 * SZ_WD;
constexpr size_t WS_KC = (WS_WEND + MiB - 1) / MiB * MiB;
constexpr size_t WS_VTC = WS_KC + 8ull * PAST * 1024 * 2;
constexpr size_t WS_X = WS_VTC + 8ull * PAST * 1024 * 2;
constexpr size_t WS_XB = WS_X + (size_t)MT * 1024 * 4;
constexpr size_t WS_PART = WS_XB + (size_t)MT * 1024 * 2;
constexpr size_t WS_Q = WS_PART + (size_t)MT * 16 * 4;
constexpr size_t WS_K = WS_Q + (size_t)MT * 1024 * 2;
constexpr size_t WS_VT = WS_K + (size_t)MT * 1024 * 2;
constexpr size_t WS_Z = WS_VT + (size_t)MT * 1024 * 2;
constexpr size_t WS_XBC = WS_Z + (size_t)MT * 2048 * 2;
constexpr size_t WS_G = WS_XBC + (size_t)MT * 4096 * 2;
constexpr size_t WS_DT = WS_G + (size_t)MT * 2048 * 2;
constexpr size_t WS_CS = WS_DT + (size_t)MT * 32 * 4;
constexpr size_t WS_CDEC = WS_CS + (size_t)NCHUNK * HPN * 2;
constexpr size_t WS_ATT = WS_CDEC + 65536;
constexpr size_t WS_YSSD = WS_ATT + (size_t)MT * 1024 * 2;
constexpr size_t WS_HIST = WS_YSSD + (size_t)MT * 2048 * 2;
constexpr size_t WS_XTG = WS_HIST + 256ull * 3 * 4096 * 2;
constexpr size_t WS_BTG = WS_XTG + (size_t)NCHUNK * 2048 * 64 * 2;
constexpr size_t WS_ACTS = WS_BTG + (size_t)NCHUNK * 1024 * 64 * 2;
constexpr size_t WS_DTA = WS_ACTS + 256ull * DFF * 2;
constexpr size_t WS_ACSG = WS_DTA + (size_t)NCHUNK * 32 * 64 * 4;
constexpr size_t WS_END = WS_ACSG + (size_t)NCHUNK * 32 * 64 * 4;
static_assert(WS_END <= 1024ull * MiB, "workspace map must fit 1 GiB");

constexpr int LDS_CTL = 131072, LDS_BYTES = 131072 + 1024;
constexpr int AT_KROW = 272, AT_VROW = 144, AT_KSZ = 64 * AT_KROW, AT_VSZ = 128 * AT_VROW, AT_STAGE = AT_KSZ + AT_VSZ;
constexpr int SD_DT = 0, SD_ACS = 1024, SD_RS = 2048, SD_BT = 4096, SD_XT = SD_BT + 128 * 144, SD_CM = SD_XT + 256 * 144, SD_BM = SD_CM + 64 * 272, SD_END = SD_BM + 64 * 272;
static_assert(SD_END <= 131072 && 2 * AT_STAGE <= 131072, "lds");

struct Args { const float* in[26]; float* out; unsigned char* ws; int ph_lo, ph_hi; };

__device__ __forceinline__ unsigned pk_bf16(float lo, float hi) {
    typedef float f2 __attribute__((ext_vector_type(2))); typedef __bf16 b2 __attribute__((ext_vector_type(2)));
    f2 v = {lo, hi}; b2 b = __builtin_convertvector(v, b2); return __builtin_bit_cast(unsigned, b);
}
__device__ __forceinline__ float bf_lo(unsigned u) { return __uint_as_float(u << 16); }
__device__ __forceinline__ float bf_hi(unsigned u) { return __uint_as_float(u & 0xffff0000u); }
__device__ __forceinline__ float fexp2(float x) { return __builtin_amdgcn_exp2f(x); }
__device__ __forceinline__ float fexp(float x) { return __builtin_amdgcn_exp2f(x * 1.4426950408889634f); }
__device__ __forceinline__ float frcp(float x) { return __builtin_amdgcn_rcpf(x); }
__device__ __forceinline__ float silu_f(float x) { return x * frcp(1.0f + fexp(-x)); }
__device__ __forceinline__ float sigmoid_f(float x) { return frcp(1.0f + fexp(-x)); }
__device__ __forceinline__ float wave_sum(float v) {
#pragma unroll
    for (int o = 1; o < 64; o <<= 1) v += __shfl_xor(v, o);
    return v;
}
__device__ __forceinline__ int sig5(int i) { return (i & ~12) | ((i & 4) << 1) | ((i & 8) >> 1); }
__device__ __forceinline__ float rstd1(const float* rss, int row, float eps) { return 1.0f / sqrtf(rss[row] * (1.0f / 1024.0f) + eps); }
__device__ __forceinline__ float rstd_row(const float* part, int row, float eps) {
    const f32x4* p = (const f32x4*)(part + (size_t)row * 16);
    const f32x4 a = p[0], b = p[1], c = p[2], d = p[3];
    const float s = ((a.x + a.y) + (a.z + a.w)) + ((b.x + b.y) + (b.z + b.w)) + ((c.x + c.y) + (c.z + c.w)) + ((d.x + d.y) + (d.z + d.w));
    return 1.0f / sqrtf(s * (1.0f / 1024.0f) + eps);
}
__device__ __forceinline__ float max3f(float a, float b, float c) { float r; asm("v_max3_f32 %0, %1, %2, %3" : "=v"(r) : "v"(a), "v"(b), "v"(c)); return r; }
#define MFMA32(a, b, c) __builtin_amdgcn_mfma_f32_32x32x16_bf16((a), (b), (c), 0, 0, 0)

#define EPI_LOOP_ROWS _Pragma("unroll") for (int ai = 0; ai < 2; ++ai) _Pragma("unroll") for (int m = 0; m < 4; ++m)
#define EPI_LOOP_COLS _Pragma("unroll") for (int bj = 0; bj < 2; ++bj) _Pragma("unroll") for (int n = 0; n < 2; ++n)

struct EpiIn {
    static constexpr bool PERM = true, AFTER_DRAIN = false;
    const float* part; bf16_t *Q, *K, *VT, *Z, *XBC, *G; float* DT; float* out; int layer; bf16_t* HIST;
    __device__ __forceinline__ void operator()(const pg8::f32x4 (&acc)[2][2][4][2], const pg8::Unit& u, int wr, int wc, int fr, int fq) const {
        const int pn = u.pn; const int cb = pn * 256 + wc * 32 + 8 * fq;
        float rsv[2][4];
#pragma unroll
        for (int ai = 0; ai < 2; ++ai)
#pragma unroll
            for (int m = 0; m < 4; ++m) rsv[ai][m] = part[u.pm * 256 + ai * 128 + wr * 64 + m * 16 + fr];
#pragma unroll
        for (int ai = 0; ai < 2; ++ai)
#pragma unroll
            for (int m = 0; m < 4; ++m) rsv[ai][m] = 1.0f / sqrtf(rsv[ai][m] * (1.0f / 1024.0f) + 1e-6f);
        EPI_LOOP_ROWS {
            const int row = u.pm * 256 + ai * 128 + wr * 64 + m * 16 + fr;
            const float rs = rsv[ai][m];
#pragma unroll
            for (int bj = 0; bj < 2; ++bj) {
                const pg8::f32x4 v0 = acc[ai][bj][m][0] * rs, v1 = acc[ai][bj][m][1] * rs; const int col = cb + bj * 128;
                if (pn < 4) {
                    const float sc = 0.125f * 1.4426950408889634f;
                    u32x4 w; w.x = pk_bf16(v0[0] * sc, v0[1] * sc); w.y = pk_bf16(v0[2] * sc, v0[3] * sc); w.z = pk_bf16(v1[0] * sc, v1[1] * sc); w.w = pk_bf16(v1[2] * sc, v1[3] * sc);
                    *(u32x4*)(Q + (size_t)row * 1024 + col) = w;
                } else if (pn < 8) {
                    const int c = col - 1024; u32x4 w; w.x = pk_bf16(v0[0], v0[1]); w.y = pk_bf16(v0[2], v0[3]); w.z = pk_bf16(v1[0], v1[1]); w.w = pk_bf16(v1[2], v1[3]);
                    *(u32x4*)(K + (size_t)row * 1024 + c) = w;
                    float* o = nullptr;
                    if (row < SEQ) o = out + O_KP + ((size_t)layer * SEQ + row) * 1024 + c; else if (row < MV) o = out + O_KS + ((size_t)layer * NSMP + (row - SEQ)) * 1024 + c;
                    if (o) { *(pg8::f32x4*)o = v0; *(pg8::f32x4*)(o + 4) = v1; }
                } else if (pn < 12) {
                    const int c = col - 2048;
                    const unsigned w0 = pk_bf16(v0[0], v0[1]), w1 = pk_bf16(v0[2], v0[3]), w2 = pk_bf16(v1[0], v1[1]), w3 = pk_bf16(v1[2], v1[3]);
                    VT[(size_t)(c + 0) * MT + row] = (bf16_t)(w0 & 0xffffu); VT[(size_t)(c + 1) * MT + row] = (bf16_t)(w0 >> 16);
                    VT[(size_t)(c + 2) * MT + row] = (bf16_t)(w1 & 0xffffu); VT[(size_t)(c + 3) * MT + row] = (bf16_t)(w1 >> 16);
                    VT[(size_t)(c + 4) * MT + row] = (bf16_t)(w2 & 0xffffu); VT[(size_t)(c + 5) * MT + row] = (bf16_t)(w2 >> 16);
                    VT[(size_t)(c + 6) * MT + row] = (bf16_t)(w3 & 0xffffu); VT[(size_t)(c + 7) * MT + row] = (bf16_t)(w3 >> 16);
                    float* o = nullptr;
                    if (row < SEQ) o = out + O_VP + ((size_t)layer * SEQ + row) * 1024 + c; else if (row < MV) o = out + O_VS + ((size_t)layer * NSMP + (row - SEQ)) * 1024 + c;
                    if (o) { *(pg8::f32x4*)o = v0; *(pg8::f32x4*)(o + 4) = v1; }
                } else if (pn < 20) {
                    const int c = col - 3072; u32x4 w; w.x = pk_bf16(v0[0], v0[1]); w.y = pk_bf16(v0[2], v0[3]); w.z = pk_bf16(v1[0], v1[1]); w.w = pk_bf16(v1[2], v1[3]);
                    *(u32x4*)(Z + (size_t)row * 2048 + c) = w;
                } else if (pn < 36) {
                    const int c = col - 5120; u32x4 w; w.x = pk_bf16(v0[0], v0[1]); w.y = pk_bf16(v0[2], v0[3]); w.z = pk_bf16(v1[0], v1[1]); w.w = pk_bf16(v1[2], v1[3]);
                    *(u32x4*)(XBC + (size_t)row * 4096 + c) = w;
                    if (row < SEQ && (row & 63) >= 61) *(u32x4*)(HIST + ((size_t)(row >> 6) * 3 + ((row & 63) - 61)) * 4096 + c) = w;
                    float* o = nullptr;
                    if (row >= SEQ - 3 && row < SEQ) o = out + O_CP + ((size_t)layer * 3 + (row - (SEQ - 3))) * 4096 + c;
                    else if (row >= SEQ && row < MV) { const int s = row - SEQ, t = s & 15; if (t >= 13) o = out + O_CS + (((size_t)layer * 8 + (s >> 4)) * 3 + (t - 13)) * 4096 + c; }
                    if (o) { *(pg8::f32x4*)o = v0; *(pg8::f32x4*)(o + 4) = v1; }
                } else if (pn < 44) {
                    const int c = col - 9216; u32x4 w; w.x = pk_bf16(sigmoid_f(v0[0]), sigmoid_f(v0[1])); w.y = pk_bf16(sigmoid_f(v0[2]), sigmoid_f(v0[3]));
                    w.z = pk_bf16(sigmoid_f(v1[0]), sigmoid_f(v1[1])); w.w = pk_bf16(sigmoid_f(v1[2]), sigmoid_f(v1[3]));
                    *(u32x4*)(G + (size_t)row * 2048 + c) = w;
                } else {
                    const int c = col - 11264;
                    if (c < 32) { *(pg8::f32x4*)(DT + (size_t)row * 32 + c) = v0; *(pg8::f32x4*)(DT + (size_t)row * 32 + c + 4) = v1; }
                }
            }
        }
    }
};

struct EpiNull {
    static constexpr bool PERM = false, AFTER_DRAIN = false; float* sink;
    __device__ __forceinline__ void operator()(const pg8::f32x4 (&acc)[2][2][4][2], const pg8::Unit& u, int wr, int wc, int fr, int fq) const {
        pg8::f32x4 s = acc[0][0][0][0];
        EPI_LOOP_ROWS { EPI_LOOP_COLS { s += acc[ai][bj][m][n]; } }
        if (s[0] == 123456.789f) sink[0] = s[1] + s[2] + s[3];
    }
};
struct EpiBrA {
    static constexpr bool PERM = false, AFTER_DRAIN = false;
    const bf16_t* G; float* MF; int row0;
    __device__ __forceinline__ void operator()(const pg8::f32x4 (&acc)[2][2][4][2], const pg8::Unit& u, int wr, int wc, int fr, int fq) const {
        const int cb = u.pn * 256 + wc * 32 + 4 * fq;
        EPI_LOOP_ROWS { const int row = row0 + u.pm * 256 + ai * 128 + wr * 64 + m * 16 + fr;
            EPI_LOOP_COLS { const int col = cb + bj * 128 + n * 16; const u32x2 g = *(const u32x2*)(G + (size_t)row * 2048 + col);
                pg8::f32x4 v = acc[ai][bj][m][n]; v[0] *= bf_lo(g.x); v[1] *= bf_hi(g.x); v[2] *= bf_lo(g.y); v[3] *= bf_hi(g.y);
                *(pg8::f32x4*)(MF + (size_t)row * 1024 + col) = v; } }
    }
};
struct EpiBrB {
    static constexpr bool PERM = false, AFTER_DRAIN = false;
    const bf16_t* G; const float* MF; bf16_t* MB; int row0;
    __device__ __forceinline__ void operator()(const pg8::f32x4 (&acc)[2][2][4][2], const pg8::Unit& u, int wr, int wc, int fr, int fq) const {
        const int cb = u.pn * 256 + wc * 32 + 4 * fq;
        EPI_LOOP_ROWS { const int row = row0 + u.pm * 256 + ai * 128 + wr * 64 + m * 16 + fr;
            EPI_LOOP_COLS { const int col = cb + bj * 128 + n * 16; const u32x2 g = *(const u32x2*)(G + (size_t)row * 2048 + 1024 + col);
                const pg8::f32x4 a = acc[ai][bj][m][n]; const pg8::f32x4 o = *(const pg8::f32x4*)(MF + (size_t)row * 1024 + col);
                u32x2 w; w.x = pk_bf16(o[0] + a[0] * bf_lo(g.x), o[1] + a[1] * bf_hi(g.x)); w.y = pk_bf16(o[2] + a[2] * bf_lo(g.y), o[3] + a[3] * bf_hi(g.y));
                *(u32x2*)(MB + (size_t)row * 1024 + col) = w; } }
    }
};
struct EpiRes {
    static constexpr bool PERM = false, AFTER_DRAIN = false;
    float* X; bf16_t* XB; float* part; int row0;
    __device__ __forceinline__ void operator()(const pg8::f32x4 (&acc)[2][2][4][2], const pg8::Unit& u, int wr, int wc, int fr, int fq) const {
        const int cb = u.pn * 256 + wc * 32 + 4 * fq;
        EPI_LOOP_ROWS { const int row = row0 + u.pm * 256 + ai * 128 + wr * 64 + m * 16 + fr; float ss = 0.f;
            EPI_LOOP_COLS { const int col = cb + bj * 128 + n * 16; float* xp = X + (size_t)row * 1024 + col;
                const pg8::f32x4 x = *(const pg8::f32x4*)xp + acc[ai][bj][m][n];
                *(pg8::f32x4*)xp = x; u32x2 w; w.x = pk_bf16(x[0], x[1]); w.y = pk_bf16(x[2], x[3]); *(u32x2*)(XB + (size_t)row * 1024 + col) = w;
                ss += (x[0] * x[0] + x[1] * x[1]) + (x[2] * x[2] + x[3] * x[3]); }
            ss += __shfl_xor(ss, 16); ss += __shfl_xor(ss, 32);
            if (fq == 0) atomicAdd(part + row, ss); }
    }
};
struct EpiGU {
    static constexpr bool PERM = true, AFTER_DRAIN = false;
    const float* part; bf16_t* ACT; int row0; int act_sub;
    __device__ __forceinline__ void operator()(const pg8::f32x4 (&acc)[2][2][4][2], const pg8::Unit& u, int wr, int wc, int fr, int fq) const {
        const int cb = u.pn * 128 + wc * 32 + 8 * fq;
        float rsv[2][4];
#pragma unroll
        for (int ai = 0; ai < 2; ++ai)
#pragma unroll
            for (int m = 0; m < 4; ++m) rsv[ai][m] = part[row0 + u.pm * 256 + ai * 128 + wr * 64 + m * 16 + fr];
#pragma unroll
        for (int ai = 0; ai < 2; ++ai)
#pragma unroll
            for (int m = 0; m < 4; ++m) rsv[ai][m] = 1.0f / sqrtf(rsv[ai][m] * (1.0f / 1024.0f) + 1e-6f);
        EPI_LOOP_ROWS { const int row = row0 - act_sub + u.pm * 256 + ai * 128 + wr * 64 + m * 16 + fr; const float rs = rsv[ai][m];
            const pg8::f32x4 g0 = acc[ai][0][m][0] * rs, g1 = acc[ai][0][m][1] * rs, u0 = acc[ai][1][m][0] * rs, u1 = acc[ai][1][m][1] * rs;
            u32x4 w; w.x = pk_bf16(silu_f(g0[0]) * u0[0], silu_f(g0[1]) * u0[1]); w.y = pk_bf16(silu_f(g0[2]) * u0[2], silu_f(g0[3]) * u0[3]);
            w.z = pk_bf16(silu_f(g1[0]) * u1[0], silu_f(g1[1]) * u1[1]); w.w = pk_bf16(silu_f(g1[2]) * u1[2], silu_f(g1[3]) * u1[3]);
            *(u32x4*)(ACT + (size_t)row * DFF + cb) = w; }
    }
};

struct Ctx {
    LAS unsigned char* lds; int tid, lane, wid, G, bid;
    const float* in[26]; float* out; unsigned char* ws;
};
#define WSP(T, off) ((T*)(C.ws + (off)))

struct TItem { const float* W; int N, k0, n0; bf16_t* WT; size_t dst_row0; int Kd; const float* kscale; };
struct TRegs { float tv[32]; f32x4 s0, s1; };
__device__ __forceinline__ void tr_load(const TItem& t, TRegs& r, int lane) {
#pragma unroll
    for (int i = 0; i < 32; ++i) r.tv[i] = t.W[(size_t)(t.k0 + 2 * i + (lane >> 5)) * t.N + t.n0 + (lane & 31)];
    if (t.kscale) { r.s0 = *(const f32x4*)(t.kscale + t.k0 + 8 * (lane & 7)); r.s1 = *(const f32x4*)(t.kscale + t.k0 + 8 * (lane & 7) + 4); }
    else { r.s0 = (f32x4){1.f, 1.f, 1.f, 1.f}; r.s1 = r.s0; }
}
__device__ __forceinline__ void tr_finish(const TItem& t, const TRegs& r, LAS float* scr, int lane) {
#pragma unroll
    for (int i = 0; i < 32; ++i) scr[(2 * i + (lane >> 5)) * 33 + (lane & 31)] = r.tv[i];
    asm volatile("s_waitcnt lgkmcnt(0)" ::: "memory");
    const int c = lane & 7;
#pragma unroll
    for (int j = 0; j < 4; ++j) { const int n = (lane >> 3) + 8 * j; const LAS float* s = scr + (8 * c) * 33 + n;
        u32x4 o; o.x = pk_bf16(s[0 * 33] * r.s0.x, s[1 * 33] * r.s0.y); o.y = pk_bf16(s[2 * 33] * r.s0.z, s[3 * 33] * r.s0.w);
        o.z = pk_bf16(s[4 * 33] * r.s1.x, s[5 * 33] * r.s1.y); o.w = pk_bf16(s[6 * 33] * r.s1.z, s[7 * 33] * r.s1.w);
        *(u32x4*)(t.WT + (t.dst_row0 + n) * (size_t)t.Kd + t.k0 + 8 * c) = o; }
    asm volatile("s_waitcnt lgkmcnt(0)" ::: "memory");
}
__device__ __forceinline__ bool p0_item(const Ctx& C, int it, TItem& t) {
    constexpr int I_IN = 16 * 353, I_BA = 16 * 32, I_BS = 32 * 32, I_OUT = 16 * 32, I_GU = 16 * 176, I_D = 44 * 32, I_L = I_IN + I_BA + I_BS + I_OUT + I_GU + I_D;
    if (it >= 2 * I_L) return false;
    const int L = it / I_L; int r = it % I_L; t.kscale = nullptr;
    if (r < I_IN) { const int kb = r / 353, nb = r % 353, n0 = 32 * nb;
        t.W = C.in[7] + (size_t)L * 1024 * NIN; t.N = NIN; t.k0 = 64 * kb; t.n0 = n0; t.WT = WSP(bf16_t, WS_WIN + L * SZ_WIN);
        t.dst_row0 = n0 < 9216 ? n0 : (n0 < 9248 ? 11264 + (n0 - 9216) : 9216 + (n0 - 9248)); t.Kd = 1024; t.kscale = C.in[6] + L * 1024; return true; }
    r -= I_IN;
    if (r < I_BA) { t.W = C.in[19] + (size_t)L * 1024 * 1024; t.N = 1024; t.k0 = 64 * (r / 32); t.n0 = 32 * (r % 32); t.WT = WSP(bf16_t, WS_WBA + L * SZ_WBA); t.dst_row0 = t.n0; t.Kd = 1024; return true; }
    r -= I_BA;
    if (r < I_BS) { t.W = C.in[20] + (size_t)L * 2048 * 1024; t.N = 1024; t.k0 = 64 * (r / 32); t.n0 = 32 * (r % 32); t.WT = WSP(bf16_t, WS_WBS + L * SZ_WBS); t.dst_row0 = t.n0; t.Kd = 2048; return true; }
    r -= I_BS;
    if (r < I_OUT) { t.W = C.in[21] + (size_t)L * 1024 * 1024; t.N = 1024; t.k0 = 64 * (r / 32); t.n0 = 32 * (r % 32); t.WT = WSP(bf16_t, WS_WOUT + L * SZ_WOUT); t.dst_row0 = t.n0; t.Kd = 1024; return true; }
    r -= I_OUT;
    if (r < I_GU) { const int kb = r / 176, nb = r % 176, n0 = 32 * nb; const int ch = n0 % DFF;
        t.W = C.in[23] + (size_t)L * 1024 * 5632; t.N = 5632; t.k0 = 64 * kb; t.n0 = n0; t.WT = WSP(bf16_t, WS_WGU + L * SZ_WGU);
        t.dst_row0 = 256 * (ch / 128) + (ch % 128) + (n0 >= DFF ? 128 : 0); t.Kd = 1024; t.kscale = C.in[22] + L * 1024; return true; }
    r -= I_GU;
    t.W = C.in[24] + (size_t)L * DFF * 1024; t.N = 1024; t.k0 = 64 * (r / 32); t.n0 = 32 * (r % 32); t.WT = WSP(bf16_t, WS_WD + L * SZ_WD); t.dst_row0 = t.n0; t.Kd = DFF; return true;
}

__device__ __forceinline__ void phase_p0(Ctx& C) {
    LAS float* scr = (LAS float*)(C.lds + C.wid * 8704);
    const int gw = C.bid * 8 + C.wid, NGW = C.G * 8;
    {   TItem cur, nxt; TRegs ra, rb; int it = gw;
        bool have = p0_item(C, it, cur); if (have) tr_load(cur, ra, C.lane);
        while (have) { it += NGW; const bool hn = p0_item(C, it, nxt); if (hn) tr_load(nxt, rb, C.lane);
            tr_finish(cur, ra, scr, C.lane); cur = nxt; ra = rb; have = hn; } }
    {   const int nz = 2 * (NINP - NIN) * 1024 / 8;
        for (int i = C.bid * 512 + C.tid; i < nz; i += C.G * 512) { const int L = i / ((NINP - NIN) * 128), r = i % ((NINP - NIN) * 128);
            *(u32x4*)(WSP(bf16_t, WS_WIN + L * SZ_WIN) + (size_t)NIN * 1024 + (size_t)r * 8) = (u32x4){0u, 0u, 0u, 0u}; } }
    float* X = WSP(float, WS_X); bf16_t* XB = WSP(bf16_t, WS_XB); float* PART = WSP(float, WS_PART);
    for (int mrow = gw; mrow < MT; mrow += NGW) {
        f32x4 v[4]; float ss = 0.f;
#pragma unroll
        for (int j = 0; j < 4; ++j) {
            if (mrow < SEQ) v[j] = *(const f32x4*)(C.in[0] + (size_t)mrow * 1024 + 4 * C.lane + 256 * j);
            else if (mrow < MV) v[j] = *(const f32x4*)(C.in[1] + (size_t)(mrow - SEQ) * 1024 + 4 * C.lane + 256 * j);
            else v[j] = (f32x4){0.f, 0.f, 0.f, 0.f};
            ss += (v[j].x * v[j].x + v[j].y * v[j].y) + (v[j].z * v[j].z + v[j].w * v[j].w);
            *(f32x4*)(X + (size_t)mrow * 1024 + 4 * C.lane + 256 * j) = v[j];
            u32x2 w; w.x = pk_bf16(v[j].x, v[j].y); w.y = pk_bf16(v[j].z, v[j].w);
            *(u32x2*)(XB + (size_t)mrow * 1024 + 4 * C.lane + 256 * j) = w;
        }
        ss = wave_sum(ss);
        if (C.lane < 5) PART[(size_t)C.lane * MT + mrow] = (C.lane == 0) ? ss : 0.f;
    }
}

__device__ __forceinline__ void cache_convert(Ctx& C, int L) {
    const float* ck = C.in[2] + (size_t)L * 8 * PAST * 1024; bf16_t* KC = WSP(bf16_t, WS_KC);
    const int ntask = 8 * PAST * 1024 / 8;
    {   const int stride = C.G * 512;
        for (int i0 = C.bid * 512 + C.tid; i0 < ntask; i0 += 4 * stride) { f32x4 a[4], b[4];
#pragma unroll
            for (int j = 0; j < 4; ++j) { const int i = i0 + j * stride; if (i < ntask) { a[j] = *(const f32x4*)(ck + (size_t)i * 8); b[j] = *(const f32x4*)(ck + (size_t)i * 8 + 4); } }
#pragma unroll
            for (int j = 0; j < 4; ++j) { const int i = i0 + j * stride; if (i < ntask) { u32x4 o; o.x = pk_bf16(a[j].x, a[j].y); o.y = pk_bf16(a[j].z, a[j].w); o.z = pk_bf16(b[j].x, b[j].y); o.w = pk_bf16(b[j].z, b[j].w);
                *(u32x4*)(KC + (size_t)i * 8) = o; } } } }
    LAS float* scr = (LAS float*)(C.lds + C.wid * 8704);
    const int gw = C.bid * 8 + C.wid, NGW = C.G * 8;
    {   TItem cur, nxt; TRegs ra, rb; int it = gw;
#define CV_ITEM(IT, T) ((IT) < 8 * 2048 ? ((T).W = C.in[3] + ((size_t)L * 8 + (IT) / 2048) * PAST * 1024, (T).N = 1024, (T).k0 = 64 * (((IT) % 2048) / 32), (T).n0 = 32 * ((IT) % 32), \
            (T).WT = WSP(bf16_t, WS_VTC) + (size_t)((IT) / 2048) * 1024 * PAST, (T).dst_row0 = (size_t)(T).n0, (T).Kd = PAST, (T).kscale = nullptr, true) : false)
        bool have = CV_ITEM(it, cur); if (have) tr_load(cur, ra, C.lane);
        while (have) { it += NGW; const bool hn = CV_ITEM(it, nxt); if (hn) tr_load(nxt, rb, C.lane);
            tr_finish(cur, ra, scr, C.lane); cur = nxt; ra = rb; have = hn; }
#undef CV_ITEM
    }
}

struct ChunkInfo { int base, Lc, mode; const float* hist; };
__device__ __forceinline__ ChunkInfo chunk_info(const Ctx& C, int L, int c) {
    ChunkInfo ci;
    if (c < 256) { ci.base = 64 * c; ci.Lc = 64; ci.mode = (c == 0) ? 1 : 0; ci.hist = nullptr; }
    else { const int b = c - 256; ci.base = SEQ + 16 * b; ci.Lc = 16; ci.mode = 2; ci.hist = C.in[4] + ((size_t)L * 8 + b) * 3 * CONVD; }
    return ci;
}
__device__ __forceinline__ void conv_t8(const bf16_t* XBC, const ChunkInfo& ci, const float* cw, const float* cbias, int col, int l0, float (&o0)[8], float (&o1)[8]) {
    float i0[11], i1[11];
#pragma unroll
    for (int i = 0; i < 11; ++i) { const int rr = l0 - 3 + i;
        if (rr >= 0 || ci.mode == 0) { const unsigned v = *(const unsigned*)(XBC + (size_t)(ci.base + rr) * 4096 + col); i0[i] = bf_lo(v); i1[i] = bf_hi(v); }
        else if (ci.mode == 1) { i0[i] = 0.f; i1[i] = 0.f; }
        else { const float* hp = ci.hist + (size_t)(3 + rr) * 4096 + col; i0[i] = hp[0]; i1[i] = hp[1]; } }
    float w0[4], w1[4];
#pragma unroll
    for (int j = 0; j < 4; ++j) { w0[j] = cw[j * 4096 + col]; w1[j] = cw[j * 4096 + col + 1]; }
    const float b0 = cbias[col], b1 = cbias[col + 1];
#pragma unroll
    for (int k = 0; k < 8; ++k) { float a0 = b0, a1 = b1;
#pragma unroll
        for (int j = 0; j < 4; ++j) { a0 += w0[j] * i0[k + j]; a1 += w1[j] * i1[k + j]; }
        o0[k] = silu_f(a0); o1[k] = silu_f(a1); }
}
__device__ __forceinline__ void conv_n8(const bf16_t* XBC, const ChunkInfo& ci, const float* cw, const float* cbias, int col, int l, float (&o)[8]) {
    { const f32x4 b0 = *(const f32x4*)(cbias + col), b1 = *(const f32x4*)(cbias + col + 4);
      o[0] = b0.x; o[1] = b0.y; o[2] = b0.z; o[3] = b0.w; o[4] = b1.x; o[5] = b1.y; o[6] = b1.z; o[7] = b1.w; }
#pragma unroll
    for (int j = 0; j < 4; ++j) { const int rr = l - 3 + j; float x[8];
        if (rr >= 0 || ci.mode == 0) { const u32x4 v = *(const u32x4*)(XBC + (size_t)(ci.base + rr) * 4096 + col);
            x[0] = bf_lo(v.x); x[1] = bf_hi(v.x); x[2] = bf_lo(v.y); x[3] = bf_hi(v.y); x[4] = bf_lo(v.z); x[5] = bf_hi(v.z); x[6] = bf_lo(v.w); x[7] = bf_hi(v.w); }
        else if (ci.mode == 1) {
#pragma unroll
            for (int q = 0; q < 8; ++q) x[q] = 0.f; }
        else { const float* hp = ci.hist + (size_t)(3 + rr) * 4096 + col; const f32x4 h0 = *(const f32x4*)hp, h1 = *(const f32x4*)(hp + 4);
            x[0] = h0.x; x[1] = h0.y; x[2] = h0.z; x[3] = h0.w; x[4] = h1.x; x[5] = h1.y; x[6] = h1.z; x[7] = h1.w; }
        const f32x4 wa = *(const f32x4*)(cw + j * 4096 + col), wb = *(const f32x4*)(cw + j * 4096 + col + 4);
        o[0] += wa.x * x[0]; o[1] += wa.y * x[1]; o[2] += wa.z * x[2]; o[3] += wa.w * x[3]; o[4] += wb.x * x[4]; o[5] += wb.y * x[5]; o[6] += wb.z * x[6]; o[7] += wb.w * x[7]; }
#pragma unroll
    for (int q = 0; q < 8; ++q) o[q] = silu_f(o[q]);
}
__device__ __forceinline__ void ssd_dt_acs(Ctx& C, int L, const ChunkInfo& ci, int c, int g, bool write_cdec) {
    if (C.wid < 4) { const int h = 4 * g + C.wid, l = C.lane;
        const float raw = WSP(const float, WS_DT)[(size_t)(ci.base + l) * 32 + h] + C.in[15][L * 32 + h];
        float dt = raw > 20.f ? raw : log1pf(expf(raw)); if (l >= ci.Lc) dt = 0.f;
        const float A = -expf(C.in[16][L * 32 + h]); float a = dt * A;
#pragma unroll
        for (int o = 1; o < 64; o <<= 1) { const float t = __shfl_up(a, o); if (l >= o) a += t; }
        ((LAS float*)(C.lds + SD_DT))[C.wid * 64 + l] = dt; ((LAS float*)(C.lds + SD_ACS))[C.wid * 64 + l] = a;
        if (write_cdec && l == 63) WSP(float, WS_CDEC)[c * 32 + h] = expf(a);
    }
}
__device__ __forceinline__ void st8_bf16(LAS unsigned char* p, const float (&o)[8]) {
    u32x4 w; w.x = pk_bf16(o[0], o[1]); w.y = pk_bf16(o[2], o[3]); w.z = pk_bf16(o[4], o[5]); w.w = pk_bf16(o[6], o[7]); *(LAS u32x4*)p = w;
}

__device__ __forceinline__ void conv_unit(Ctx& C, int L, int c, int slab) {
    const ChunkInfo ci = chunk_info(C, L, c);
    bf16_t* XBC = WSP(bf16_t, WS_XBC); const bf16_t* HIST = WSP(const bf16_t, WS_HIST);
    const float* cw = C.in[13] + (size_t)L * 4 * CONVD; const float* cbias = C.in[14] + (size_t)L * CONVD;
    const int col0 = slab * 512;
    {   u32x4 v[8];
#pragma unroll
        for (int k = 0; k < 8; ++k) { const int idx = C.tid + 512 * k; v[k] = *(const u32x4*)(XBC + (size_t)(ci.base + (idx >> 6)) * 4096 + col0 + (idx & 63) * 8); }
        if (C.tid < 192) { const int r = C.tid >> 6, c16 = C.tid & 63; u32x4 hv;
            if (ci.mode == 1) hv = (u32x4){0u, 0u, 0u, 0u};
            else if (ci.mode == 0) hv = *(const u32x4*)(HIST + ((size_t)(c - 1) * 3 + r) * 4096 + col0 + c16 * 8);
            else { const float* hp = ci.hist + (size_t)r * 4096 + col0 + c16 * 8; const f32x4 a = *(const f32x4*)hp, b = *(const f32x4*)(hp + 4);
                hv.x = pk_bf16(a.x, a.y); hv.y = pk_bf16(a.z, a.w); hv.z = pk_bf16(b.x, b.y); hv.w = pk_bf16(b.z, b.w); }
            *(LAS u32x4*)(C.lds + r * 1024 + c16 * 16) = hv; }
#pragma unroll
        for (int k = 0; k < 8; ++k) { const int idx = C.tid + 512 * k; *(LAS u32x4*)(C.lds + (3 + (idx >> 6)) * 1024 + (idx & 63) * 16) = v[k]; }
    }
    __syncthreads();
#pragma unroll 1
    for (int i = 0; i < 4; ++i) { const int task = C.tid + 512 * i, p = task & 255, lb = task >> 8, l0 = 8 * lb, col = col0 + 2 * p;
        float i0[11], i1[11];
#pragma unroll
        for (int k = 0; k < 11; ++k) { const unsigned v = *(const LAS unsigned*)(C.lds + (l0 + k) * 1024 + p * 4); i0[k] = bf_lo(v); i1[k] = bf_hi(v); }
        float w0[4], w1[4];
#pragma unroll
        for (int j = 0; j < 4; ++j) { const float2 w = *(const float2*)(cw + j * 4096 + col); w0[j] = w.x; w1[j] = w.y; }
        const float2 bb = *(const float2*)(cbias + col);
        float o0[8], o1[8];
#pragma unroll
        for (int k = 0; k < 8; ++k) { float a0 = bb.x, a1 = bb.y;
#pragma unroll
            for (int j = 0; j < 4; ++j) { a0 += w0[j] * i0[k + j]; a1 += w1[j] * i1[k + j]; }
            o0[k] = silu_f(a0); o1[k] = silu_f(a1); }
        if (slab < 6) {
            const int ch_ = (slab < 4) ? col : col - 2048;
            bf16_t* dst = ((slab < 4) ? WSP(bf16_t, WS_XTG) + (size_t)c * 2048 * 64 : WSP(bf16_t, WS_BTG) + (size_t)c * 1024 * 64) + ((((size_t)(ch_ >> 5)) * 4 + (lb >> 1)) * 64 + (lb & 1) * 32 + (ch_ & 31)) * 8;
            u32x4 w; w.x = pk_bf16(o0[0], o0[1]); w.y = pk_bf16(o0[2], o0[3]); w.z = pk_bf16(o0[4], o0[5]); w.w = pk_bf16(o0[6], o0[7]); *(u32x4*)dst = w;
            w.x = pk_bf16(o1[0], o1[1]); w.y = pk_bf16(o1[2], o1[3]); w.z = pk_bf16(o1[4], o1[5]); w.w = pk_bf16(o1[6], o1[7]); *(u32x4*)(dst + 8) = w;
        }
        if (slab >= 4) {
#pragma unroll
            for (int k = 0; k < 8; ++k) if (l0 + k < ci.Lc) *(unsigned*)(XBC + (size_t)(ci.base + l0 + k) * 4096 + col) = pk_bf16(o0[k], o1[k]);
        }
    }
    __syncthreads();
}

__device__ __forceinline__ void ssd_s1_wave(Ctx& C, int L, int c, int h) {
    const ChunkInfo ci = chunk_info(C, L, c);
    const int l = C.lane, q32 = C.lane & 31, hi = C.lane >> 5, g = h >> 2;
    const float raw = WSP(const float, WS_DT)[(size_t)(ci.base + l) * 32 + h] + C.in[15][L * 32 + h];
    float dt = raw > 20.f ? raw : log1pf(expf(raw)); if (l >= ci.Lc) dt = 0.f;
    const float A = -expf(C.in[16][L * 32 + h]); float a = dt * A;
#pragma unroll
    for (int o = 1; o < 64; o <<= 1) { const float t = __shfl_up(a, o); if (l >= o) a += t; }
    WSP(float, WS_DTA)[((size_t)c * 32 + h) * 64 + l] = dt; WSP(float, WS_ACSG)[((size_t)c * 32 + h) * 64 + l] = a;
    const float aend = __shfl(a, 63);
    const float w = dt * fexp(aend - a);
    if (l == 63) WSP(float, WS_CDEC)[c * 32 + h] = expf(a);
    const bf16_t* xt = WSP(const bf16_t, WS_XTG) + (size_t)c * 2048 * 64 + ((size_t)(2 * h) * 4 * 64 + C.lane) * 8;
    const bf16_t* bt = WSP(const bf16_t, WS_BTG) + (size_t)c * 1024 * 64 + ((size_t)(4 * g) * 4 * 64 + C.lane) * 8;
    f32x16 acc[2][4];
#pragma unroll
    for (int ph = 0; ph < 2; ++ph)
#pragma unroll
        for (int nt = 0; nt < 4; ++nt) acc[ph][nt] = (f32x16){};
#pragma unroll
    for (int ks = 0; ks < 4; ++ks) {
        float wv[8];
#pragma unroll
        for (int j = 0; j < 8; ++j) wv[j] = __shfl(w, 16 * ks + 8 * hi + j);
        bf16x8 bfr[2];
#pragma unroll
        for (int ph = 0; ph < 2; ++ph) { const u32x4 r = *(const u32x4*)(xt + (ph * 4 + ks) * 512);
            u32x4 o; o.x = pk_bf16(bf_lo(r.x) * wv[0], bf_hi(r.x) * wv[1]); o.y = pk_bf16(bf_lo(r.y) * wv[2], bf_hi(r.y) * wv[3]);
            o.z = pk_bf16(bf_lo(r.z) * wv[4], bf_hi(r.z) * wv[5]); o.w = pk_bf16(bf_lo(r.w) * wv[6], bf_hi(r.w) * wv[7]); bfr[ph] = __builtin_bit_cast(bf16x8, o); }
#pragma unroll
        for (int nt = 0; nt < 4; ++nt) { const bf16x8 afr = *(const bf16x8*)(bt + (nt * 4 + ks) * 512);
            acc[0][nt] = MFMA32(afr, bfr[0], acc[0][nt]); acc[1][nt] = MFMA32(afr, bfr[1], acc[1][nt]); }
    }
#pragma unroll
    for (int ph = 0; ph < 2; ++ph) { bf16_t* dst = WSP(bf16_t, WS_CS) + ((size_t)c * 32 + h) * 8192;
#pragma unroll
        for (int nt = 0; nt < 4; ++nt)
#pragma unroll
            for (int rq = 0; rq < 4; ++rq) { u32x2 o; o.x = pk_bf16(acc[ph][nt][4 * rq], acc[ph][nt][4 * rq + 1]); o.y = pk_bf16(acc[ph][nt][4 * rq + 2], acc[ph][nt][4 * rq + 3]);
                *(u32x2*)(dst + ((ph * 8 + 2 * nt + (rq >> 1)) * 64 + (rq & 1) * 32 + q32) * 8 + 4 * hi) = o; } }
}

__device__ __forceinline__ void ssd_s1_unit(Ctx& C, int L, int c, int g) {
    const ChunkInfo ci = chunk_info(C, L, c);
    const bf16_t* XBC = WSP(const bf16_t, WS_XBC); const float* cw = C.in[13] + (size_t)L * 4 * CONVD; const float* cbias = C.in[14] + (size_t)L * CONVD;
    ssd_dt_acs(C, L, ci, c, g, true);
    __syncthreads();
    {
        const int cp = C.tid & 63, lb = C.tid >> 6; float o0[8], o1[8];
        conv_t8(XBC, ci, cw, cbias, 2048 + g * 128 + 2 * cp, 8 * lb, o0, o1);
        st8_bf16(C.lds + SD_BT + (2 * cp) * 144 + lb * 16, o0); st8_bf16(C.lds + SD_BT + (2 * cp + 1) * 144 + lb * 16, o1);
    }
#pragma unroll 1
    for (int i = 0; i < 2; ++i) {
        const int task = C.tid + 512 * i, cp = task & 127, lb = task >> 7, hh = cp >> 5; float o0[8], o1[8];
        conv_t8(XBC, ci, cw, cbias, g * 256 + 2 * cp, 8 * lb, o0, o1);
        const LAS float* dts = (const LAS float*)(C.lds + SD_DT) + hh * 64 + 8 * lb; const LAS float* acs = (const LAS float*)(C.lds + SD_ACS) + hh * 64;
        const float aend = acs[63];
#pragma unroll
        for (int k = 0; k < 8; ++k) { const float w = dts[k] * fexp(aend - acs[8 * lb + k]); o0[k] *= w; o1[k] *= w; }
        st8_bf16(C.lds + SD_XT + (2 * cp) * 144 + lb * 16, o0); st8_bf16(C.lds + SD_XT + (2 * cp + 1) * 144 + lb * 16, o1);
    }
    __syncthreads();
    {   const int hh = C.wid >> 1, ph = C.wid & 1, q32 = C.lane & 31, hi = C.lane >> 5, h = 4 * g + hh;
        f32x16 acc[4];
#pragma unroll
        for (int nt = 0; nt < 4; ++nt) acc[nt] = (f32x16){};
#pragma unroll
        for (int ks = 0; ks < 4; ++ks) { const bf16x8 bfr = *(const LAS bf16x8*)(C.lds + SD_XT + (hh * 64 + ph * 32 + q32) * 144 + ks * 32 + hi * 16);
#pragma unroll
            for (int nt = 0; nt < 4; ++nt) { const bf16x8 afr = *(const LAS bf16x8*)(C.lds + SD_BT + (nt * 32 + q32) * 144 + ks * 32 + hi * 16); acc[nt] = MFMA32(afr, bfr, acc[nt]); } }
        bf16_t* dst = WSP(bf16_t, WS_CS) + (((size_t)c * 32 + h) * 64 + ph * 32 + q32) * 128;
#pragma unroll
        for (int nt = 0; nt < 4; ++nt)
#pragma unroll
            for (int rq = 0; rq < 4; ++rq) { u32x2 w; w.x = pk_bf16(acc[nt][4 * rq], acc[nt][4 * rq + 1]); w.y = pk_bf16(acc[nt][4 * rq + 2], acc[nt][4 * rq + 3]);
                *(u32x2*)(dst + 32 * nt + 8 * rq + 4 * hi) = w; }
    }
    __syncthreads();
}

__device__ __forceinline__ void ssd_scan(Ctx& C, int L) {
    bf16_t* CS = WSP(bf16_t, WS_CS); const float* CDEC = WSP(const float, WS_CDEC);
    for (int gid = C.bid * 512 + C.tid; gid < (int)(HPN / 2); gid += C.G * 512) {
        const int h = gid >> 12; float s0 = 0.f, s1 = 0.f; unsigned* p = (unsigned*)CS + gid;
#pragma unroll 1
        for (int c0 = 0; c0 < 256; c0 += 16) { unsigned v[16]; float d[16];
#pragma unroll
            for (int j = 0; j < 16; ++j) { v[j] = p[(size_t)(c0 + j) * (HPN / 2)]; d[j] = CDEC[(c0 + j) * 32 + h]; }
#pragma unroll
            for (int j = 0; j < 16; ++j) { p[(size_t)(c0 + j) * (HPN / 2)] = pk_bf16(s0, s1); s0 = d[j] * s0 + bf_lo(v[j]); s1 = d[j] * s1 + bf_hi(v[j]); } }
        const int e_ = 2 * (gid & 4095), lane_ = (e_ >> 3) & 63;
        const size_t nat = (size_t)h * 8192 + (size_t)(32 * (e_ >> 12) + (lane_ & 31)) * 128 + 16 * ((e_ >> 9) & 7) + 8 * (lane_ >> 5) + (e_ & 7);
        float* o = C.out + O_SP + (size_t)L * HPN + nat; o[0] = s0; o[1] = s1;
#pragma unroll
        for (int b = 0; b < 8; ++b) { const float* ip = C.in[5] + ((size_t)L * 8 + b) * HPN + nat; const float i0 = ip[0], i1 = ip[1];
            unsigned* q = p + (size_t)(256 + b) * (HPN / 2); const unsigned v = *q; const float d = CDEC[(256 + b) * 32 + h];
            *q = pk_bf16(i0, i1);
            float* os = C.out + O_SS + ((size_t)L * 8 + b) * HPN + nat; os[0] = d * i0 + bf_lo(v); os[1] = d * i1 + bf_hi(v); }
    }
}

__device__ __forceinline__ void ssd_s3_unit(Ctx& C, int L, int c, int g) {
    const ChunkInfo ci = chunk_info(C, L, c);
    const bf16_t* XBC = WSP(const bf16_t, WS_XBC); const float* cw = C.in[13] + (size_t)L * 4 * CONVD; const float* cbias = C.in[14] + (size_t)L * CONVD;
    const int hh = C.wid >> 1, ph = C.wid & 1, q32 = C.lane & 31, hi = C.lane >> 5, h = 4 * g + hh;
    const int chb = h * 64 + ph * 32 + 4 * hi;
    bf16x8 pf[8], xf[3][2]; u32x2 zf[2][4];
    {   const bf16_t* prev = WSP(const bf16_t, WS_CS) + ((size_t)c * 32 + h) * 8192 + ((size_t)(ph * 8) * 64 + C.lane) * 8;
#pragma unroll
        for (int ks = 0; ks < 8; ++ks) pf[ks] = *(const bf16x8*)(prev + ks * 512);
#pragma unroll
        for (int tile = 0; tile < 3; ++tile)
#pragma unroll
            for (int sp = 0; sp < 2; ++sp) xf[tile][sp] = *(const bf16x8*)(WSP(const bf16_t, WS_XTG) + (size_t)c * 2048 * 64 + ((size_t)((2 * h + ph) * 4 + 2 * (tile >> 1) + sp) * 64 + C.lane) * 8);
#pragma unroll
        for (int lh = 0; lh < 2; ++lh)
#pragma unroll
            for (int rq = 0; rq < 4; ++rq) zf[lh][rq] = *(const u32x2*)(WSP(const bf16_t, WS_Z) + (size_t)(ci.base + lh * 32 + q32) * 2048 + chb + 8 * rq);
    }
    if (C.tid < 256) { const size_t o = ((size_t)c * 32 + 4 * g + (C.tid >> 6)) * 64 + (C.tid & 63); const float dtv = WSP(const float, WS_DTA)[o], av = WSP(const float, WS_ACSG)[o];
        ((LAS float*)(C.lds + SD_DT))[C.tid] = dtv; ((LAS float*)(C.lds + SD_ACS))[C.tid] = av; }
#pragma unroll
    for (int i = 0; i < 2; ++i) {
        const int task = C.tid + 512 * i, c8 = task & 15, l = task >> 4;
        const u32x4 vc = *(const u32x4*)(XBC + (size_t)(ci.base + l) * 4096 + 3072 + g * 128 + c8 * 8), vb = *(const u32x4*)(XBC + (size_t)(ci.base + l) * 4096 + 2048 + g * 128 + c8 * 8);
        *(LAS u32x4*)(C.lds + SD_CM + l * 272 + c8 * 16) = vc; *(LAS u32x4*)(C.lds + SD_BM + ((l & 32) | sig5(l & 31)) * 272 + c8 * 16) = vb;
    }
    __syncthreads();
    const LAS float* dts = (const LAS float*)(C.lds + SD_DT) + hh * 64; const LAS float* acs = (const LAS float*)(C.lds + SD_ACS) + hh * 64;
    f32x16 acc[2]; acc[0] = (f32x16){}; acc[1] = (f32x16){};
    {
#pragma unroll
        for (int ks = 0; ks < 8; ++ks) { const bf16x8 afr = pf[ks];
#pragma unroll
            for (int lh = 0; lh < 2; ++lh) { const bf16x8 bfr = *(const LAS bf16x8*)(C.lds + SD_CM + (lh * 32 + q32) * 272 + ks * 32 + hi * 16); acc[lh] = MFMA32(afr, bfr, acc[lh]); } }
#pragma unroll
        for (int lh = 0; lh < 2; ++lh) { const float e = fexp(acs[lh * 32 + q32]);
#pragma unroll
            for (int r = 0; r < 16; ++r) acc[lh][r] *= e; }
    }
    const float Dh = C.in[17][L * 32 + h];
#pragma unroll
    for (int tile = 0; tile < 3; ++tile) {
        const int sh = tile >> 1, lh = (tile + 1) >> 1;
        f32x16 T = (f32x16){};
#pragma unroll
        for (int ks = 0; ks < 8; ++ks) { const bf16x8 afr = *(const LAS bf16x8*)(C.lds + SD_BM + (sh * 32 + q32) * 272 + ks * 32 + hi * 16);
            const bf16x8 bfr = *(const LAS bf16x8*)(C.lds + SD_CM + (lh * 32 + q32) * 272 + ks * 32 + hi * 16); T = MFMA32(afr, bfr, T); }
        const int l = lh * 32 + q32; const float al = acs[l];
        unsigned pk[8];
#pragma unroll
        for (int r2 = 0; r2 < 8; ++r2) { float mv[2];
#pragma unroll
            for (int q = 0; q < 2; ++q) { const int r = 2 * r2 + q; const int s = sh * 32 + 16 * (r >> 3) + 8 * hi + (r & 7);
                float w = 0.f; if (s <= l) w = fexp(al - acs[s]) * dts[s];
                mv[q] = T[r] * w + ((s == l) ? Dh : 0.f); }
            pk[r2] = pk_bf16(mv[0], mv[1]); }
#pragma unroll
        for (int sp = 0; sp < 2; ++sp) { const bf16x8 afr = xf[tile][sp];
            const u32x4 bw = {pk[4 * sp], pk[4 * sp + 1], pk[4 * sp + 2], pk[4 * sp + 3]};
            acc[lh] = MFMA32(afr, __builtin_bit_cast(bf16x8, bw), acc[lh]); }
    }
#pragma unroll
    for (int lh = 0; lh < 2; ++lh) { const int l = lh * 32 + q32; float ss = 0.f;
#pragma unroll
        for (int rq = 0; rq < 4; ++rq) { const u32x2 z = zf[lh][rq];
            acc[lh][4 * rq + 0] *= silu_f(bf_lo(z.x)); acc[lh][4 * rq + 1] *= silu_f(bf_hi(z.x)); acc[lh][4 * rq + 2] *= silu_f(bf_lo(z.y)); acc[lh][4 * rq + 3] *= silu_f(bf_hi(z.y));
#pragma unroll
            for (int q = 0; q < 4; ++q) ss += acc[lh][4 * rq + q] * acc[lh][4 * rq + q]; }
        ss += __shfl_xor(ss, 32);
        if (hi == 0) ((LAS float*)(C.lds + SD_RS))[C.wid * 64 + l] = ss; }
    __syncthreads();
    const float* nw = C.in[18] + (size_t)L * DIN; bf16_t* Y = WSP(bf16_t, WS_YSSD);
#pragma unroll
    for (int lh = 0; lh < 2; ++lh) { const int l = lh * 32 + q32; float tot = 0.f;
#pragma unroll
        for (int w = 0; w < 8; ++w) tot += ((const LAS float*)(C.lds + SD_RS))[w * 64 + l];
        const float rs = 1.0f / sqrtf(tot * (1.0f / 256.0f) + 1e-5f);
        if (l < ci.Lc) {
#pragma unroll
            for (int rq = 0; rq < 4; ++rq) { const f32x4 wv = *(const f32x4*)(nw + chb + 8 * rq);
                u32x2 o; o.x = pk_bf16(acc[lh][4 * rq] * rs * wv.x, acc[lh][4 * rq + 1] * rs * wv.y); o.y = pk_bf16(acc[lh][4 * rq + 2] * rs * wv.z, acc[lh][4 * rq + 3] * rs * wv.w);
                *(u32x2*)(Y + (size_t)(ci.base + l) * 2048 + chb + 8 * rq) = o; } } }
    __syncthreads();
}

struct AttnUnit { int qrow0, h, NT, ncache, krow0, kvalid, b, nt_base, sample; };
constexpr int AT_ST = 32768;
__device__ __forceinline__ void attn_unit(Ctx& C, int L, const AttnUnit u, const int rep) {
    const int mp = C.wid >> 2, wq = C.wid & 3, q32 = C.lane & 31, hi = C.lane >> 5;
    const bf16_t* Qb = WSP(const bf16_t, WS_Q); const bf16_t* Kb = WSP(const bf16_t, WS_K); const bf16_t* VT = WSP(const bf16_t, WS_VT);
    const bf16_t* KC = WSP(const bf16_t, WS_KC); const bf16_t* VTC = WSP(const bf16_t, WS_VTC);
    float lam; const float lam_init = (L == 0) ? 0.2f : 0.35550906f;
    { const float s1 = wave_sum(C.in[8][L * 64 + C.lane] * C.in[9][L * 64 + C.lane]), s2 = wave_sum(C.in[10][L * 64 + C.lane] * C.in[11][L * 64 + C.lane]);
      lam = expf(s1) - expf(s2) + lam_init; }
    const bool active = u.sample ? (wq == 0) : true;
    const int ntw = u.sample ? u.NT : (u.nt_base + (wq >> 1));
    bf16x8 qf[4];
    { const bf16_t* qp = Qb + (size_t)(u.qrow0 + 32 * wq + q32) * 1024 + u.h * 128 + mp * 64 + hi * 8;
#pragma unroll
      for (int ds = 0; ds < 4; ++ds) qf[ds] = *(const bf16x8*)(qp + ds * 16); }
    asm volatile("" : "+v"(qf[0]), "+v"(qf[1]), "+v"(qf[2]), "+v"(qf[3]));
    f32x16 O[4];
#pragma unroll
    for (int eb = 0; eb < 4; ++eb) O[eb] = (f32x16){};
    float m_run = 0.f, l_run = 0.f; f32x16 negm = (f32x16){};
    int koff[2], ve[2], vc[2];
#pragma unroll
    for (int i = 0; i < 2; ++i) { const int j = C.wid + 8 * i;
        const int r = 4 * j + (C.lane >> 4), c = (C.lane & 15) ^ (r & 15); koff[i] = ((r & 32) | sig5(r & 31)) * 1024 + c * 8;
        const int e = 8 * j + (C.lane >> 3), cv = (C.lane & 7) ^ ((e >> 1) & 7); ve[i] = e; vc[i] = cv * 8; }
    int kso[4], vso[4];
#pragma unroll
    for (int ds = 0; ds < 4; ++ds) { kso[ds] = ((mp * 8 + ds * 2 + hi) ^ (q32 & 15)) * 16; vso[ds] = ((ds * 2 + hi) ^ ((q32 >> 1) & 7)) * 16; }
#define AT_ISSUE(t, st) do { const int t_ = (t); \
        const bf16_t* kp_ = (t_ < u.ncache) ? KC + ((size_t)u.b * PAST + 64 * t_) * 1024 + u.h * 128 : Kb + ((size_t)u.krow0 + 64 * (t_ - u.ncache)) * 1024 + u.h * 128; \
        const bf16_t* vp_; int vs_; \
        if (t_ < u.ncache) { vp_ = VTC + ((size_t)u.b * 1024 + u.h * 128) * PAST + 64 * t_; vs_ = PAST; } else { vp_ = VT + (size_t)(u.h * 128) * MT + u.krow0 + 64 * (t_ - u.ncache); vs_ = MT; } \
        _Pragma("unroll") for (int i_ = 0; i_ < 2; ++i_) { \
            __builtin_amdgcn_global_load_lds((const unsigned*)(kp_ + koff[i_]), (LAS unsigned*)(C.lds + (st) * AT_ST + (C.wid + 8 * i_) * 1024), 16, 0, 0); \
            __builtin_amdgcn_global_load_lds((const unsigned*)(vp_ + (size_t)ve[i_] * vs_ + vc[i_]), (LAS unsigned*)(C.lds + (st) * AT_ST + 16384 + (C.wid + 8 * i_) * 1024), 16, 0, 0); } } while (0)
    AT_ISSUE(0, 0); AT_ISSUE(1, 1);
    int st_cur = 0, st_nxt2 = 2;
#pragma unroll 1
    for (int t = 0; t < u.NT; ++t) {
        if (t + 1 < u.NT) asm volatile("s_waitcnt vmcnt(4)\n\ts_barrier" ::: "memory");
        else asm volatile("s_waitcnt vmcnt(0)\n\ts_barrier" ::: "memory");
        if (t + 2 < u.NT) AT_ISSUE(t + 2, st_nxt2);
        if (active && t < ntw) {
            const LAS unsigned char* kb = C.lds + st_cur * AT_ST + q32 * 256;
            const LAS unsigned char* vb = C.lds + st_cur * AT_ST + 16384 + q32 * 128;
            bf16x8 ka[8];
#pragma unroll
            for (int ds = 0; ds < 4; ++ds) { ka[ds] = *(const LAS bf16x8*)(kb + kso[ds]); ka[4 + ds] = *(const LAS bf16x8*)(kb + 8192 + kso[ds]); }
            f32x16 S0 = MFMA32(ka[0], qf[0], negm);
#pragma unroll
            for (int ds = 1; ds < 4; ++ds) S0 = MFMA32(ka[ds], qf[ds], S0);
            f32x16 S1 = MFMA32(ka[4], qf[0], negm);
#pragma unroll
            for (int ds = 1; ds < 4; ++ds) S1 = MFMA32(ka[4 + ds], qf[ds], S1);
            bf16x8 va[4];
#pragma unroll
            for (int eb = 0; eb < 4; ++eb) va[eb] = *(const LAS bf16x8*)(vb + eb * 4096 + vso[0]);
            float mx = max3f(S0[0], S0[1], S0[2]);
#pragma unroll
            for (int r = 3; r < 15; r += 2) mx = max3f(mx, S0[r], S0[r + 1]);
            mx = max3f(mx, S0[15], S0[15]);
#pragma unroll
            for (int r = 0; r < 16; ++r) S0[r] = fexp2(S0[r]);
            float mx1 = max3f(S1[0], S1[1], S1[2]);
#pragma unroll
            for (int r = 3; r < 15; r += 2) mx1 = max3f(mx1, S1[r], S1[r + 1]);
            mx = max3f(mx, mx1, S1[15]);
            mx = max3f(mx, __shfl_xor(mx, 32), mx);
            if (t == 0 || __any(mx > 8.0f)) {
                const float dl = (t == 0) ? mx : fmaxf(mx, 0.f);
                m_run += dl;
                const float f = fexp2(-dl); l_run *= f;
#pragma unroll
                for (int r = 0; r < 16; ++r) { S0[r] *= f; S1[r] -= dl; negm[r] = -m_run; }
#pragma unroll
                for (int eb = 0; eb < 4; ++eb)
#pragma unroll
                    for (int r = 0; r < 16; ++r) O[eb][r] *= f;
            }
            if (t == u.NT - 1 && u.kvalid < 64) {
#pragma unroll
                for (int r = 0; r < 16; ++r) { const int kv = 16 * (r >> 3) + 8 * hi + (r & 7); if (kv >= u.kvalid) S0[r] = 0.f; if (kv + 32 >= u.kvalid) S1[r] = -INFINITY; } }
            u32x4 pk[4];
#pragma unroll
            for (int sp = 0; sp < 2; ++sp)
                pk[sp] = (u32x4){pk_bf16(S0[8 * sp], S0[8 * sp + 1]), pk_bf16(S0[8 * sp + 2], S0[8 * sp + 3]), pk_bf16(S0[8 * sp + 4], S0[8 * sp + 5]), pk_bf16(S0[8 * sp + 6], S0[8 * sp + 7])};
#pragma unroll
            for (int eb = 0; eb < 4; ++eb) O[eb] = MFMA32(va[eb], __builtin_bit_cast(bf16x8, pk[0]), O[eb]);
#pragma unroll
            for (int eb = 0; eb < 4; ++eb) va[eb] = *(const LAS bf16x8*)(vb + eb * 4096 + vso[1]);
#pragma unroll
            for (int r = 0; r < 16; ++r) S1[r] = fexp2(S1[r]);
#pragma unroll
            for (int eb = 0; eb < 4; ++eb) O[eb] = MFMA32(va[eb], __builtin_bit_cast(bf16x8, pk[1]), O[eb]);
#pragma unroll
            for (int eb = 0; eb < 4; ++eb) va[eb] = *(const LAS bf16x8*)(vb + eb * 4096 + vso[2]);
#pragma unroll
            for (int sp = 0; sp < 2; ++sp)
                pk[2 + sp] = (u32x4){pk_bf16(S1[8 * sp], S1[8 * sp + 1]), pk_bf16(S1[8 * sp + 2], S1[8 * sp + 3]), pk_bf16(S1[8 * sp + 4], S1[8 * sp + 5]), pk_bf16(S1[8 * sp + 6], S1[8 * sp + 7])};
#pragma unroll
            for (int eb = 0; eb < 4; ++eb) O[eb] = MFMA32(va[eb], __builtin_bit_cast(bf16x8, pk[2]), O[eb]);
#pragma unroll
            for (int eb = 0; eb < 4; ++eb) va[eb] = *(const LAS bf16x8*)(vb + eb * 4096 + vso[3]);
            float sum = 0.f, sum2 = 0.f;
#pragma unroll
            for (int r = 0; r < 16; ++r) { sum += S0[r]; sum2 += S1[r]; }
            l_run += sum + sum2;
#pragma unroll
            for (int eb = 0; eb < 4; ++eb) O[eb] = MFMA32(va[eb], __builtin_bit_cast(bf16x8, pk[3]), O[eb]);
#if MK_SGB
#pragma unroll
            for (int i_ = 0; i_ < 16; ++i_) { __builtin_amdgcn_sched_group_barrier(0x008, 1, 0); __builtin_amdgcn_sched_group_barrier(0x100, 1, 0); __builtin_amdgcn_sched_group_barrier(0x002, 5, 0); }
#endif
        }
        st_cur = (st_cur == 2) ? 0 : st_cur + 1; st_nxt2 = (st_nxt2 == 2) ? 0 : st_nxt2 + 1;
    }
#undef AT_ISSUE
    asm volatile("s_waitcnt lgkmcnt(0)\n\ts_barrier" ::: "memory");
    const float ltot = l_run + __shfl_xor(l_run, 32); const float inv = 1.0f / ltot;
    LAS float* EX = (LAS float*)C.lds + wq * 4096;
    if (mp == 1 && active) {
#pragma unroll
        for (int eb = 0; eb < 4; ++eb)
#pragma unroll
            for (int r = 0; r < 16; ++r) EX[(32 * eb + 8 * (r >> 2) + 4 * hi + (r & 3)) * 32 + q32] = O[eb][r] * inv;
    }
    __syncthreads();
    if (mp == 0 && active) {
        float ss = 0.f;
#pragma unroll
        for (int eb = 0; eb < 4; ++eb)
#pragma unroll
            for (int r = 0; r < 16; ++r) { const float d = O[eb][r] * inv - lam * EX[(32 * eb + 8 * (r >> 2) + 4 * hi + (r & 3)) * 32 + q32]; O[eb][r] = d; ss += d * d; }
        ss += __shfl_xor(ss, 32);
        const float rs = (1.0f / sqrtf(ss * (1.0f / 128.0f) + 1e-5f)) * (1.0f - lam_init);
        const float* sw = C.in[12] + L * 128;
        if (!u.sample || q32 < 16) {
            bf16_t* dst = WSP(bf16_t, WS_ATT) + (size_t)(u.qrow0 + 32 * wq + q32) * 1024 + u.h * 128 + 4 * hi;
#pragma unroll
            for (int eb = 0; eb < 4; ++eb)
#pragma unroll
                for (int rq = 0; rq < 4; ++rq) { const f32x4 wv = *(const f32x4*)(sw + 32 * eb + 8 * rq + 4 * hi);
                    u32x2 o; o.x = pk_bf16(O[eb][4 * rq] * rs * wv.x, O[eb][4 * rq + 1] * rs * wv.y); o.y = pk_bf16(O[eb][4 * rq + 2] * rs * wv.z, O[eb][4 * rq + 3] * rs * wv.w);
                    *(u32x2*)(dst + 32 * eb + 8 * rq) = o; }
        }
    }
    __syncthreads();
}

struct OneUnit { int pm, pn;
    __device__ __forceinline__ bool next(int i, pg8::Unit& u) const { if (i) return false; u.pm = pm; u.pn = pn; return true; }
    __device__ __forceinline__ void a_ready(const pg8::Unit&) const {}
    __device__ __forceinline__ void done(const pg8::Unit&) const {} };
__device__ __forceinline__ void flag_publish(unsigned* cnt, int tid) {
    asm volatile("s_waitcnt vmcnt(0)" ::: "memory"); __syncthreads();
    if (tid == 0) { __builtin_amdgcn_fence(__ATOMIC_RELEASE, "agent"); asm volatile("s_waitcnt vmcnt(0)" ::: "memory"); __hip_atomic_fetch_add(cnt, 1u, __ATOMIC_RELAXED, __HIP_MEMORY_SCOPE_AGENT); }
}
__device__ __forceinline__ void flag_wait(unsigned* cnt, unsigned target, int tid) {
    if (tid == 0) { unsigned sp = 0; while (__hip_atomic_load(cnt, __ATOMIC_RELAXED, __HIP_MEMORY_SCOPE_AGENT) < target) { __builtin_amdgcn_s_sleep(16); if (++sp > (1u << 24)) break; } }
    __syncthreads();
    __builtin_amdgcn_fence(__ATOMIC_ACQUIRE, "agent"); asm volatile("s_waitcnt vmcnt(0)" ::: "memory");
    __syncthreads();
}
__device__ __forceinline__ void chain_item(Ctx& C, int L, int kind, int idx) {
    unsigned* cnt = WSP(unsigned, WS_CTL) + 64 * (20 + 4 * L);
    if (kind == 0) {
        flag_wait(cnt, 128u, C.tid);
        OneUnit S{0, idx};
        { pg8::Gemm g{WSP(const bf16_t, WS_ATT) + (size_t)SEQ * 1024, WSP(const bf16_t, WS_WBA + L * SZ_WBA), 256, 1024, 1024}; EpiBrA E{WSP(const bf16_t, WS_G), WSP(float, WS_Z), SEQ};
          pg8::gemm_phase<EpiBrA, OneUnit, true, true>(C.lds, g, S, E); }
        { pg8::Gemm g{WSP(const bf16_t, WS_YSSD) + (size_t)SEQ * 2048, WSP(const bf16_t, WS_WBS + L * SZ_WBS), 256, 1024, 2048}; EpiBrB E{WSP(const bf16_t, WS_G), WSP(const float, WS_Z), WSP(bf16_t, WS_Q), SEQ};
          pg8::gemm_phase<EpiBrB, OneUnit, true, true>(C.lds, g, S, E); }
        flag_publish(cnt + 64, C.tid);
    } else if (kind == 1) {
        flag_wait(cnt + 64, 4u, C.tid);
        OneUnit S{0, idx};
        pg8::Gemm g{WSP(const bf16_t, WS_Q) + (size_t)SEQ * 1024, WSP(const bf16_t, WS_WOUT + L * SZ_WOUT), 256, 1024, 1024};
        EpiRes E{WSP(float, WS_X), WSP(bf16_t, WS_XB), WSP(float, WS_PART) + (size_t)(2 * L + 1) * MT, SEQ};
        pg8::gemm_phase<EpiRes, OneUnit, true, true>(C.lds, g, S, E);
        flag_publish(cnt + 128, C.tid);
    } else if (kind == 2) {
        flag_wait(cnt + 128, 4u, C.tid);
        OneUnit S{0, idx};
        pg8::Gemm g{WSP(const bf16_t, WS_XB) + (size_t)SEQ * 1024, WSP(const bf16_t, WS_WGU + L * SZ_WGU), 256, 5632, 1024};
        EpiGU E{WSP(const float, WS_PART) + (size_t)(2 * L + 1) * MT, WSP(bf16_t, WS_ACTS), SEQ, SEQ};
        pg8::gemm_phase<EpiGU, OneUnit, true, true>(C.lds, g, S, E);
        flag_publish(cnt + 192, C.tid);
    } else {
        flag_wait(cnt + 192, 22u, C.tid);
        OneUnit S{0, idx};
        pg8::Gemm g{WSP(const bf16_t, WS_ACTS), WSP(const bf16_t, WS_WD + L * SZ_WD), 256, 1024, DFF};
        EpiRes E{WSP(float, WS_X), WSP(bf16_t, WS_XB), WSP(float, WS_PART) + (size_t)(2 * L + 2) * MT, SEQ};
        pg8::gemm_phase<EpiRes, OneUnit, true, true>(C.lds, g, S, E);
    }
    __syncthreads();
}

__device__ __forceinline__ void phase_mix(Ctx& C, int L, int rep) {
    unsigned* counter = WSP(unsigned, WS_CTL) + 64 * (1 + L + 4 * rep);
    unsigned* cntA = WSP(unsigned, WS_CTL) + 64 * (20 + 4 * L);
    volatile LAS int* slot = (volatile LAS int*)(C.lds + LDS_CTL);
    constexpr int N_SMP = 64, N_S3S = 64, N_MID = 1024 + 34, N_S3 = 2048, N_ALL = N_SMP + N_S3S + N_MID + N_S3;
    for (;;) {
        __syncthreads();
        if (C.tid == 0) slot[0] = (int)atomicAdd(counter, 1u);
        __syncthreads();
        const int item = slot[0];
        if (item >= N_ALL) break;
        { int t_ = threadIdx.x; asm volatile("" : "+v"(t_)); C.tid = t_; C.lane = t_ & 63; C.wid = __builtin_amdgcn_readfirstlane(t_ >> 6); }
        if (item < N_SMP) { AttnUnit u; u.sample = 1; u.b = item >> 3; u.h = item & 7; u.qrow0 = SEQ + 16 * u.b; u.NT = 65; u.ncache = 64; u.krow0 = SEQ + 16 * u.b; u.kvalid = 16; u.nt_base = 65;
            attn_unit(C, L, u, rep); flag_publish(cntA, C.tid); }
        else if (item < N_SMP + N_S3S) { const int j = 2048 + (item - N_SMP); ssd_s3_unit(C, L, j >> 3, j & 7); flag_publish(cntA, C.tid); }
        else if (item < N_SMP + N_S3S + N_MID) { const int mi = item - N_SMP - N_S3S; int j = -1, kind = -1, idx = 0;
            if (mi < 400) j = mi; else if (mi < 404) { kind = 0; idx = mi - 400; } else if (mi < 560) j = mi - 4; else if (mi < 564) { kind = 1; idx = mi - 560; }
            else if (mi < 720) j = mi - 8; else if (mi < 742) { kind = 2; idx = mi - 720; } else if (mi < 880) j = mi - 30; else if (mi < 884) { kind = 3; idx = mi - 880; } else j = mi - 34;
            if (kind >= 0) chain_item(C, L, kind, idx);
            else { const int qb = 127 - (j >> 3); AttnUnit u; u.sample = 0; u.b = 0; u.h = j & 7; u.qrow0 = 128 * qb; u.NT = 2 * qb + 2; u.ncache = 0; u.krow0 = 0; u.kvalid = 64; u.nt_base = 2 * qb + 1; attn_unit(C, L, u, rep); } }
        else { const int j = item - N_SMP - N_S3S - N_MID; ssd_s3_unit(C, L, j >> 3, j & 7); }
    }
}

__device__ __forceinline__ void phase_final(Ctx& C) {
    const float* X = WSP(const float, WS_X); const float* PART = WSP(const float, WS_PART); const float* nw = C.in[25];
    const int gw = C.bid * 8 + C.wid, NGW = C.G * 8;
    for (int row = gw; row < MV; row += NGW) { const float rs = rstd1(PART + 4 * MT, row, 1e-6f);
#pragma unroll
        for (int j = 0; j < 4; ++j) { const int col = 4 * C.lane + 256 * j; const f32x4 x = *(const f32x4*)(X + (size_t)row * 1024 + col); const f32x4 w = *(const f32x4*)(nw + col);
            *(f32x4*)(C.out + O_YP + (size_t)row * 1024 + col) = (x * rs) * w; } }
}

#define XB_TMO      128
#define XB_XCNT(j)  (256  + 64 * (j))
#define XB_XSUB(j)  (1280 + 64 * (j))
#define XB_XGEN(j)  (2304 + 64 * (j))
#define XB_TOP      3328
#define XB_TOPGEN   3392
#define XCD_BAR_WORDS 3456
#define XB_SPIN_CAP (1u << 23)

__device__ __forceinline__ unsigned xb_ld(unsigned* p)              { return __hip_atomic_load(p, __ATOMIC_RELAXED, __HIP_MEMORY_SCOPE_AGENT); }
__device__ __forceinline__ unsigned xb_add(unsigned* p, unsigned v) { return __hip_atomic_fetch_add(p, v, __ATOMIC_RELAXED, __HIP_MEMORY_SCOPE_AGENT); }
__device__ __forceinline__ unsigned xb_xcc_id() { return (unsigned)__builtin_amdgcn_s_getreg((3 << 11) | 20) & 0xFu; }
#define XB_SPIN(cond, bar) do { unsigned _sp = 0; while (cond) { __builtin_amdgcn_s_sleep(1); \
    if ((++_sp & 255u) == 0u) { if (xb_ld(&(bar)[XB_TMO])) break; if (_sp > XB_SPIN_CAP) { atomicAdd(&(bar)[XB_TMO], 1u); break; } } } } while (0)

struct XcdBarrier {
    unsigned* bar; unsigned x;
    volatile LAS unsigned* st;
};

__device__ __forceinline__ XcdBarrier xcd_barrier_post(unsigned* bar, volatile LAS unsigned* st) {
    XcdBarrier b; b.bar = bar; b.x = xb_xcc_id(); b.st = st;
    if (threadIdx.x == 0) (void)xb_add(&bar[XB_XCNT(b.x)], 1u);
    return b;
}
__device__ __forceinline__ void xcd_barrier_complete(unsigned* bar, unsigned x, unsigned& nloc, unsigned& nx) {
    const unsigned G = gridDim.x * gridDim.y * gridDim.z;
    unsigned sum, cnt, mine, sp = 0u;
    for (;;) {
        sum = 0u; cnt = 0u; mine = 0u;
#pragma unroll
        for (unsigned j = 0; j < 16; ++j) { const unsigned c = xb_ld(&bar[XB_XCNT(j)]); sum += c; cnt += (c > 0u) ? 1u : 0u; mine = (j == x) ? c : mine; }
        if (sum == G) break;
        __builtin_amdgcn_s_sleep(1);
        if ((++sp & 255u) == 0u) { if (xb_ld(&bar[XB_TMO])) break; if (sp > XB_SPIN_CAP) { atomicAdd(&bar[XB_TMO], 1u); break; } }
    }
    nloc = mine > 0u ? mine : 1u; nx = cnt > 0u ? cnt : 1u;
}

__device__ __forceinline__ void xcd_barrier(const XcdBarrier& b) {
    asm volatile("s_waitcnt vmcnt(0)" ::: "memory");
    __syncthreads();
    if (threadIdx.x == 0) {
        unsigned* bar = b.bar;
        __builtin_amdgcn_s_waitcnt(0);
        unsigned nloc = b.st[0], nx = b.st[1];
        if (nloc == 0u) { xcd_barrier_complete(bar, b.x, nloc, nx); b.st[0] = nloc; b.st[1] = nx; }
        const unsigned old = xb_add(&bar[XB_XSUB(b.x)], 1u);
        const unsigned gen = old / nloc;
        if (old + 1u == (gen + 1u) * nloc) {
            __builtin_amdgcn_fence(__ATOMIC_RELEASE, "agent");
            asm volatile("s_waitcnt vmcnt(0)" ::: "memory");
            const unsigned og = xb_add(&bar[XB_TOP], 1u);
            const unsigned tg = og / nx;
            if (og + 1u == (tg + 1u) * nx) xb_add(&bar[XB_TOPGEN], 1u);
            else XB_SPIN(xb_ld(&bar[XB_TOPGEN]) == tg, bar);
            __builtin_amdgcn_fence(__ATOMIC_ACQUIRE, "agent");
            xb_add(&bar[XB_XGEN(b.x)], 1u);
            asm volatile("s_waitcnt vmcnt(0)" ::: "memory");
        } else {
            XB_SPIN(xb_ld(&bar[XB_XGEN(b.x)]) == gen, bar);
            __builtin_amdgcn_fence(__ATOMIC_ACQUIRE, "agent");
            asm volatile("s_waitcnt vmcnt(0)" ::: "memory");
        }
    }
    __syncthreads();
}

constexpr int N_PHASES = 18;
__global__ void __launch_bounds__(512, 2) mk_fwd(Args a) {
    extern __shared__ __attribute__((aligned(16))) unsigned char lds_raw[];
    Ctx C;
    C.lds = (LAS unsigned char*)lds_raw; C.G = gridDim.x; C.bid = blockIdx.x;
#pragma unroll
    for (int i = 0; i < 26; ++i) C.in[i] = a.in[i];
    C.out = a.out; C.ws = a.ws;
    cg::grid_group grid = cg::this_grid();
    if (threadIdx.x < 64) ((LAS unsigned*)(C.lds + LDS_CTL))[threadIdx.x] = 0u;
    __syncthreads();
    XcdBarrier xbar = xcd_barrier_post(WSP(unsigned, WS_CTL) + 4096, (volatile LAS unsigned*)(C.lds + LDS_CTL + 32));
#pragma unroll 1
    for (int ph = a.ph_lo; ph < a.ph_hi; ++ph) {
        if (ph == a.ph_lo + 1) { grid.sync(); } else if (ph > a.ph_lo) { xcd_barrier(xbar); }
        { int t_ = threadIdx.x; asm volatile("" : "+v"(t_)); C.tid = t_; C.lane = t_ & 63; C.wid = __builtin_amdgcn_readfirstlane(t_ >> 6); }
        if (ph == 0) { if (!(MK_SKIP & 1024)) phase_p0(C); continue; }
        if (ph == N_PHASES - 1) { phase_final(C); continue; }
        const int L = (ph - 1) >> 3, sub = (ph - 1) & 7;
        if (sub == 0) {
            pg8::Gemm g{WSP(const bf16_t, WS_XB), WSP(const bf16_t, WS_WIN + L * SZ_WIN), MT, NINP, 1024}; pg8::StaticOrder S; S.init(MT, NINP, C.G, C.bid);
            EpiIn E{WSP(const float, WS_PART) + (size_t)(2 * L) * MT, WSP(bf16_t, WS_Q), WSP(bf16_t, WS_K), WSP(bf16_t, WS_VT), WSP(bf16_t, WS_Z), WSP(bf16_t, WS_XBC), WSP(bf16_t, WS_G), WSP(float, WS_DT), C.out, L, WSP(bf16_t, WS_HIST)};
            if (!(MK_SKIP & 1)) pg8::gemm_phase<EpiIn, pg8::StaticOrder, true, true>(C.lds, g, S, E);
            if (MK_PROBE & 2) { grid.sync(); pg8::gemm_phase<EpiIn, pg8::StaticOrder, true, true>(C.lds, g, S, E); }
            if (MK_PROBE & 1024) { grid.sync(); EpiNull EN{WSP(float, WS_END - 64)}; pg8::gemm_phase<EpiNull, pg8::StaticOrder, true, true>(C.lds, g, S, EN); }
        } else if (sub == 1) {
            for (int uidx = C.bid; uidx < NCHUNK * 8; uidx += C.G) { { int t_ = threadIdx.x; asm volatile("" : "+v"(t_)); C.tid = t_; C.lane = t_ & 63; C.wid = __builtin_amdgcn_readfirstlane(t_ >> 6); } conv_unit(C, L, uidx >> 3, uidx & 7); }
            if (!(MK_SKIP & 4)) cache_convert(C, L);
            xcd_barrier(xbar);
            for (int uidx = C.bid * 8 + C.wid; uidx < NCHUNK * 32; uidx += C.G * 8) { { int t_ = threadIdx.x; asm volatile("" : "+v"(t_)); C.tid = t_; C.lane = t_ & 63; C.wid = __builtin_amdgcn_readfirstlane(t_ >> 6); } ssd_s1_wave(C, L, uidx >> 5, uidx & 31); }
            if (MK_PROBE & 512) { grid.sync(); for (int uidx = C.bid * 8 + C.wid; uidx < NCHUNK * 32; uidx += C.G * 8) { { int t_ = threadIdx.x; asm volatile("" : "+v"(t_)); C.tid = t_; C.lane = t_ & 63; C.wid = __builtin_amdgcn_readfirstlane(t_ >> 6); } ssd_s1_wave(C, L, uidx >> 5, uidx & 31); } }
        } else if (sub == 2) {
            if (!(MK_SKIP & 8)) ssd_scan(C, L);
        } else if (sub == 3) {
            phase_mix(C, L, 0);
            if (MK_PROBE & 1) { grid.sync(); phase_mix(C, L, 1); }
        } else if (sub == 4) {
            pg8::StaticOrder S; S.init(SEQ, 1024, C.G, C.bid);
            { pg8::Gemm g{WSP(const bf16_t, WS_ATT), WSP(const bf16_t, WS_WBA + L * SZ_WBA), SEQ, 1024, 1024}; EpiBrA E{WSP(const bf16_t, WS_G), WSP(float, WS_Z), 0};
              if (!(MK_SKIP & 64)) pg8::gemm_phase<EpiBrA, pg8::StaticOrder, true, true>(C.lds, g, S, E); }
            { pg8::Gemm g{WSP(const bf16_t, WS_YSSD), WSP(const bf16_t, WS_WBS + L * SZ_WBS), SEQ, 1024, 2048}; EpiBrB E{WSP(const bf16_t, WS_G), WSP(const float, WS_Z), WSP(bf16_t, WS_Q), 0};
              if (!(MK_SKIP & 128)) pg8::gemm_phase<EpiBrB, pg8::StaticOrder, true, true>(C.lds, g, S, E); }
        } else if (sub == 5) {
            pg8::Gemm g{WSP(const bf16_t, WS_Q), WSP(const bf16_t, WS_WOUT + L * SZ_WOUT), SEQ, 1024, 1024}; pg8::StaticOrder S; S.init(SEQ, 1024, C.G, C.bid);
            EpiRes E{WSP(float, WS_X), WSP(bf16_t, WS_XB), WSP(float, WS_PART) + (size_t)(2 * L + 1) * MT, 0};
            if (!(MK_SKIP & 256)) pg8::gemm_phase<EpiRes, pg8::StaticOrder, true, true>(C.lds, g, S, E);
        } else if (sub == 6) {
            pg8::Gemm g{WSP(const bf16_t, WS_XB), WSP(const bf16_t, WS_WGU + L * SZ_WGU), SEQ, 5632, 1024}; pg8::StaticOrder S; S.init(SEQ, 5632, C.G, C.bid);
            EpiGU E{WSP(const float, WS_PART) + (size_t)(2 * L + 1) * MT, WSP(bf16_t, WS_XBC), 0, 0};
            if (!(MK_SKIP & 512)) pg8::gemm_phase<EpiGU, pg8::StaticOrder, true, true>(C.lds, g, S, E);
            if (MK_PROBE & 4) { grid.sync(); pg8::gemm_phase<EpiGU, pg8::StaticOrder, true, true>(C.lds, g, S, E); }
        } else {
            pg8::Gemm g{WSP(const bf16_t, WS_XBC), WSP(const bf16_t, WS_WD + L * SZ_WD), SEQ, 1024, DFF}; pg8::StaticOrder S; S.init(SEQ, 1024, C.G, C.bid);
            EpiRes E{WSP(float, WS_X), WSP(bf16_t, WS_XB), WSP(float, WS_PART) + (size_t)(2 * L + 2) * MT, 0};
            if (!(MK_SKIP & 256)) pg8::gemm_phase<EpiRes, pg8::StaticOrder, true, true>(C.lds, g, S, E);
        }
    }
}

extern "C" void kernel_launch(void* const* d_in, const int* in_sizes, int n_in, void* d_out, int out_size, void* d_ws, size_t ws_size, hipStream_t stream) {
    static int grid = 0;
    if (grid == 0) {
        if (n_in != 26 || (size_t)out_size != O_END || ws_size < WS_END) { fprintf(stderr, "kernel_launch: unexpected shapes (n_in %d, out %d, ws %zu)\n", n_in, out_size, ws_size); grid = -1; return; }
        int dev = 0, cus = 0, per_cu = 0;
        hipGetDevice(&dev); hipDeviceGetAttribute(&cus, hipDeviceAttributeMultiprocessorCount, dev);
        if (hipFuncSetAttribute((const void*)mk_fwd, hipFuncAttributeMaxDynamicSharedMemorySize, LDS_BYTES) != hipSuccess) { fprintf(stderr, "kernel_launch: hipFuncSetAttribute failed\n"); grid = -1; return; }
        if (hipOccupancyMaxActiveBlocksPerMultiprocessor(&per_cu, (const void*)mk_fwd, 512, LDS_BYTES) != hipSuccess || per_cu < 1) per_cu = 1;
        (void)hipGetLastError();
        grid = cus * per_cu;
    }
    if (grid < 0) return;
    hipMemsetAsync((char*)d_ws + WS_CTL, 0, CTL_BYTES, stream);
    Args a{};
    for (int i = 0; i < 26; ++i) a.in[i] = (const float*)d_in[i];
    a.out = (float*)d_out; a.ws = (unsigned char*)d_ws;
#if MK_MULTI
    for (int ph = 0; ph < N_PHASES; ++ph) { a.ph_lo = ph; a.ph_hi = ph + 1; hipLaunchKernelGGL(mk_fwd, dim3(grid), dim3(512), LDS_BYTES, stream, a); }
#else
    a.ph_lo = 0; a.ph_hi = N_PHASES;
    void* args[] = {&a};
    hipError_t e = hipLaunchCooperativeKernel((const void*)mk_fwd, dim3(grid), dim3(512), args, LDS_BYTES, stream);
    if (e != hipSuccess) fprintf(stderr, "cooperative launch failed: %s (grid %d)\n", hipGetErrorString(e), grid);
#endif
}
```

```cpp
#include <hip/hip_runtime.h>
#include <hip/hip_cooperative_groups.h>
#include <cstdio>
#include <cstdint>
#include <cmath>
namespace cg = cooperative_groups;
#ifndef MK_MULTI
#define MK_MULTI 0
#endif
#ifndef MK_SKIP
#define MK_SKIP 0
#endif
#ifndef MK_PROBE
#define MK_PROBE 0
#endif
#ifndef MK_SGB
#define MK_SGB 0
#endif
namespace pg8 {
#define PG8_LAS __attribute__((address_space(3)))
typedef unsigned short bf16_t;
typedef short bf16x8 __attribute__((ext_vector_type(8)));
typedef float f32x4 __attribute__((ext_vector_type(4)));
typedef unsigned u32x4 __attribute__((ext_vector_type(4)));
constexpr int BM = 256, BK = 64, HALF = 128, HTB = HALF * BK * 2  , STAGE_BYTES = 8 * HTB, NXCD = 8, WGM = 8;

__host__ __device__ __forceinline__ int lds_byte(int r, int c) { const int st = (r >> 4) * 2 + (c >> 5), rr = r & 15, cc = c & 31, ob = rr * 64 + cc * 2; return st * 1024 + (ob ^ (((ob >> 9) & 1) << 5)); }
__host__ __device__ __forceinline__ void stage_rc(int b, int& R, int& C) { const int st = b / 1024, sb = b % 1024, swz = sb ^ (((sb >> 9) & 1) << 5); R = (st >> 1) * 16 + swz / 64; C = (st & 1) * 32 + (swz % 64) / 2; }
__host__ __device__ __forceinline__ int perm32(int rho) { const int n = rho >> 4, i = rho & 15; return 8 * (i >> 2) + 4 * n + (i & 3); }

struct Unit { int pm, pn; };
struct Gemm { const bf16_t* A; const bf16_t* Bt; int M, N, K; };

struct StaticOrder {
    int nM, nN, nwg, G, c;
    __host__ __device__ void init(int M, int N, int G_, int c_) { nM = M / BM; nN = N / BM; nwg = nM * nN; G = G_; c = c_; }
    __host__ __device__ bool next(int i, Unit& u) const {
        const long L = (long)i * G + c; if (L >= nwg) return false;
        int wgid = (int)L; { const int q = nwg / NXCD, r = nwg % NXCD, xcd = wgid % NXCD, off = wgid / NXCD; wgid = (xcd < r ? xcd * (q + 1) : r * (q + 1) + (xcd - r) * q) + off; }
        const int nig = WGM * nN, gid = wgid / nig, fm = gid * WGM, gsz = (nM - fm) < WGM ? (nM - fm) : WGM;
        u.pm = fm + ((wgid % nig) % gsz); u.pn = (wgid % nig) / gsz; return true;
    }
    __device__ __forceinline__ void a_ready(const Unit&) const {}
    __device__ __forceinline__ void done(const Unit&) const {}
};

template <class Epi, class Sched, bool ALIGN_EPI = false, bool SP2 = false>
__device__ __forceinline__ void gemm_phase(PG8_LAS unsigned char* lds, const Gemm g, const Sched& S, const Epi& E) {
    int tid_ = threadIdx.x; asm volatile("" : "+v"(tid_)); const int tid = tid_, wid = __builtin_amdgcn_readfirstlane(tid >> 6), lane = tid & 63, wr = wid >> 2, wc = wid & 3, fr = lane & 15, fq = lane >> 4;
    const int K = g.K, nt = K / BK;
    unsigned voffA[2], voffB[2];
#pragma unroll
    for (int i = 0; i < 2; ++i) { int R, C; stage_rc(tid * 16 + i * 8192, R, C); const int Rb = Epi::PERM ? ((R & ~31) + perm32(R & 31)) : R;
        voffA[i] = (unsigned)(R * K + C) * 2u; voffB[i] = (unsigned)(Rb * K + C) * 2u; }
    const size_t kstep = (size_t)(BK * 2);
    const size_t hstep = (size_t)HALF * K * 2;
    const size_t tstep = 2 * hstep;
    const unsigned ldsw = (unsigned)wid * 1024u;
    const int aoff = lds_byte(wr * 64 + fr, fq * 8), boff = lds_byte(wc * 32 + fr, fq * 8);
#define PG8_SA(b, h) (((b) * 2 + (h)) * HTB)
#define PG8_SB(b, h) ((4 + (b) * 2 + (h)) * HTB)
#define PG8_STAGE(bufoff, gbase, voff) do { _Pragma("unroll") for (int _i = 0; _i < 2; ++_i) \
        __builtin_amdgcn_global_load_lds((const unsigned*)((const char*)(gbase) + (voff)[_i]), (PG8_LAS unsigned*)(lds + (bufoff) + ldsw + _i * 8192), 16, 0, 0); } while (0)
#define PG8_LDA(dst, b, h) do { _Pragma("unroll") for (int m = 0; m < 4; ++m) _Pragma("unroll") for (int k = 0; k < 2; ++k) dst[m][k] = *(const PG8_LAS bf16x8*)(lds + PG8_SA(b, h) + aoff + m * 2048 + k * 1024); } while (0)
#define PG8_LDB(dst, b, h) do { _Pragma("unroll") for (int n = 0; n < 2; ++n) _Pragma("unroll") for (int k = 0; k < 2; ++k) dst[n][k] = *(const PG8_LAS bf16x8*)(lds + PG8_SB(b, h) + boff + n * 2048 + k * 1024); } while (0)
#define PG8_MMA(ai, bj, At, Bt) do { __builtin_amdgcn_s_setprio(1); _Pragma("unroll") for (int m = 0; m < 4; ++m) _Pragma("unroll") for (int n = 0; n < 2; ++n) _Pragma("unroll") for (int k = 0; k < 2; ++k) \
        acc[ai][bj][m][n] = __builtin_amdgcn_mfma_f32_16x16x32_bf16(Bt[n][k], At[m][k], acc[ai][bj][m][n], 0, 0, 0); __builtin_amdgcn_s_setprio(0); } while (0)
#define PG8_WAIT_V(n) asm volatile("s_waitcnt vmcnt(" #n ")" ::: "memory")
#define PG8_WAIT_L(n) asm volatile("s_waitcnt lgkmcnt(" #n ")" ::: "memory")
#define PG8_BAR __builtin_amdgcn_s_barrier()
#define PG8_SCHED __builtin_amdgcn_sched_barrier(0)
    Unit cur, nxt; int ui = 0;
    if (!S.next(0, cur)) return;
    f32x4 acc[2][2][4][2];
#pragma unroll
    for (int a = 0; a < 2; ++a)
#pragma unroll
        for (int b = 0; b < 2; ++b)
#pragma unroll
            for (int m = 0; m < 4; ++m)
#pragma unroll
                for (int n = 0; n < 2; ++n) acc[a][b][m][n] = (f32x4){0.f, 0.f, 0.f, 0.f};
    bf16x8 At[4][2], B0[2][2], B1[2][2];
    const char* cA = (const char*)g.A + (size_t)cur.pm * tstep; const char* cB = (const char*)g.Bt + (size_t)cur.pn * tstep;
    S.a_ready(cur);
    if constexpr (SP2) {
        PG8_STAGE(PG8_SB(0, 0), cB, voffB); PG8_STAGE(PG8_SB(0, 1), cB + hstep, voffB); PG8_STAGE(PG8_SA(0, 0), cA, voffA); PG8_STAGE(PG8_SA(0, 1), cA + hstep, voffA);
        if (wr == 1) PG8_BAR;
        PG8_WAIT_V(2); PG8_BAR;
        PG8_STAGE(PG8_SB(1, 0), cB + kstep, voffB); PG8_STAGE(PG8_SA(1, 0), cA + kstep, voffA); PG8_STAGE(PG8_SB(1, 1), cB + hstep + kstep, voffB);
        PG8_WAIT_V(6); PG8_BAR;
    } else {
        PG8_STAGE(PG8_SB(0, 0), cB, voffB); PG8_STAGE(PG8_SA(0, 0), cA, voffA); PG8_STAGE(PG8_SB(0, 1), cB + hstep, voffB); PG8_STAGE(PG8_SA(0, 1), cA + hstep, voffA);
        if (wr == 1) PG8_BAR;
        PG8_WAIT_V(4); PG8_BAR;
        PG8_STAGE(PG8_SB(1, 0), cB + kstep, voffB); PG8_STAGE(PG8_SA(1, 0), cA + kstep, voffA); PG8_STAGE(PG8_SB(1, 1), cB + hstep + kstep, voffB);
        PG8_WAIT_V(6); PG8_BAR;
    }
    for (;;) {
        const bool has_next = S.next(ui + 1, nxt);
        const char* nA = has_next ? (const char*)g.A + (size_t)nxt.pm * tstep : cA; const char* nB = has_next ? (const char*)g.Bt + (size_t)nxt.pn * tstep : cB;
        for (int t = 0; t < nt; t += 2) {
            const bool last = (t == nt - 2);
            const char* a1 = cA + (size_t)(t + 1) * kstep;
            const char* a2 = last ? nA : cA + (size_t)(t + 2) * kstep; const char* b2 = last ? nB : cB + (size_t)(t + 2) * kstep;
            const char* a3 = a2 + kstep; const char* b3 = b2 + kstep;
            if (last && has_next) S.a_ready(nxt);
            if constexpr (SP2) {
            PG8_LDB(B0, 0, 0); PG8_LDB(B1, 0, 1); PG8_SCHED; PG8_LDA(At, 0, 0); PG8_STAGE(PG8_SA(1, 1), a1 + hstep, voffA);
            PG8_WAIT_V(8); PG8_WAIT_L(0); PG8_BAR; PG8_MMA(0, 0, At, B0); PG8_MMA(0, 1, At, B1); PG8_BAR; PG8_SCHED;
            PG8_LDA(At, 0, 1); PG8_STAGE(PG8_SB(0, 0), b2, voffB); PG8_STAGE(PG8_SB(0, 1), b2 + hstep, voffB); PG8_STAGE(PG8_SA(0, 0), a2, voffA);
            PG8_WAIT_V(8); PG8_WAIT_L(0); PG8_BAR; PG8_MMA(1, 0, At, B0); PG8_MMA(1, 1, At, B1); PG8_BAR; PG8_SCHED;
            PG8_LDB(B0, 1, 0); PG8_LDB(B1, 1, 1); PG8_SCHED; PG8_LDA(At, 1, 0); PG8_STAGE(PG8_SA(0, 1), a2 + hstep, voffA);
            PG8_WAIT_V(8); PG8_WAIT_L(0); PG8_BAR; PG8_MMA(0, 0, At, B0); PG8_MMA(0, 1, At, B1); PG8_BAR; PG8_SCHED;
            PG8_LDA(At, 1, 1); PG8_STAGE(PG8_SB(1, 0), b3, voffB); PG8_STAGE(PG8_SB(1, 1), b3 + hstep, voffB); PG8_STAGE(PG8_SA(1, 0), a3, voffA);
            PG8_WAIT_V(8); PG8_WAIT_L(0); PG8_BAR; PG8_MMA(1, 0, At, B0); PG8_MMA(1, 1, At, B1); PG8_BAR; PG8_SCHED;
            } else {
            PG8_LDB(B0, 0, 0); PG8_SCHED; PG8_LDA(At, 0, 0); PG8_STAGE(PG8_SA(1, 1), a1 + hstep, voffA);
            PG8_WAIT_L(8); PG8_BAR; PG8_WAIT_L(0); PG8_MMA(0, 0, At, B0); PG8_BAR; PG8_SCHED;
            PG8_LDB(B1, 0, 1); PG8_STAGE(PG8_SB(0, 0), b2, voffB);
            PG8_BAR; PG8_WAIT_L(0); PG8_MMA(0, 1, At, B1); PG8_BAR;
            PG8_LDA(At, 0, 1); PG8_STAGE(PG8_SA(0, 0), a2, voffA);
            PG8_BAR; PG8_WAIT_L(0); PG8_MMA(1, 0, At, B0); PG8_BAR; PG8_SCHED;
            PG8_STAGE(PG8_SB(0, 1), b2 + hstep, voffB);
            PG8_WAIT_V(6); PG8_BAR; PG8_MMA(1, 1, At, B1); PG8_BAR;
            PG8_LDB(B0, 1, 0); PG8_SCHED; PG8_LDA(At, 1, 0); PG8_STAGE(PG8_SA(0, 1), a2 + hstep, voffA);
            PG8_WAIT_L(8); PG8_BAR; PG8_WAIT_L(0); PG8_MMA(0, 0, At, B0); PG8_BAR; PG8_SCHED;
            PG8_LDB(B1, 1, 1); PG8_STAGE(PG8_SB(1, 0), b3, voffB);
            PG8_BAR; PG8_WAIT_L(0); PG8_MMA(0, 1, At, B1); PG8_BAR;
            PG8_LDA(At, 1, 1); PG8_STAGE(PG8_SA(1, 0), a3, voffA);
            PG8_BAR; PG8_WAIT_L(0); PG8_MMA(1, 0, At, B0); PG8_BAR; PG8_SCHED;
            PG8_STAGE(PG8_SB(1, 1), b3 + hstep, voffB);
            PG8_WAIT_V(6); PG8_BAR; PG8_MMA(1, 1, At, B1); PG8_BAR;
            }
        }
        if constexpr (ALIGN_EPI) { if (wr == 0) PG8_BAR; }
        if constexpr (!Epi::AFTER_DRAIN) { E(acc, cur, wr, wc, fr, fq); S.done(cur); }
        if (!has_next) break;
#pragma unroll
        for (int a = 0; a < 2; ++a)
#pragma unroll
            for (int b = 0; b < 2; ++b)
#pragma unroll
                for (int m = 0; m < 4; ++m)
#pragma unroll
                    for (int n = 0; n < 2; ++n) acc[a][b][m][n] = (f32x4){0.f, 0.f, 0.f, 0.f};
        cur = nxt; cA = nA; cB = nB; ++ui;
        if constexpr (ALIGN_EPI) { if (wr == 1) PG8_BAR; }
    }
    PG8_WAIT_V(0);
    if constexpr (!ALIGN_EPI) { if (wr == 0) PG8_BAR; }
    PG8_BAR;
    if constexpr (Epi::AFTER_DRAIN) { E.fused(acc, cur, wr, wc, fr, fq, lds, wid, lane); S.done(cur); }
#undef PG8_SA
#undef PG8_SB
#undef PG8_STAGE
#undef PG8_LDA
#undef PG8_LDB
#undef PG8_MMA
#undef PG8_WAIT_V
#undef PG8_WAIT_L
#undef PG8_BAR
#undef PG8_SCHED
}
}

#define LAS __attribute__((address_space(3)))
typedef unsigned short bf16_t;
typedef short bf16x8 __attribute__((ext_vector_type(8)));
typedef float f32x4 __attribute__((ext_vector_type(4)));
typedef float f32x16 __attribute__((ext_vector_type(16)));
typedef unsigned u32x4 __attribute__((ext_vector_type(4)));
typedef unsigned u32x2 __attribute__((ext_vector_type(2)));

constexpr int DM = 1024, SEQ = 16384, NSMP = 128, MV = SEQ + NSMP, MT = 16640;
constexpr int NIN = 11296, NINP = 11520, DFF = 2816, DIN = 2048, CONVD = 4096;
constexpr int NCHUNK = 264;
constexpr size_t HPN = 32 * 64 * 128;
constexpr int PAST = 4096;

constexpr size_t O_YP = 0, O_YS = O_YP + (size_t)SEQ * DM, O_KP = O_YS + (size_t)NSMP * DM, O_VP = O_KP + 2ull * SEQ * DM,
                 O_CP = O_VP + 2ull * SEQ * DM, O_SP = O_CP + 2ull * 3 * CONVD, O_KS = O_SP + 2ull * HPN, O_VS = O_KS + 2ull * NSMP * DM,
                 O_CS = O_VS + 2ull * NSMP * DM, O_SS = O_CS + 2ull * 8 * 3 * CONVD, O_END = O_SS + 2ull * 8 * HPN;

constexpr size_t MiB = 1ull << 20;
constexpr size_t SZ_WIN = (size_t)NINP * 1024 * 2, SZ_WBA = 1024ull * 1024 * 2, SZ_WBS = 1024ull * 2048 * 2, SZ_WOUT = SZ_WBA,
                 SZ_WGU = 5632ull * 1024 * 2, SZ_WD = 1024ull * DFF * 2;
constexpr size_t WS_CTL = 0, CTL_BYTES = 65536;
constexpr size_t WS_WIN = 1 * MiB, WS_WBA = WS_WIN + 2 * SZ_WIN, WS_WBS = WS_WBA + 2 * SZ_WBA, WS_WOUT = WS_WBS + 2 * SZ_WBS,
                 WS_WGU = WS_WOUT + 2 * SZ_WOUT, WS_WD = WS_WGU + 2 * SZ_WGU, WS_WEND = WS_WD + 2 * SZ_WD;
constexpr size_t WS_KC = (WS_WEND + MiB - 1) / MiB * MiB;
constexpr size_t WS_VTC = WS_KC + 8ull * PAST * 1024 * 2;
constexpr size_t WS_X = WS_VTC + 8ull * PAST * 1024 * 2;
constexpr size_t WS_XB = WS_X + (size_t)MT * 1024 * 4;
constexpr size_t WS_PART = WS_XB + (size_t)MT * 1024 * 2;
constexpr size_t WS_Q = WS_PART + (size_t)MT * 16 * 4;
constexpr size_t WS_K = WS_Q + (size_t)MT * 1024 * 2;
constexpr size_t WS_VT = WS_K + (size_t)MT * 1024 * 2;
constexpr size_t WS_Z = WS_VT + (size_t)MT * 1024 * 2;
constexpr size_t WS_XBC = WS_Z + (size_t)MT * 2048 * 2;
constexpr size_t WS_G = WS_XBC + (size_t)MT * 4096 * 2;
constexpr size_t WS_DT = WS_G + (size_t)MT * 2048 * 2;
constexpr size_t WS_CS = WS_DT + (size_t)MT * 32 * 4;
constexpr size_t WS_CDEC = WS_CS + (size_t)NCHUNK * HPN * 2;
constexpr size_t WS_ATT = WS_CDEC + 65536;
constexpr size_t WS_YSSD = WS_ATT + (size_t)MT * 1024 * 2;
constexpr size_t WS_HIST = WS_YSSD + (size_t)MT * 2048 * 2;
constexpr size_t WS_XTG = WS_HIST + 256ull * 3 * 4096 * 2;
constexpr size_t WS_BTG = WS_XTG + (size_t)NCHUNK * 2048 * 64 * 2;
constexpr size_t WS_ACTS = WS_BTG + (size_t)NCHUNK * 1024 * 64 * 2;
constexpr size_t WS_DTA = WS_ACTS + 256ull * DFF * 2;
constexpr size_t WS_ACSG = WS_DTA + (size_t)NCHUNK * 32 * 64 * 4;
constexpr size_t WS_END = WS_ACSG + (size_t)NCHUNK * 32 * 64 * 4;
static_assert(WS_END <= 1024ull * MiB, "workspace map must fit 1 GiB");

constexpr int LDS_CTL = 131072, LDS_BYTES = 131072 + 1024;
constexpr int AT_KROW = 272, AT_VROW = 144, AT_KSZ = 64 * AT_KROW, AT_VSZ = 128 * AT_VROW, AT_STAGE = AT_KSZ + AT_VSZ;
constexpr int SD_DT = 0, SD_ACS = 1024, SD_RS = 2048, SD_BT = 4096, SD_XT = SD_BT + 128 * 144, SD_CM = SD_XT + 256 * 144, SD_BM = SD_CM + 64 * 272, SD_END = SD_BM + 64 * 272;
static_assert(SD_END <= 131072 && 2 * AT_STAGE <= 131072, "lds");

struct Args { const float* in[26]; float* out; unsigned char* ws; int ph_lo, ph_hi; };

__device__ __forceinline__ unsigned pk_bf16(float lo, float hi) {
    typedef float f2 __attribute__((ext_vector_type(2))); typedef __bf16 b2 __attribute__((ext_vector_type(2)));
    f2 v = {lo, hi}; b2 b = __builtin_convertvector(v, b2); return __builtin_bit_cast(unsigned, b);
}
__device__ __forceinline__ float bf_lo(unsigned u) { return __uint_as_float(u << 16); }
__device__ __forceinline__ float bf_hi(unsigned u) { return __uint_as_float(u & 0xffff0000u); }
__device__ __forceinline__ float fexp2(float x) { return __builtin_amdgcn_exp2f(x); }
__device__ __forceinline__ float fexp(float x) { return __builtin_amdgcn_exp2f(x * 1.4426950408889634f); }
__device__ __forceinline__ float frcp(float x) { return __builtin_amdgcn_rcpf(x); }
__device__ __forceinline__ float silu_f(float x) { return x * frcp(1.0f + fexp(-x)); }
__device__ __forceinline__ float sigmoid_f(float x) { return frcp(1.0f + fexp(-x)); }
__device__ __forceinline__ float wave_sum(float v) {
#pragma unroll
    for (int o = 1; o < 64; o <<= 1) v += __shfl_xor(v, o);
    return v;
}
__device__ __forceinline__ int sig5(int i) { return (i & ~12) | ((i & 4) << 1) | ((i & 8) >> 1); }
__device__ __forceinline__ float rstd1(const float* rss, int row, float eps) { return 1.0f / sqrtf(rss[row] * (1.0f / 1024.0f) + eps); }
__device__ __forceinline__ float rstd_row(const float* part, int row, float eps) {
    const f32x4* p = (const f32x4*)(part + (size_t)row * 16);
    const f32x4 a = p[0], b = p[1], c = p[2], d = p[3];
    const float s = ((a.x + a.y) + (a.z + a.w)) + ((b.x + b.y) + (b.z + b.w)) + ((c.x + c.y) + (c.z + c.w)) + ((d.x + d.y) + (d.z + d.w));
    return 1.0f / sqrtf(s * (1.0f / 1024.0f) + eps);
}
__device__ __forceinline__ float max3f(float a, float b, float c) { float r; asm("v_max3_f32 %0, %1, %2, %3" : "=v"(r) : "v"(a), "v"(b), "v"(c)); return r; }
#define MFMA32(a, b, c) __builtin_amdgcn_mfma_f32_32x32x16_bf16((a), (b), (c), 0, 0, 0)

#define EPI_LOOP_ROWS _Pragma("unroll") for (int ai = 0; ai < 2; ++ai) _Pragma("unroll") for (int m = 0; m < 4; ++m)
#define EPI_LOOP_COLS _Pragma("unroll") for (int bj = 0; bj < 2; ++bj) _Pragma("unroll") for (int n = 0; n < 2; ++n)

struct EpiIn {
    static constexpr bool PERM = true, AFTER_DRAIN = false;
    const float* part; bf16_t *Q, *K, *VT, *Z, *XBC, *G; float* DT; float* out; int layer; bf16_t* HIST;
    __device__ __forceinline__ void operator()(const pg8::f32x4 (&acc)[2][2][4][2], const pg8::Unit& u, int wr, int wc, int fr, int fq) const {
        const int pn = u.pn; const int cb = pn * 256 + wc * 32 + 8 * fq;
        float rsv[2][4];
#pragma unroll
        for (int ai = 0; ai < 2; ++ai)
#pragma unroll
            for (int m = 0; m < 4; ++m) rsv[ai][m] = part[u.pm * 256 + ai * 128 + wr * 64 + m * 16 + fr];
#pragma unroll
        for (int ai = 0; ai < 2; ++ai)
#pragma unroll
            for (int m = 0; m < 4; ++m) rsv[ai][m] = 1.0f / sqrtf(rsv[ai][m] * (1.0f / 1024.0f) + 1e-6f);
        EPI_LOOP_ROWS {
            const int row = u.pm * 256 + ai * 128 + wr * 64 + m * 16 + fr;
            const float rs = rsv[ai][m];
#pragma unroll
            for (int bj = 0; bj < 2; ++bj) {
                const pg8::f32x4 v0 = acc[ai][bj][m][0] * rs, v1 = acc[ai][bj][m][1] * rs; const int col = cb + bj * 128;
                if (pn < 4) {
                    const float sc = 0.125f * 1.4426950408889634f;
                    u32x4 w; w.x = pk_bf16(v0[0] * sc, v0[1] * sc); w.y = pk_bf16(v0[2] * sc, v0[3] * sc); w.z = pk_bf16(v1[0] * sc, v1[1] * sc); w.w = pk_bf16(v1[2] * sc, v1[3] * sc);
                    *(u32x4*)(Q + (size_t)row * 1024 + col) = w;
                } else if (pn < 8) {
                    const int c = col - 1024; u32x4 w; w.x = pk_bf16(v0[0], v0[1]); w.y = pk_bf16(v0[2], v0[3]); w.z = pk_bf16(v1[0], v1[1]); w.w = pk_bf16(v1[2], v1[3]);
                    *(u32x4*)(K + (size_t)row * 1024 + c) = w;
                    float* o = nullptr;
                    if (row < SEQ) o = out + O_KP + ((size_t)layer * SEQ + row) * 1024 + c; else if (row < MV) o = out + O_KS + ((size_t)layer * NSMP + (row - SEQ)) * 1024 + c;
                    if (o) { *(pg8::f32x4*)o = v0; *(pg8::f32x4*)(o + 4) = v1; }
                } else if (pn < 12) {
                    const int c = col - 2048;
                    const unsigned w0 = pk_bf16(v0[0], v0[1]), w1 = pk_bf16(v0[2], v0[3]), w2 = pk_bf16(v1[0], v1[1]), w3 = pk_bf16(v1[2], v1[3]);
                    VT[(size_t)(c + 0) * MT + row] = (bf16_t)(w0 & 0xffffu); VT[(size_t)(c + 1) * MT + row] = (bf16_t)(w0 >> 16);
                    VT[(size_t)(c + 2) * MT + row] = (bf16_t)(w1 & 0xffffu); VT[(size_t)(c + 3) * MT + row] = (bf16_t)(w1 >> 16);
                    VT[(size_t)(c + 4) * MT + row] = (bf16_t)(w2 & 0xffffu); VT[(size_t)(c + 5) * MT + row] = (bf16_t)(w2 >> 16);
                    VT[(size_t)(c + 6) * MT + row] = (bf16_t)(w3 & 0xffffu); VT[(size_t)(c + 7) * MT + row] = (bf16_t)(w3 >> 16);
                    float* o = nullptr;
                    if (row < SEQ) o = out + O_VP + ((size_t)layer * SEQ + row) * 1024 + c; else if (row < MV) o = out + O_VS + ((size_t)layer * NSMP + (row - SEQ)) * 1024 + c;
                    if (o) { *(pg8::f32x4*)o = v0; *(pg8::f32x4*)(o + 4) = v1; }
                } else if (pn < 20) {
                    const int c = col - 3072; u32x4 w; w.x = pk_bf16(v0[0], v0[1]); w.y = pk_bf16(v0[2], v0[3]); w.z = pk_bf16(v1[0], v1[1]); w.w = pk_bf16(v1[2], v1[3]);
                    *(u32x4*)(Z + (size_t)row * 2048 + c) = w;
                } else if (pn < 36) {
                    const int c = col - 5120; u32x4 w; w.x = pk_bf16(v0[0], v0[1]); w.y = pk_bf16(v0[2], v0[3]); w.z = pk_bf16(v1[0], v1[1]); w.w = pk_bf16(v1[2], v1[3]);
                    *(u32x4*)(XBC + (size_t)row * 4096 + c) = w;
                    if (row < SEQ && (row & 63) >= 61) *(u32x4*)(HIST + ((size_t)(row >> 6) * 3 + ((row & 63) - 61)) * 4096 + c) = w;
                    float* o = nullptr;
                    if (row >= SEQ - 3 && row < SEQ) o = out + O_CP + ((size_t)layer * 3 + (row - (SEQ - 3))) * 4096 + c;
                    else if (row >= SEQ && row < MV) { const int s = row - SEQ, t = s & 15; if (t >= 13) o = out + O_CS + (((size_t)layer * 8 + (s >> 4)) * 3 + (t - 13)) * 4096 + c; }
                    if (o) { *(pg8::f32x4*)o = v0; *(pg8::f32x4*)(o + 4) = v1; }
                } else if (pn < 44) {
                    const int c = col - 9216; u32x4 w; w.x = pk_bf16(sigmoid_f(v0[0]), sigmoid_f(v0[1])); w.y = pk_bf16(sigmoid_f(v0[2]), sigmoid_f(v0[3]));
                    w.z = pk_bf16(sigmoid_f(v1[0]), sigmoid_f(v1[1])); w.w = pk_bf16(sigmoid_f(v1[2]), sigmoid_f(v1[3]));
                    *(u32x4*)(G + (size_t)row * 2048 + c) = w;
                } else {
                    const int c = col - 11264;
                    if (c < 32) { *(pg8::f32x4*)(DT + (size_t)row * 32 + c) = v0; *(pg8::f32x4*)(DT + (size_t)row * 32 + c + 4) = v1; }
                }
            }
        }
    }
};

struct EpiNull {
    static constexpr bool PERM = false, AFTER_DRAIN = false; float* sink;
    __device__ __forceinline__ void operator()(const pg8::f32x4 (&acc)[2][2][4][2], const pg8::Unit& u, int wr, int wc, int fr, int fq) const {
        pg8::f32x4 s = acc[0][0][0][0];
        EPI_LOOP_ROWS { EPI_LOOP_COLS { s += acc[ai][bj][m][n]; } }
        if (s[0] == 123456.789f) sink[0] = s[1] + s[2] + s[3];
    }
};
struct EpiBrA {
    static constexpr bool PERM = false, AFTER_DRAIN = false;
    const bf16_t* G; float* MF; int row0;
    __device__ __forceinline__ void operator()(const pg8::f32x4 (&acc)[2][2][4][2], const pg8::Unit& u, int wr, int wc, int fr, int fq) const {
        const int cb = u.pn * 256 + wc * 32 + 4 * fq;
        EPI_LOOP_ROWS { const int row = row0 + u.pm * 256 + ai * 128 + wr * 64 + m * 16 + fr;
            EPI_LOOP_COLS { const int col = cb + bj * 128 + n * 16; const u32x2 g = *(const u32x2*)(G + (size_t)row * 2048 + col);
                pg8::f32x4 v = acc[ai][bj][m][n]; v[0] *= bf_lo(g.x); v[1] *= bf_hi(g.x); v[2] *= bf_lo(g.y); v[3] *= bf_hi(g.y);
                *(pg8::f32x4*)(MF + (size_t)row * 1024 + col) = v; } }
    }
};
struct EpiBrB {
    static constexpr bool PERM = false, AFTER_DRAIN = false;
    const bf16_t* G; const float* MF; bf16_t* MB; int row0;
    __device__ __forceinline__ void operator()(const pg8::f32x4 (&acc)[2][2][4][2], const pg8::Unit& u, int wr, int wc, int fr, int fq) const {
        const int cb = u.pn * 256 + wc * 32 + 4 * fq;
        EPI_LOOP_ROWS { const int row = row0 + u.pm * 256 + ai * 128 + wr * 64 + m * 16 + fr;
            EPI_LOOP_COLS { const int col = cb + bj * 128 + n * 16; const u32x2 g = *(const u32x2*)(G + (size_t)row * 2048 + 1024 + col);
                const pg8::f32x4 a = acc[ai][bj][m][n]; const pg8::f32x4 o = *(const pg8::f32x4*)(MF + (size_t)row * 1024 + col);
                u32x2 w; w.x = pk_bf16(o[0] + a[0] * bf_lo(g.x), o[1] + a[1] * bf_hi(g.x)); w.y = pk_bf16(o[2] + a[2] * bf_lo(g.y), o[3] + a[3] * bf_hi(g.y));
                *(u32x2*)(MB + (size_t)row * 1024 + col) = w; } }
    }
};
struct EpiRes {
    static constexpr bool PERM = false, AFTER_DRAIN = false;
    float* X; bf16_t* XB; float* part; int row0;
    __device__ __forceinline__ void operator()(const pg8::f32x4 (&acc)[2][2][4][2], const pg8::Unit& u, int wr, int wc, int fr, int fq) const {
        const int cb = u.pn * 256 + wc * 32 + 4 * fq;
        EPI_LOOP_ROWS { const int row = row0 + u.pm * 256 + ai * 128 + wr * 64 + m * 16 + fr; float ss = 0.f;
            EPI_LOOP_COLS { const int col = cb + bj * 128 + n * 16; float* xp = X + (size_t)row * 1024 + col;
                const pg8::f32x4 x = *(const pg8::f32x4*)xp + acc[ai][bj][m][n];
                *(pg8::f32x4*)xp = x; u32x2 w; w.x = pk_bf16(x[0], x[1]); w.y = pk_bf16(x[2], x[3]); *(u32x2*)(XB + (size_t)row * 1024 + col) = w;
                ss += (x[0] * x[0] + x[1] * x[1]) + (x[2] * x[2] + x[3] * x[3]); }
            ss += __shfl_xor(ss, 16); ss += __shfl_xor(ss, 32);
            if (fq == 0) atomicAdd(part + row, ss); }
    }
};
struct EpiGU {
    static constexpr bool PERM = true, AFTER_DRAIN = false;
    const float* part; bf16_t* ACT; int row0; int act_sub;
    __device__ __forceinline__ void operator()(const pg8::f32x4 (&acc)[2][2][4][2], const pg8::Unit& u, int wr, int wc, int fr, int fq) const {
        const int cb = u.pn * 128 + wc * 32 + 8 * fq;
        float rsv[2][4];
#pragma unroll
        for (int ai = 0; ai < 2; ++ai)
#pragma unroll
            for (int m = 0; m < 4; ++m) rsv[ai][m] = part[row0 + u.pm * 256 + ai * 128 + wr * 64 + m * 16 + fr];
#pragma unroll
        for (int ai = 0; ai < 2; ++ai)
#pragma unroll
            for (int m = 0; m < 4; ++m) rsv[ai][m] = 1.0f / sqrtf(rsv[ai][m] * (1.0f / 1024.0f) + 1e-6f);
        EPI_LOOP_ROWS { const int row = row0 - act_sub + u.pm * 256 + ai * 128 + wr * 64 + m * 16 + fr; const float rs = rsv[ai][m];
            const pg8::f32x4 g0 = acc[ai][0][m][0] * rs, g1 = acc[ai][0][m][1] * rs, u0 = acc[ai][1][m][0] * rs, u1 = acc[ai][1][m][1] * rs;
            u32x4 w; w.x = pk_bf16(silu_f(g0[0]) * u0[0], silu_f(g0[1]) * u0[1]); w.y = pk_bf16(silu_f(g0[2]) * u0[2], silu_f(g0[3]) * u0[3]);
            w.z = pk_bf16(silu_f(g1[0]) * u1[0], silu_f(g1[1]) * u1[1]); w.w = pk_bf16(silu_f(g1[2]) * u1[2], silu_f(g1[3]) * u1[3]);
            *(u32x4*)(ACT + (size_t)row * DFF + cb) = w; }
    }
};

struct Ctx {
    LAS unsigned char* lds; int tid, lane, wid, G, bid;
    const float* in[26]; float* out; unsigned char* ws;
};
#define WSP(T, off) ((T*)(C.ws + (off)))

struct TItem { const float* W; int N, k0, n0; bf16_t* WT; size_t dst_row0; int Kd; const float* kscale; };
struct TRegs { float tv[32]; f32x4 s0, s1; };
__device__ __forceinline__ void tr_load(const TItem& t, TRegs& r, int lane) {
#pragma unroll
    for (int i = 0; i < 32; ++i) r.tv[i] = t.W[(size_t)(t.k0 + 2 * i + (lane >> 5)) * t.N + t.n0 + (lane & 31)];
    if (t.kscale) { r.s0 = *(const f32x4*)(t.kscale + t.k0 + 8 * (lane & 7)); r.s1 = *(const f32x4*)(t.kscale + t.k0 + 8 * (lane & 7) + 4); }
    else { r.s0 = (f32x4){1.f, 1.f, 1.f, 1.f}; r.s1 = r.s0; }
}
__device__ __forceinline__ void tr_finish(const TItem& t, const TRegs& r, LAS float* scr, int lane) {
#pragma unroll
    for (int i = 0; i < 32; ++i) scr[(2 * i + (lane >> 5)) * 33 + (lane & 31)] = r.tv[i];
    asm volatile("s_waitcnt lgkmcnt(0)" ::: "memory");
    const int c = lane & 7;
#pragma unroll
    for (int j = 0; j < 4; ++j) { const int n = (lane >> 3) + 8 * j; const LAS float* s = scr + (8 * c) * 33 + n;
        u32x4 o; o.x = pk_bf16(s[0 * 33] * r.s0.x, s[1 * 33] * r.s0.y); o.y = pk_bf16(s[2 * 33] * r.s0.z, s[3 * 33] * r.s0.w);
        o.z = pk_bf16(s[4 * 33] * r.s1.x, s[5 * 33] * r.s1.y); o.w = pk_bf16(s[6 * 33] * r.s1.z, s[7 * 33] * r.s1.w);
        *(u32x4*)(t.WT + (t.dst_row0 + n) * (size_t)t.Kd + t.k0 + 8 * c) = o; }
    asm volatile("s_waitcnt lgkmcnt(0)" ::: "memory");
}
__device__ __forceinline__ bool p0_item(const Ctx& C, int it, TItem& t) {
    constexpr int I_IN = 16 * 353, I_BA = 16 * 32, I_BS = 32 * 32, I_OUT = 16 * 32, I_GU = 16 * 176, I_D = 44 * 32, I_L = I_IN + I_BA + I_BS + I_OUT + I_GU + I_D;
    if (it >= 2 * I_L) return false;
    const int L = it / I_L; int r = it % I_L; t.kscale = nullptr;
    if (r < I_IN) { const int kb = r / 353, nb = r % 353, n0 = 32 * nb;
        t.W = C.in[7] + (size_t)L * 1024 * NIN; t.N = NIN; t.k0 = 64 * kb; t.n0 = n0; t.WT = WSP(bf16_t, WS_WIN + L * SZ_WIN);
        t.dst_row0 = n0 < 9216 ? n0 : (n0 < 9248 ? 11264 + (n0 - 9216) : 9216 + (n0 - 9248)); t.Kd = 1024; t.kscale = C.in[6] + L * 1024; return true; }
    r -= I_IN;
    if (r < I_BA) { t.W = C.in[19] + (size_t)L * 1024 * 1024; t.N = 1024; t.k0 = 64 * (r / 32); t.n0 = 32 * (r % 32); t.WT = WSP(bf16_t, WS_WBA + L * SZ_WBA); t.dst_row0 = t.n0; t.Kd = 1024; return true; }
    r -= I_BA;
    if (r < I_BS) { t.W = C.in[20] + (size_t)L * 2048 * 1024; t.N = 1024; t.k0 = 64 * (r / 32); t.n0 = 32 * (r % 32); t.WT = WSP(bf16_t, WS_WBS + L * SZ_WBS); t.dst_row0 = t.n0; t.Kd = 2048; return true; }
    r -= I_BS;
    if (r < I_OUT) { t.W = C.in[21] + (size_t)L * 1024 * 1024; t.N = 1024; t.k0 = 64 * (r / 32); t.n0 = 32 * (r % 32); t.WT = WSP(bf16_t, WS_WOUT + L * SZ_WOUT); t.dst_row0 = t.n0; t.Kd = 1024; return true; }
    r -= I_OUT;
    if (r < I_GU) { const int kb = r / 176, nb = r % 176, n0 = 32 * nb; const int ch = n0 % DFF;
        t.W = C.in[23] + (size_t)L * 1024 * 5632; t.N = 5632; t.k0 = 64 * kb; t.n0 = n0; t.WT = WSP(bf16_t, WS_WGU + L * SZ_WGU);
        t.dst_row0 = 256 * (ch / 128) + (ch % 128) + (n0 >= DFF ? 128 : 0); t.Kd = 1024; t.kscale = C.in[22] + L * 1024; return true; }
    r -= I_GU;
    t.W = C.in[24] + (size_t)L * DFF * 1024; t.N = 1024; t.k0 = 64 * (r / 32); t.n0 = 32 * (r % 32); t.WT = WSP(bf16_t, WS_WD + L * SZ_WD); t.dst_row0 = t.n0; t.Kd = DFF; return true;
}

__device__ __forceinline__ void phase_p0(Ctx& C) {
    LAS float* scr = (LAS float*)(C.lds + C.wid * 8704);
    const int gw = C.bid * 8 + C.wid, NGW = C.G * 8;
    {   TItem cur, nxt; TRegs ra, rb; int it = gw;
        bool have = p0_item(C, it, cur); if (have) tr_load(cur, ra, C.lane);
        while (have) { it += NGW; const bool hn = p0_item(C, it, nxt); if (hn) tr_load(nxt, rb, C.lane);
            tr_finish(cur, ra, scr, C.lane); cur = nxt; ra = rb; have = hn; } }
    {   const int nz = 2 * (NINP - NIN) * 1024 / 8;
        for (int i = C.bid * 512 + C.tid; i < nz; i += C.G * 512) { const int L = i / ((NINP - NIN) * 128), r = i % ((NINP - NIN) * 128);
            *(u32x4*)(WSP(bf16_t, WS_WIN + L * SZ_WIN) + (size_t)NIN * 1024 + (size_t)r * 8) = (u32x4){0u, 0u, 0u, 0u}; } }
    float* X = WSP(float, WS_X); bf16_t* XB = WSP(bf16_t, WS_XB); float* PART = WSP(float, WS_PART);
    for (int mrow = gw; mrow < MT; mrow += NGW) {
        f32x4 v[4]; float ss = 0.f;
#pragma unroll
        for (int j = 0; j < 4; ++j) {
            if (mrow < SEQ) v[j] = *(const f32x4*)(C.in[0] + (size_t)mrow * 1024 + 4 * C.lane + 256 * j);
            else if (mrow < MV) v[j] = *(const f32x4*)(C.in[1] + (size_t)(mrow - SEQ) * 1024 + 4 * C.lane + 256 * j);
            else v[j] = (f32x4){0.f, 0.f, 0.f, 0.f};
            ss += (v[j].x * v[j].x + v[j].y * v[j].y) + (v[j].z * v[j].z + v[j].w * v[j].w);
            *(f32x4*)(X + (size_t)mrow * 1024 + 4 * C.lane + 256 * j) = v[j];
            u32x2 w; w.x = pk_bf16(v[j].x, v[j].y); w.y = pk_bf16(v[j].z, v[j].w);
            *(u32x2*)(XB + (size_t)mrow * 1024 + 4 * C.lane + 256 * j) = w;
        }
        ss = wave_sum(ss);
        if (C.lane < 5) PART[(size_t)C.lane * MT + mrow] = (C.lane == 0) ? ss : 0.f;
    }
}

__device__ __forceinline__ void cache_convert(Ctx& C, int L) {
    const float* ck = C.in[2] + (size_t)L * 8 * PAST * 1024; bf16_t* KC = WSP(bf16_t, WS_KC);
    const int ntask = 8 * PAST * 1024 / 8;
    {   const int stride = C.G * 512;
        for (int i0 = C.bid * 512 + C.tid; i0 < ntask; i0 += 4 * stride) { f32x4 a[4], b[4];
#pragma unroll
            for (int j = 0; j < 4; ++j) { const int i = i0 + j * stride; if (i < ntask) { a[j] = *(const f32x4*)(ck + (size_t)i * 8); b[j] = *(const f32x4*)(ck + (size_t)i * 8 + 4); } }
#pragma unroll
            for (int j = 0; j < 4; ++j) { const int i = i0 + j * stride; if (i < ntask) { u32x4 o; o.x = pk_bf16(a[j].x, a[j].y); o.y = pk_bf16(a[j].z, a[j].w); o.z = pk_bf16(b[j].x, b[j].y); o.w = pk_bf16(b[j].z, b[j].w);
                *(u32x4*)(KC + (size_t)i * 8) = o; } } } }
    LAS float* scr = (LAS float*)(C.lds + C.wid * 8704);
    const int gw = C.bid * 8 + C.wid, NGW = C.G * 8;
    {   TItem cur, nxt; TRegs ra, rb; int it = gw;
#define CV_ITEM(IT, T) ((IT) < 8 * 2048 ? ((T).W = C.in[3] + ((size_t)L * 8 + (IT) / 2048) * PAST * 1024, (T).N = 1024, (T).k0 = 64 * (((IT) % 2048) / 32), (T).n0 = 32 * ((IT) % 32), \
            (T).WT = WSP(bf16_t, WS_VTC) + (size_t)((IT) / 2048) * 1024 * PAST, (T).dst_row0 = (size_t)(T).n0, (T).Kd = PAST, (T).kscale = nullptr, true) : false)
        bool have = CV_ITEM(it, cur); if (have) tr_load(cur, ra, C.lane);
        while (have) { it += NGW; const bool hn = CV_ITEM(it, nxt); if (hn) tr_load(nxt, rb, C.lane);
            tr_finish(cur, ra, scr, C.lane); cur = nxt; ra = rb; have = hn; }
#undef CV_ITEM
    }
}

struct ChunkInfo { int base, Lc, mode; const float* hist; };
__device__ __forceinline__ ChunkInfo chunk_info(const Ctx& C, int L, int c) {
    ChunkInfo ci;
    if (c < 256) { ci.base = 64 * c; ci.Lc = 64; ci.mode = (c == 0) ? 1 : 0; ci.hist = nullptr; }
    else { const int b = c - 256; ci.base = SEQ + 16 * b; ci.Lc = 16; ci.mode = 2; ci.hist = C.in[4] + ((size_t)L * 8 + b) * 3 * CONVD; }
    return ci;
}
__device__ __forceinline__ void conv_t8(const bf16_t* XBC, const ChunkInfo& ci, const float* cw, const float* cbias, int col, int l0, float (&o0)[8], float (&o1)[8]) {
    float i0[11], i1[11];
#pragma unroll
    for (int i = 0; i < 11; ++i) { const int rr = l0 - 3 + i;
        if (rr >= 0 || ci.mode == 0) { const unsigned v = *(const unsigned*)(XBC + (size_t)(ci.base + rr) * 4096 + col); i0[i] = bf_lo(v); i1[i] = bf_hi(v); }
        else if (ci.mode == 1) { i0[i] = 0.f; i1[i] = 0.f; }
        else { const float* hp = ci.hist + (size_t)(3 + rr) * 4096 + col; i0[i] = hp[0]; i1[i] = hp[1]; } }
    float w0[4], w1[4];
#pragma unroll
    for (int j = 0; j < 4; ++j) { w0[j] = cw[j * 4096 + col]; w1[j] = cw[j * 4096 + col + 1]; }
    const float b0 = cbias[col], b1 = cbias[col + 1];
#pragma unroll
    for (int k = 0; k < 8; ++k) { float a0 = b0, a1 = b1;
#pragma unroll
        for (int j = 0; j < 4; ++j) { a0 += w0[j] * i0[k + j]; a1 += w1[j] * i1[k + j]; }
        o0[k] = silu_f(a0); o1[k] = silu_f(a1); }
}
__device__ __forceinline__ void conv_n8(const bf16_t* XBC, const ChunkInfo& ci, const float* cw, const float* cbias, int col, int l, float (&o)[8]) {
    { const f32x4 b0 = *(const f32x4*)(cbias + col), b1 = *(const f32x4*)(cbias + col + 4);
      o[0] = b0.x; o[1] = b0.y; o[2] = b0.z; o[3] = b0.w; o[4] = b1.x; o[5] = b1.y; o[6] = b1.z; o[7] = b1.w; }
#pragma unroll
    for (int j = 0; j < 4; ++j) { const int rr = l - 3 + j; float x[8];
        if (rr >= 0 || ci.mode == 0) { const u32x4 v = *(const u32x4*)(XBC + (size_t)(ci.base + rr) * 4096 + col);
            x[0] = bf_lo(v.x); x[1] = bf_hi(v.x); x[2] = bf_lo(v.y); x[3] = bf_hi(v.y); x[4] = bf_lo(v.z); x[5] = bf_hi(v.z); x[6] = bf_lo(v.w); x[7] = bf_hi(v.w); }
        else if (ci.mode == 1) {
#pragma unroll
            for (int q = 0; q < 8; ++q) x[q] = 0.f; }
        else { const float* hp = ci.hist + (size_t)(3 + rr) * 4096 + col; const f32x4 h0 = *(const f32x4*)hp, h1 = *(const f32x4*)(hp + 4);
            x[0] = h0.x; x[1] = h0.y; x[2] = h0.z; x[3] = h0.w; x[4] = h1.x; x[5] = h1.y; x[6] = h1.z; x[7] = h1.w; }
        const f32x4 wa = *(const f32x4*)(cw + j * 4096 + col), wb = *(const f32x4*)(cw + j * 4096 + col + 4);
        o[0] += wa.x * x[0]; o[1] += wa.y * x[1]; o[2] += wa.z * x[2]; o[3] += wa.w * x[3]; o[4] += wb.x * x[4]; o[5] += wb.y * x[5]; o[6] += wb.z * x[6]; o[7] += wb.w * x[7]; }
#pragma unroll
    for (int q = 0; q < 8; ++q) o[q] = silu_f(o[q]);
}
__device__ __forceinline__ void ssd_dt_acs(Ctx& C, int L, const ChunkInfo& ci, int c, int g, bool write_cdec) {
    if (C.wid < 4) { const int h = 4 * g + C.wid, l = C.lane;
        const float raw = WSP(const float, WS_DT)[(size_t)(ci.base + l) * 32 + h] + C.in[15][L * 32 + h];
        float dt = raw > 20.f ? raw : log1pf(expf(raw)); if (l >= ci.Lc) dt = 0.f;
        const float A = -expf(C.in[16][L * 32 + h]); float a = dt * A;
#pragma unroll
        for (int o = 1; o < 64; o <<= 1) { const float t = __shfl_up(a, o); if (l >= o) a += t; }
        ((LAS float*)(C.lds + SD_DT))[C.wid * 64 + l] = dt; ((LAS float*)(C.lds + SD_ACS))[C.wid * 64 + l] = a;
        if (write_cdec && l == 63) WSP(float, WS_CDEC)[c * 32 + h] = expf(a);
    }
}
__device__ __forceinline__ void st8_bf16(LAS unsigned char* p, const float (&o)[8]) {
    u32x4 w; w.x = pk_bf16(o[0], o[1]); w.y = pk_bf16(o[2], o[3]); w.z = pk_bf16(o[4], o[5]); w.w = pk_bf16(o[6], o[7]); *(LAS u32x4*)p = w;
}

__device__ __forceinline__ void conv_unit(Ctx& C, int L, int c, int slab) {
    const ChunkInfo ci = chunk_info(C, L, c);
    bf16_t* XBC = WSP(bf16_t, WS_XBC); const bf16_t* HIST = WSP(const bf16_t, WS_HIST);
    const float* cw = C.in[13] + (size_t)L * 4 * CONVD; const float* cbias = C.in[14] + (size_t)L * CONVD;
    const int col0 = slab * 512;
    {   u32x4 v[8];
#pragma unroll
        for (int k = 0; k < 8; ++k) { const int idx = C.tid + 512 * k; v[k] = *(const u32x4*)(XBC + (size_t)(ci.base + (idx >> 6)) * 4096 + col0 + (idx & 63) * 8); }
        if (C.tid < 192) { const int r = C.tid >> 6, c16 = C.tid & 63; u32x4 hv;
            if (ci.mode == 1) hv = (u32x4){0u, 0u, 0u, 0u};
            else if (ci.mode == 0) hv = *(const u32x4*)(HIST + ((size_t)(c - 1) * 3 + r) * 4096 + col0 + c16 * 8);
            else { const float* hp = ci.hist + (size_t)r * 4096 + col0 + c16 * 8; const f32x4 a = *(const f32x4*)hp, b = *(const f32x4*)(hp + 4);
                hv.x = pk_bf16(a.x, a.y); hv.y = pk_bf16(a.z, a.w); hv.z = pk_bf16(b.x, b.y); hv.w = pk_bf16(b.z, b.w); }
            *(LAS u32x4*)(C.lds + r * 1024 + c16 * 16) = hv; }
#pragma unroll
        for (int k = 0; k < 8; ++k) { const int idx = C.tid + 512 * k; *(LAS u32x4*)(C.lds + (3 + (idx >> 6)) * 1024 + (idx & 63) * 16) = v[k]; }
    }
    __syncthreads();
#pragma unroll 1
    for (int i = 0; i < 4; ++i) { const int task = C.tid + 512 * i, p = task & 255, lb = task >> 8, l0 = 8 * lb, col = col0 + 2 * p;
        float i0[11], i1[11];
#pragma unroll
        for (int k = 0; k < 11; ++k) { const unsigned v = *(const LAS unsigned*)(C.lds + (l0 + k) * 1024 + p * 4); i0[k] = bf_lo(v); i1[k] = bf_hi(v); }
        float w0[4], w1[4];
#pragma unroll
        for (int j = 0; j < 4; ++j) { const float2 w = *(const float2*)(cw + j * 4096 + col); w0[j] = w.x; w1[j] = w.y; }
        const float2 bb = *(const float2*)(cbias + col);
        float o0[8], o1[8];
#pragma unroll
        for (int k = 0; k < 8; ++k) { float a0 = bb.x, a1 = bb.y;
#pragma unroll
            for (int j = 0; j < 4; ++j) { a0 += w0[j] * i0[k + j]; a1 += w1[j] * i1[k + j]; }
            o0[k] = silu_f(a0); o1[k] = silu_f(a1); }
        if (slab < 6) {
            const int ch_ = (slab < 4) ? col : col - 2048;
            bf16_t* dst = ((slab < 4) ? WSP(bf16_t, WS_XTG) + (size_t)c * 2048 * 64 : WSP(bf16_t, WS_BTG) + (size_t)c * 1024 * 64) + ((((size_t)(ch_ >> 5)) * 4 + (lb >> 1)) * 64 + (lb & 1) * 32 + (ch_ & 31)) * 8;
            u32x4 w; w.x = pk_bf16(o0[0], o0[1]); w.y = pk_bf16(o0[2], o0[3]); w.z = pk_bf16(o0[4], o0[5]); w.w = pk_bf16(o0[6], o0[7]); *(u32x4*)dst = w;
            w.x = pk_bf16(o1[0], o1[1]); w.y = pk_bf16(o1[2], o1[3]); w.z = pk_bf16(o1[4], o1[5]); w.w = pk_bf16(o1[6], o1[7]); *(u32x4*)(dst + 8) = w;
        }
        if (slab >= 4) {
#pragma unroll
            for (int k = 0; k < 8; ++k) if (l0 + k < ci.Lc) *(unsigned*)(XBC + (size_t)(ci.base + l0 + k) * 4096 + col) = pk_bf16(o0[k], o1[k]);
        }
    }
    __syncthreads();
}

__device__ __forceinline__ void ssd_s1_wave(Ctx& C, int L, int c, int h) {
    const ChunkInfo ci = chunk_info(C, L, c);
    const int l = C.lane, q32 = C.lane & 31, hi = C.lane >> 5, g = h >> 2;
    const float raw = WSP(const float, WS_DT)[(size_t)(ci.base + l) * 32 + h] + C.in[15][L * 32 + h];
    float dt = raw > 20.f ? raw : log1pf(expf(raw)); if (l >= ci.Lc) dt = 0.f;
    const float A = -expf(C.in[16][L * 32 + h]); float a = dt * A;
#pragma unroll
    for (int o = 1; o < 64; o <<= 1) { const float t = __shfl_up(a, o); if (l >= o) a += t; }
    WSP(float, WS_DTA)[((size_t)c * 32 + h) * 64 + l] = dt; WSP(float, WS_ACSG)[((size_t)c * 32 + h) * 64 + l] = a;
    const float aend = __shfl(a, 63);
    const float w = dt * fexp(aend - a);
    if (l == 63) WSP(float, WS_CDEC)[c * 32 + h] = expf(a);
    const bf16_t* xt = WSP(const bf16_t, WS_XTG) + (size_t)c * 2048 * 64 + ((size_t)(2 * h) * 4 * 64 + C.lane) * 8;
    const bf16_t* bt = WSP(const bf16_t, WS_BTG) + (size_t)c * 1024 * 64 + ((size_t)(4 * g) * 4 * 64 + C.lane) * 8;
    f32x16 acc[2][4];
#pragma unroll
    for (int ph = 0; ph < 2; ++ph)
#pragma unroll
        for (int nt = 0; nt < 4; ++nt) acc[ph][nt] = (f32x16){};
#pragma unroll
    for (int ks = 0; ks < 4; ++ks) {
        float wv[8];
#pragma unroll
        for (int j = 0; j < 8; ++j) wv[j] = __shfl(w, 16 * ks + 8 * hi + j);
        bf16x8 bfr[2];
#pragma unroll
        for (int ph = 0; ph < 2; ++ph) { const u32x4 r = *(const u32x4*)(xt + (ph * 4 + ks) * 512);
            u32x4 o; o.x = pk_bf16(bf_lo(r.x) * wv[0], bf_hi(r.x) * wv[1]); o.y = pk_bf16(bf_lo(r.y) * wv[2], bf_hi(r.y) * wv[3]);
            o.z = pk_bf16(bf_lo(r.z) * wv[4], bf_hi(r.z) * wv[5]); o.w = pk_bf16(bf_lo(r.w) * wv[6], bf_hi(r.w) * wv[7]); bfr[ph] = __builtin_bit_cast(bf16x8, o); }
#pragma unroll
        for (int nt = 0; nt < 4; ++nt) { const bf16x8 afr = *(const bf16x8*)(bt + (nt * 4 + ks) * 512);
            acc[0][nt] = MFMA32(afr, bfr[0], acc[0][nt]); acc[1][nt] = MFMA32(afr, bfr[1], acc[1][nt]); }
    }
#pragma unroll
    for (int ph = 0; ph < 2; ++ph) { bf16_t* dst = WSP(bf16_t, WS_CS) + ((size_t)c * 32 + h) * 8192;
#pragma unroll
        for (int nt = 0; nt < 4; ++nt)
#pragma unroll
            for (int rq = 0; rq < 4; ++rq) { u32x2 o; o.x = pk_bf16(acc[ph][nt][4 * rq], acc[ph][nt][4 * rq + 1]); o.y = pk_bf16(acc[ph][nt][4 * rq + 2], acc[ph][nt][4 * rq + 3]);
                *(u32x2*)(dst + ((ph * 8 + 2 * nt + (rq >> 1)) * 64 + (rq & 1) * 32 + q32) * 8 + 4 * hi) = o; } }
}

__device__ __forceinline__ void ssd_s1_unit(Ctx& C, int L, int c, int g) {
    const ChunkInfo ci = chunk_info(C, L, c);
    const bf16_t* XBC = WSP(const bf16_t, WS_XBC); const float* cw = C.in[13] + (size_t)L * 4 * CONVD; const float* cbias = C.in[14] + (size_t)L * CONVD;
    ssd_dt_acs(C, L, ci, c, g, true);
    __syncthreads();
    {
        const int cp = C.tid & 63, lb = C.tid >> 6; float o0[8], o1[8];
        conv_t8(XBC, ci, cw, cbias, 2048 + g * 128 + 2 * cp, 8 * lb, o0, o1);
        st8_bf16(C.lds + SD_BT + (2 * cp) * 144 + lb * 16, o0); st8_bf16(C.lds + SD_BT + (2 * cp + 1) * 144 + lb * 16, o1);
    }
#pragma unroll 1
    for (int i = 0; i < 2; ++i) {
        const int task = C.tid + 512 * i, cp = task & 127, lb = task >> 7, hh = cp >> 5; float o0[8], o1[8];
        conv_t8(XBC, ci, cw, cbias, g * 256 + 2 * cp, 8 * lb, o0, o1);
        const LAS float* dts = (const LAS float*)(C.lds + SD_DT) + hh * 64 + 8 * lb; const LAS float* acs = (const LAS float*)(C.lds + SD_ACS) + hh * 64;
        const float aend = acs[63];
#pragma unroll
        for (int k = 0; k < 8; ++k) { const float w = dts[k] * fexp(aend - acs[8 * lb + k]); o0[k] *= w; o1[k] *= w; }
        st8_bf16(C.lds + SD_XT + (2 * cp) * 144 + lb * 16, o0); st8_bf16(C.lds + SD_XT + (2 * cp + 1) * 144 + lb * 16, o1);
    }
    __syncthreads();
    {   const int hh = C.wid >> 1, ph = C.wid & 1, q32 = C.lane & 31, hi = C.lane >> 5, h = 4 * g + hh;
        f32x16 acc[4];
#pragma unroll
        for (int nt = 0; nt < 4; ++nt) acc[nt] = (f32x16){};
#pragma unroll
        for (int ks = 0; ks < 4; ++ks) { const bf16x8 bfr = *(const LAS bf16x8*)(C.lds + SD_XT + (hh * 64 + ph * 32 + q32) * 144 + ks * 32 + hi * 16);
#pragma unroll
            for (int nt = 0; nt < 4; ++nt) { const bf16x8 afr = *(const LAS bf16x8*)(C.lds + SD_BT + (nt * 32 + q32) * 144 + ks * 32 + hi * 16); acc[nt] = MFMA32(afr, bfr, acc[nt]); } }
        bf16_t* dst = WSP(bf16_t, WS_CS) + (((size_t)c * 32 + h) * 64 + ph * 32 + q32) * 128;
#pragma unroll
        for (int nt = 0; nt < 4; ++nt)
#pragma unroll
            for (int rq = 0; rq < 4; ++rq) { u32x2 w; w.x = pk_bf16(acc[nt][4 * rq], acc[nt][4 * rq + 1]); w.y = pk_bf16(acc[nt][4 * rq + 2], acc[nt][4 * rq + 3]);
                *(u32x2*)(dst + 32 * nt + 8 * rq + 4 * hi) = w; }
    }
    __syncthreads();
}

__device__ __forceinline__ void ssd_scan(Ctx& C, int L) {
    bf16_t* CS = WSP(bf16_t, WS_CS); const float* CDEC = WSP(const float, WS_CDEC);
    for (int gid = C.bid * 512 + C.tid; gid < (int)(HPN / 2); gid += C.G * 512) {
        const int h = gid >> 12; float s0 = 0.f, s1 = 0.f; unsigned* p = (unsigned*)CS + gid;
#pragma unroll 1
        for (int c0 = 0; c0 < 256; c0 += 16) { unsigned v[16]; float d[16];
#pragma unroll
            for (int j = 0; j < 16; ++j) { v[j] = p[(size_t)(c0 + j) * (HPN / 2)]; d[j] = CDEC[(c0 + j) * 32 + h]; }
#pragma unroll
            for (int j = 0; j < 16; ++j) { p[(size_t)(c0 + j) * (HPN / 2)] = pk_bf16(s0, s1); s0 = d[j] * s0 + bf_lo(v[j]); s1 = d[j] * s1 + bf_hi(v[j]); } }
        const int e_ = 2 * (gid & 4095), lane_ = (e_ >> 3) & 63;
        const size_t nat = (size_t)h * 8192 + (size_t)(32 * (e_ >> 12) + (lane_ & 31)) * 128 + 16 * ((e_ >> 9) & 7) + 8 * (lane_ >> 5) + (e_ & 7);
        float* o = C.out + O_SP + (size_t)L * HPN + nat; o[0] = s0; o[1] = s1;
#pragma unroll
        for (int b = 0; b < 8; ++b) { const float* ip = C.in[5] + ((size_t)L * 8 + b) * HPN + nat; const float i0 = ip[0], i1 = ip[1];
            unsigned* q = p + (size_t)(256 + b) * (HPN / 2); const unsigned v = *q; const float d = CDEC[(256 + b) * 32 + h];
            *q = pk_bf16(i0, i1);
            float* os = C.out + O_SS + ((size_t)L * 8 + b) * HPN + nat; os[0] = d * i0 + bf_lo(v); os[1] = d * i1 + bf_hi(v); }
    }
}

__device__ __forceinline__ void ssd_s3_unit(Ctx& C, int L, int c, int g) {
    const ChunkInfo ci = chunk_info(C, L, c);
    const bf16_t* XBC = WSP(const bf16_t, WS_XBC); const float* cw = C.in[13] + (size_t)L * 4 * CONVD; const float* cbias = C.in[14] + (size_t)L * CONVD;
    const int hh = C.wid >> 1, ph = C.wid & 1, q32 = C.lane & 31, hi = C.lane >> 5, h = 4 * g + hh;
    const int chb = h * 64 + ph * 32 + 4 * hi;
    bf16x8 pf[8], xf[3][2]; u32x2 zf[2][4];
    {   const bf16_t* prev = WSP(const bf16_t, WS_CS) + ((size_t)c * 32 + h) * 8192 + ((size_t)(ph * 8) * 64 + C.lane) * 8;
#pragma unroll
        for (int ks = 0; ks < 8; ++ks) pf[ks] = *(const bf16x8*)(prev + ks * 512);
#pragma unroll
        for (int tile = 0; tile < 3; ++tile)
#pragma unroll
            for (int sp = 0; sp < 2; ++sp) xf[tile][sp] = *(const bf16x8*)(WSP(const bf16_t, WS_XTG) + (size_t)c * 2048 * 64 + ((size_t)((2 * h + ph) * 4 + 2 * (tile >> 1) + sp) * 64 + C.lane) * 8);
#pragma unroll
        for (int lh = 0; lh < 2; ++lh)
#pragma unroll
            for (int rq = 0; rq < 4; ++rq) zf[lh][rq] = *(const u32x2*)(WSP(const bf16_t, WS_Z) + (size_t)(ci.base + lh * 32 + q32) * 2048 + chb + 8 * rq);
    }
    if (C.tid < 256) { const size_t o = ((size_t)c * 32 + 4 * g + (C.tid >> 6)) * 64 + (C.tid & 63); const float dtv = WSP(const float, WS_DTA)[o], av = WSP(const float, WS_ACSG)[o];
        ((LAS float*)(C.lds + SD_DT))[C.tid] = dtv; ((LAS float*)(C.lds + SD_ACS))[C.tid] = av; }
#pragma unroll
    for (int i = 0; i < 2; ++i) {
        const int task = C.tid + 512 * i, c8 = task & 15, l = task >> 4;
        const u32x4 vc = *(const u32x4*)(XBC + (size_t)(ci.base + l) * 4096 + 3072 + g * 128 + c8 * 8), vb = *(const u32x4*)(XBC + (size_t)(ci.base + l) * 4096 + 2048 + g * 128 + c8 * 8);
        *(LAS u32x4*)(C.lds + SD_CM + l * 272 + c8 * 16) = vc; *(LAS u32x4*)(C.lds + SD_BM + ((l & 32) | sig5(l & 31)) * 272 + c8 * 16) = vb;
    }
    __syncthreads();
    const LAS float* dts = (const LAS float*)(C.lds + SD_DT) + hh * 64; const LAS float* acs = (const LAS float*)(C.lds + SD_ACS) + hh * 64;
    f32x16 acc[2]; acc[0] = (f32x16){}; acc[1] = (f32x16){};
    {
#pragma unroll
        for (int ks = 0; ks < 8; ++ks) { const bf16x8 afr = pf[ks];
#pragma unroll
            for (int lh = 0; lh < 2; ++lh) { const bf16x8 bfr = *(const LAS bf16x8*)(C.lds + SD_CM + (lh * 32 + q32) * 272 + ks * 32 + hi * 16); acc[lh] = MFMA32(afr, bfr, acc[lh]); } }
#pragma unroll
        for (int lh = 0; lh < 2; ++lh) { const float e = fexp(acs[lh * 32 + q32]);
#pragma unroll
            for (int r = 0; r < 16; ++r) acc[lh][r] *= e; }
    }
    const float Dh = C.in[17][L * 32 + h];
#pragma unroll
    for (int tile = 0; tile < 3; ++tile) {
        const int sh = tile >> 1, lh = (tile + 1) >> 1;
        f32x16 T = (f32x16){};
#pragma unroll
        for (int ks = 0; ks < 8; ++ks) { const bf16x8 afr = *(const LAS bf16x8*)(C.lds + SD_BM + (sh * 32 + q32) * 272 + ks * 32 + hi * 16);
            const bf16x8 bfr = *(const LAS bf16x8*)(C.lds + SD_CM + (lh * 32 + q32) * 272 + ks * 32 + hi * 16); T = MFMA32(afr, bfr, T); }
        const int l = lh * 32 + q32; const float al = acs[l];
        unsigned pk[8];
#pragma unroll
        for (int r2 = 0; r2 < 8; ++r2) { float mv[2];
#pragma unroll
            for (int q = 0; q < 2; ++q) { const int r = 2 * r2 + q; const int s = sh * 32 + 16 * (r >> 3) + 8 * hi + (r & 7);
                float w = 0.f; if (s <= l) w = fexp(al - acs[s]) * dts[s];
                mv[q] = T[r] * w + ((s == l) ? Dh : 0.f); }
            pk[r2] = pk_bf16(mv[0], mv[1]); }
#pragma unroll
        for (int sp = 0; sp < 2; ++sp) { const bf16x8 afr = xf[tile][sp];
            const u32x4 bw = {pk[4 * sp], pk[4 * sp + 1], pk[4 * sp + 2], pk[4 * sp + 3]};
            acc[lh] = MFMA32(afr, __builtin_bit_cast(bf16x8, bw), acc[lh]); }
    }
#pragma unroll
    for (int lh = 0; lh < 2; ++lh) { const int l = lh * 32 + q32; float ss = 0.f;
#pragma unroll
        for (int rq = 0; rq < 4; ++rq) { const u32x2 z = zf[lh][rq];
            acc[lh][4 * rq + 0] *= silu_f(bf_lo(z.x)); acc[lh][4 * rq + 1] *= silu_f(bf_hi(z.x)); acc[lh][4 * rq + 2] *= silu_f(bf_lo(z.y)); acc[lh][4 * rq + 3] *= silu_f(bf_hi(z.y));
#pragma unroll
            for (int q = 0; q < 4; ++q) ss += acc[lh][4 * rq + q] * acc[lh][4 * rq + q]; }
        ss += __shfl_xor(ss, 32);
        if (hi == 0) ((LAS float*)(C.lds + SD_RS))[C.wid * 64 + l] = ss; }
    __syncthreads();
    const float* nw = C.in[18] + (size_t)L * DIN; bf16_t* Y = WSP(bf16_t, WS_YSSD);
#pragma unroll
    for (int lh = 0; lh < 2; ++lh) { const int l = lh * 32 + q32; float tot = 0.f;
#pragma unroll
        for (int w = 0; w < 8; ++w) tot += ((const LAS float*)(C.lds + SD_RS))[w * 64 + l];
        const float rs = 1.0f / sqrtf(tot * (1.0f / 256.0f) + 1e-5f);
        if (l < ci.Lc) {
#pragma unroll
            for (int rq = 0; rq < 4; ++rq) { const f32x4 wv = *(const f32x4*)(nw + chb + 8 * rq);
                u32x2 o; o.x = pk_bf16(acc[lh][4 * rq] * rs * wv.x, acc[lh][4 * rq + 1] * rs * wv.y); o.y = pk_bf16(acc[lh][4 * rq + 2] * rs * wv.z, acc[lh][4 * rq + 3] * rs * wv.w);
                *(u32x2*)(Y + (size_t)(ci.base + l) * 2048 + chb + 8 * rq) = o; } } }
    __syncthreads();
}

struct AttnUnit { int qrow0, h, NT, ncache, krow0, kvalid, b, nt_base, sample; };
constexpr int AT_ST = 32768;
__device__ __forceinline__ void attn_unit(Ctx& C, int L, const AttnUnit u, const int rep) {
    const int mp = C.wid >> 2, wq = C.wid & 3, q32 = C.lane & 31, hi = C.lane >> 5;
    const bf16_t* Qb = WSP(const bf16_t, WS_Q); const bf16_t* Kb = WSP(const bf16_t, WS_K); const bf16_t* VT = WSP(const bf16_t, WS_VT);
    const bf16_t* KC = WSP(const bf16_t, WS_KC); const bf16_t* VTC = WSP(const bf16_t, WS_VTC);
    float lam; const float lam_init = (L == 0) ? 0.2f : 0.35550906f;
    { const float s1 = wave_sum(C.in[8][L * 64 + C.lane] * C.in[9][L * 64 + C.lane]), s2 = wave_sum(C.in[10][L * 64 + C.lane] * C.in[11][L * 64 + C.lane]);
      lam = expf(s1) - expf(s2) + lam_init; }
    const bool active = u.sample ? (wq == 0) : true;
    const int ntw = u.sample ? u.NT : (u.nt_base + (wq >> 1));
    bf16x8 qf[4];
    { const bf16_t* qp = Qb + (size_t)(u.qrow0 + 32 * wq + q32) * 1024 + u.h * 128 + mp * 64 + hi * 8;
#pragma unroll
      for (int ds = 0; ds < 4; ++ds) qf[ds] = *(const bf16x8*)(qp + ds * 16); }
    asm volatile("" : "+v"(qf[0]), "+v"(qf[1]), "+v"(qf[2]), "+v"(qf[3]));
    f32x16 O[4];
#pragma unroll
    for (int eb = 0; eb < 4; ++eb) O[eb] = (f32x16){};
    float m_run = 0.f, l_run = 0.f; f32x16 negm = (f32x16){};
    int koff[2], ve[2], vc[2];
#pragma unroll
    for (int i = 0; i < 2; ++i) { const int j = C.wid + 8 * i;
        const int r = 4 * j + (C.lane >> 4), c = (C.lane & 15) ^ (r & 15); koff[i] = ((r & 32) | sig5(r & 31)) * 1024 + c * 8;
        const int e = 8 * j + (C.lane >> 3), cv = (C.lane & 7) ^ ((e >> 1) & 7); ve[i] = e; vc[i] = cv * 8; }
    int kso[4], vso[4];
#pragma unroll
    for (int ds = 0; ds < 4; ++ds) { kso[ds] = ((mp * 8 + ds * 2 + hi) ^ (q32 & 15)) * 16; vso[ds] = ((ds * 2 + hi) ^ ((q32 >> 1) & 7)) * 16; }
#define AT_ISSUE(t, st) do { const int t_ = (t); \
        const bf16_t* kp_ = (t_ < u.ncache) ? KC + ((size_t)u.b * PAST + 64 * t_) * 1024 + u.h * 128 : Kb + ((size_t)u.krow0 + 64 * (t_ - u.ncache)) * 1024 + u.h * 128; \
        const bf16_t* vp_; int vs_; \
        if (t_ < u.ncache) { vp_ = VTC + ((size_t)u.b * 1024 + u.h * 128) * PAST + 64 * t_; vs_ = PAST; } else { vp_ = VT + (size_t)(u.h * 128) * MT + u.krow0 + 64 * (t_ - u.ncache); vs_ = MT; } \
        _Pragma("unroll") for (int i_ = 0; i_ < 2; ++i_) { \
            __builtin_amdgcn_global_load_lds((const unsigned*)(kp_ + koff[i_]), (LAS unsigned*)(C.lds + (st) * AT_ST + (C.wid + 8 * i_) * 1024), 16, 0, 0); \
            __builtin_amdgcn_global_load_lds((const unsigned*)(vp_ + (size_t)ve[i_] * vs_ + vc[i_]), (LAS unsigned*)(C.lds + (st) * AT_ST + 16384 + (C.wid + 8 * i_) * 1024), 16, 0, 0); } } while (0)
    AT_ISSUE(0, 0); AT_ISSUE(1, 1);
    int st_cur = 0, st_nxt2 = 2;
#pragma unroll 1
    for (int t = 0; t < u.NT; ++t) {
        if (t + 1 < u.NT) asm volatile("s_waitcnt vmcnt(4)\n\ts_barrier" ::: "memory");
        else asm volatile("s_waitcnt vmcnt(0)\n\ts_barrier" ::: "memory");
        if (t + 2 < u.NT) AT_ISSUE(t + 2, st_nxt2);
        if (active && t < ntw) {
            const LAS unsigned char* kb = C.lds + st_cur * AT_ST + q32 * 256;
            const LAS unsigned char* vb = C.lds + st_cur * AT_ST + 16384 + q32 * 128;
            bf16x8 ka[8];
#pragma unroll
            for (int ds = 0; ds < 4; ++ds) { ka[ds] = *(const LAS bf16x8*)(kb + kso[ds]); ka[4 + ds] = *(const LAS bf16x8*)(kb + 8192 + kso[ds]); }
            f32x16 S0 = MFMA32(ka[0], qf[0], negm);
#pragma unroll
            for (int ds = 1; ds < 4; ++ds) S0 = MFMA32(ka[ds], qf[ds], S0);
            f32x16 S1 = MFMA32(ka[4], qf[0], negm);
#pragma unroll
            for (int ds = 1; ds < 4; ++ds) S1 = MFMA32(ka[4 + ds], qf[ds], S1);
            bf16x8 va[4];
#pragma unroll
            for (int eb = 0; eb < 4; ++eb) va[eb] = *(const LAS bf16x8*)(vb + eb * 4096 + vso[0]);
            float mx = max3f(S0[0], S0[1], S0[2]);
#pragma unroll
            for (int r = 3; r < 15; r += 2) mx = max3f(mx, S0[r], S0[r + 1]);
            mx = max3f(mx, S0[15], S0[15]);
#pragma unroll
            for (int r = 0; r < 16; ++r) S0[r] = fexp2(S0[r]);
            float mx1 = max3f(S1[0], S1[1], S1[2]);
#pragma unroll
            for (int r = 3; r < 15; r += 2) mx1 = max3f(mx1, S1[r], S1[r + 1]);
            mx = max3f(mx, mx1, S1[15]);
            mx = max3f(mx, __shfl_xor(mx, 32), mx);
            if (t == 0 || __any(mx > 8.0f)) {
                const float dl = (t == 0) ? mx : fmaxf(mx, 0.f);
                m_run += dl;
                const float f = fexp2(-dl); l_run *= f;
#pragma unroll
                for (int r = 0; r < 16; ++r) { S0[r] *= f; S1[r] -= dl; negm[r] = -m_run; }
#pragma unroll
                for (int eb = 0; eb < 4; ++eb)
#pragma unroll
                    for (int r = 0; r < 16; ++r) O[eb][r] *= f;
            }
            if (t == u.NT - 1 && u.kvalid < 64) {
#pragma unroll
                for (int r = 0; r < 16; ++r) { const int kv = 16 * (r >> 3) + 8 * hi + (r & 7); if (kv >= u.kvalid) S0[r] = 0.f; if (kv + 32 >= u.kvalid) S1[r] = -INFINITY; } }
            u32x4 pk[4];
#pragma unroll
            for (int sp = 0; sp < 2; ++sp)
                pk[sp] = (u32x4){pk_bf16(S0[8 * sp], S0[8 * sp + 1]), pk_bf16(S0[8 * sp + 2], S0[8 * sp + 3]), pk_bf16(S0[8 * sp + 4], S0[8 * sp + 5]), pk_bf16(S0[8 * sp + 6], S0[8 * sp + 7])};
#pragma unroll
            for (int eb = 0; eb < 4; ++eb) O[eb] = MFMA32(va[eb], __builtin_bit_cast(bf16x8, pk[0]), O[eb]);
#pragma unroll
            for (int eb = 0; eb < 4; ++eb) va[eb] = *(const LAS bf16x8*)(vb + eb * 4096 + vso[1]);
#pragma unroll
            for (int r = 0; r < 16; ++r) S1[r] = fexp2(S1[r]);
#pragma unroll
            for (int eb = 0; eb < 4; ++eb) O[eb] = MFMA32(va[eb], __builtin_bit_cast(bf16x8, pk[1]), O[eb]);
#pragma unroll
            for (int eb = 0; eb < 4; ++eb) va[eb] = *(const LAS bf16x8*)(vb + eb * 4096 + vso[2]);
#pragma unroll
            for (int sp = 0; sp < 2; ++sp)
                pk[2 + sp] = (u32x4){pk_bf16(S1[8 * sp], S1[8 * sp + 1]), pk_bf16(S1[8 * sp + 2], S1[8 * sp + 3]), pk_bf16(S1[8 * sp + 4], S1[8 * sp + 5]), pk_bf16(S1[8 * sp + 6], S1[8 * sp + 7])};
#pragma unroll
            for (int eb = 0; eb < 4; ++eb) O[eb] = MFMA32(va[eb], __builtin_bit_cast(bf16x8, pk[2]), O[eb]);
#pragma unroll
            for (int eb = 0; eb < 4; ++eb) va[eb] = *(const LAS bf16x8*)(vb + eb * 4096 + vso[3]);
            float sum = 0.f, sum2 = 0.f;
#pragma unroll
            for (int r = 0; r < 16; ++r) { sum += S0[r]; sum2 += S1[r]; }
            l_run += sum + sum2;
#pragma unroll
            for (int eb = 0; eb < 4; ++eb) O[eb] = MFMA32(va[eb], __builtin_bit_cast(bf16x8, pk[3]), O[eb]);
#if MK_SGB
#pragma unroll
            for (int i_ = 0; i_ < 16; ++i_) { __builtin_amdgcn_sched_group_barrier(0x008, 1, 0); __builtin_amdgcn_sched_group_barrier(0x100, 1, 0); __builtin_amdgcn_sched_group_barrier(0x002, 5, 0); }
#endif
        }
        st_cur = (st_cur == 2) ? 0 : st_cur + 1; st_nxt2 = (st_nxt2 == 2) ? 0 : st_nxt2 + 1;
    }
#undef AT_ISSUE
    asm volatile("s_waitcnt lgkmcnt(0)\n\ts_barrier" ::: "memory");
    const float ltot = l_run + __shfl_xor(l_run, 32); const float inv = 1.0f / ltot;
    LAS float* EX = (LAS float*)C.lds + wq * 4096;
    if (mp == 1 && active) {
#pragma unroll
        for (int eb = 0; eb < 4; ++eb)
#pragma unroll
            for (int r = 0; r < 16; ++r) EX[(32 * eb + 8 * (r >> 2) + 4 * hi + (r & 3)) * 32 + q32] = O[eb][r] * inv;
    }
    __syncthreads();
    if (mp == 0 && active) {
        float ss = 0.f;
#pragma unroll
        for (int eb = 0; eb < 4; ++eb)
#pragma unroll
            for (int r = 0; r < 16; ++r) { const float d = O[eb][r] * inv - lam * EX[(32 * eb + 8 * (r >> 2) + 4 * hi + (r & 3)) * 32 + q32]; O[eb][r] = d; ss += d * d; }
        ss += __shfl_xor(ss, 32);
        const float rs = (1.0f / sqrtf(ss * (1.0f / 128.0f) + 1e-5f)) * (1.0f - lam_init);
        const float* sw = C.in[12] + L * 128;
        if (!u.sample || q32 < 16) {
            bf16_t* dst = WSP(bf16_t, WS_ATT) + (size_t)(u.qrow0 + 32 * wq + q32) * 1024 + u.h * 128 + 4 * hi;
#pragma unroll
            for (int eb = 0; eb < 4; ++eb)
#pragma unroll
                for (int rq = 0; rq < 4; ++rq) { const f32x4 wv = *(const f32x4*)(sw + 32 * eb + 8 * rq + 4 * hi);
                    u32x2 o; o.x = pk_bf16(O[eb][4 * rq] * rs * wv.x, O[eb][4 * rq + 1] * rs * wv.y); o.y = pk_bf16(O[eb][4 * rq + 2] * rs * wv.z, O[eb][4 * rq + 3] * rs * wv.w);
                    *(u32x2*)(dst + 32 * eb + 8 * rq) = o; }
        }
    }
    __syncthreads();
}

struct OneUnit { int pm, pn;
    __device__ __forceinline__ bool next(int i, pg8::Unit& u) const { if (i) return false; u.pm = pm; u.pn = pn; return true; }
    __device__ __forceinline__ void a_ready(const pg8::Unit&) const {}
    __device__ __forceinline__ void done(const pg8::Unit&) const {} };
__device__ __forceinline__ void flag_publish(unsigned* cnt, int tid) {
    asm volatile("s_waitcnt vmcnt(0)" ::: "memory"); __syncthreads();
    if (tid == 0) { __builtin_amdgcn_fence(__ATOMIC_RELEASE, "agent"); asm volatile("s_waitcnt vmcnt(0)" ::: "memory"); __hip_atomic_fetch_add(cnt, 1u, __ATOMIC_RELAXED, __HIP_MEMORY_SCOPE_AGENT); }
}
__device__ __forceinline__ void flag_wait(unsigned* cnt, unsigned target, int tid) {
    if (tid == 0) { unsigned sp = 0; while (__hip_atomic_load(cnt, __ATOMIC_RELAXED, __HIP_MEMORY_SCOPE_AGENT) < target) { __builtin_amdgcn_s_sleep(16); if (++sp > (1u << 24)) break; } }
    __syncthreads();
    __builtin_amdgcn_fence(__ATOMIC_ACQUIRE, "agent"); asm volatile("s_waitcnt vmcnt(0)" ::: "memory");
    __syncthreads();
}
__device__ __forceinline__ void chain_item(Ctx& C, int L, int kind, int idx) {
    unsigned* cnt = WSP(unsigned, WS_CTL) + 64 * (20 + 4 * L);
    if (kind == 0) {
        flag_wait(cnt, 128u, C.tid);
        OneUnit S{0, idx};
        { pg8::Gemm g{WSP(const bf16_t, WS_ATT) + (size_t)SEQ * 1024, WSP(const bf16_t, WS_WBA + L * SZ_WBA), 256, 1024, 1024}; EpiBrA E{WSP(const bf16_t, WS_G), WSP(float, WS_Z), SEQ};
          pg8::gemm_phase<EpiBrA, OneUnit, true, true>(C.lds, g, S, E); }
        { pg8::Gemm g{WSP(const bf16_t, WS_YSSD) + (size_t)SEQ * 2048, WSP(const bf16_t, WS_WBS + L * SZ_WBS), 256, 1024, 2048}; EpiBrB E{WSP(const bf16_t, WS_G), WSP(const float, WS_Z), WSP(bf16_t, WS_Q), SEQ};
          pg8::gemm_phase<EpiBrB, OneUnit, true, true>(C.lds, g, S, E); }
        flag_publish(cnt + 64, C.tid);
    } else if (kind == 1) {
        flag_wait(cnt + 64, 4u, C.tid);
        OneUnit S{0, idx};
        pg8::Gemm g{WSP(const bf16_t, WS_Q) + (size_t)SEQ * 1024, WSP(const bf16_t, WS_WOUT + L * SZ_WOUT), 256, 1024, 1024};
        EpiRes E{WSP(float, WS_X), WSP(bf16_t, WS_XB), WSP(float, WS_PART) + (size_t)(2 * L + 1) * MT, SEQ};
        pg8::gemm_phase<EpiRes, OneUnit, true, true>(C.lds, g, S, E);
        flag_publish(cnt + 128, C.tid);
    } else if (kind == 2) {
        flag_wait(cnt + 128, 4u, C.tid);
        OneUnit S{0, idx};
        pg8::Gemm g{WSP(const bf16_t, WS_XB) + (size_t)SEQ * 1024, WSP(const bf16_t, WS_WGU + L * SZ_WGU), 256, 5632, 1024};
        EpiGU E{WSP(const float, WS_PART) + (size_t)(2 * L + 1) * MT, WSP(bf16_t, WS_ACTS), SEQ, SEQ};
        pg8::gemm_phase<EpiGU, OneUnit, true, true>(C.lds, g, S, E);
        flag_publish(cnt + 192, C.tid);
    } else {
        flag_wait(cnt + 192, 22u, C.tid);
        OneUnit S{0, idx};
        pg8::Gemm g{WSP(const bf16_t, WS_ACTS), WSP(const bf16_t, WS_WD + L * SZ_WD), 256, 1024, DFF};
        EpiRes E{WSP(float, WS_X), WSP(bf16_t, WS_XB), WSP(float, WS_PART) + (size_t)(2 * L + 2) * MT, SEQ};
        pg8::gemm_phase<EpiRes, OneUnit, true, true>(C.lds, g, S, E);
    }
    __syncthreads();
}

__device__ __forceinline__ void phase_mix(Ctx& C, int L, int rep) {
    unsigned* counter = WSP(unsigned, WS_CTL) + 64 * (1 + L + 4 * rep);
    unsigned* cntA = WSP(unsigned, WS_CTL) + 64 * (20 + 4 * L);
    volatile LAS int* slot = (volatile LAS int*)(C.lds + LDS_CTL);
    constexpr int N_SMP = 64, N_S3S = 64, N_MID = 1024 + 34, N_S3 = 2048, N_ALL = N_SMP + N_S3S + N_MID + N_S3;
    for (;;) {
        __syncthreads();
        if (C.tid == 0) slot[0] = (int)atomicAdd(counter, 1u);
        __syncthreads();
        const int item = slot[0];
        if (item >= N_ALL) break;
        { int t_ = threadIdx.x; asm volatile("" : "+v"(t_)); C.tid = t_; C.lane = t_ & 63; C.wid = __builtin_amdgcn_readfirstlane(t_ >> 6); }
        if (item < N_SMP) { AttnUnit u; u.sample = 1; u.b = item >> 3; u.h = item & 7; u.qrow0 = SEQ + 16 * u.b; u.NT = 65; u.ncache = 64; u.krow0 = SEQ + 16 * u.b; u.kvalid = 16; u.nt_base = 65;
            attn_unit(C, L, u, rep); flag_publish(cntA, C.tid); }
        else if (item < N_SMP + N_S3S) { const int j = 2048 + (item - N_SMP); ssd_s3_unit(C, L, j >> 3, j & 7); flag_publish(cntA, C.tid); }
        else if (item < N_SMP + N_S3S + N_MID) { const int mi = item - N_SMP - N_S3S; int j = -1, kind = -1, idx = 0;
            if (mi < 400) j = mi; else if (mi < 404) { kind = 0; idx = mi - 400; } else if (mi < 560) j = mi - 4; else if (mi < 564) { kind = 1; idx = mi - 560; }
            else if (mi < 720) j = mi - 8; else if (mi < 742) { kind = 2; idx = mi - 720; } else if (mi < 880) j = mi - 30; else if (mi < 884) { kind = 3; idx = mi - 880; } else j = mi - 34;
            if (kind >= 0) chain_item(C, L, kind, idx);
            else { const int qb = 127 - (j >> 3); AttnUnit u; u.sample = 0; u.b = 0; u.h = j & 7; u.qrow0 = 128 * qb; u.NT = 2 * qb + 2; u.ncache = 0; u.krow0 = 0; u.kvalid = 64; u.nt_base = 2 * qb + 1; attn_unit(C, L, u, rep); } }
        else { const int j = item - N_SMP - N_S3S - N_MID; ssd_s3_unit(C, L, j >> 3, j & 7); }
    }
}

__device__ __forceinline__ void phase_final(Ctx& C) {
    const float* X = WSP(const float, WS_X); const float* PART = WSP(const float, WS_PART); const float* nw = C.in[25];
    const int gw = C.bid * 8 + C.wid, NGW = C.G * 8;
    for (int row = gw; row < MV; row += NGW) { const float rs = rstd1(PART + 4 * MT, row, 1e-6f);
#pragma unroll
        for (int j = 0; j < 4; ++j) { const int col = 4 * C.lane + 256 * j; const f32x4 x = *(const f32x4*)(X + (size_t)row * 1024 + col); const f32x4 w = *(const f32x4*)(nw + col);
            *(f32x4*)(C.out + O_YP + (size_t)row * 1024 + col) = (x * rs) * w; } }
}

#define XB_TMO      128
#define XB_XCNT(j)  (256  + 64 * (j))
#define XB_XSUB(j)  (1280 + 64 * (j))
#define XB_XGEN(j)  (2304 + 64 * (j))
#define XB_TOP      3328
#define XB_TOPGEN   3392
#define XCD_BAR_WORDS 3456
#define XB_SPIN_CAP (1u << 23)

__device__ __forceinline__ unsigned xb_ld(unsigned* p)              { return __hip_atomic_load(p, __ATOMIC_RELAXED, __HIP_MEMORY_SCOPE_AGENT); }
__device__ __forceinline__ unsigned xb_add(unsigned* p, unsigned v) { return __hip_atomic_fetch_add(p, v, __ATOMIC_RELAXED, __HIP_MEMORY_SCOPE_AGENT); }
__device__ __forceinline__ unsigned xb_xcc_id() { return (unsigned)__builtin_amdgcn_s_getreg((3 << 11) | 20) & 0xFu; }
#define XB_SPIN(cond, bar) do { unsigned _sp = 0; while (cond) { __builtin_amdgcn_s_sleep(1); \
    if ((++_sp & 255u) == 0u) { if (xb_ld(&(bar)[XB_TMO])) break; if (_sp > XB_SPIN_CAP) { atomicAdd(&(bar)[XB_TMO], 1u); break; } } } } while (0)

struct XcdBarrier {
    unsigned* bar; unsigned x;
    volatile LAS unsigned* st;
};

__device__ __forceinline__ XcdBarrier xcd_barrier_post(unsigned* bar, volatile LAS unsigned* st) {
    XcdBarrier b; b.bar = bar; b.x = xb_xcc_id(); b.st = st;
    if (threadIdx.x == 0) (void)xb_add(&bar[XB_XCNT(b.x)], 1u);
    return b;
}
__device__ __forceinline__ void xcd_barrier_complete(unsigned* bar, unsigned x, unsigned& nloc, unsigned& nx) {
    const unsigned G = gridDim.x * gridDim.y * gridDim.z;
    unsigned sum, cnt, mine, sp = 0u;
    for (;;) {
        sum = 0u; cnt = 0u; mine = 0u;
#pragma unroll
        for (unsigned j = 0; j < 16; ++j) { const unsigned c = xb_ld(&bar[XB_XCNT(j)]); sum += c; cnt += (c > 0u) ? 1u : 0u; mine = (j == x) ? c : mine; }
        if (sum == G) break;
        __builtin_amdgcn_s_sleep(1);
        if ((++sp & 255u) == 0u) { if (xb_ld(&bar[XB_TMO])) break; if (sp > XB_SPIN_CAP) { atomicAdd(&bar[XB_TMO], 1u); break; } }
    }
    nloc = mine > 0u ? mine : 1u; nx = cnt > 0u ? cnt : 1u;
}

__device__ __forceinline__ void xcd_barrier(const XcdBarrier& b) {
    asm volatile("s_waitcnt vmcnt(0)" ::: "memory");
    __syncthreads();
    if (threadIdx.x == 0) {
        unsigned* bar = b.bar;
        __builtin_amdgcn_s_waitcnt(0);
        unsigned nloc = b.st[0], nx = b.st[1];
        if (nloc == 0u) { xcd_barrier_complete(bar, b.x, nloc, nx); b.st[0] = nloc; b.st[1] = nx; }
        const unsigned old = xb_add(&bar[XB_XSUB(b.x)], 1u);
        const unsigned gen = old / nloc;
        if (old + 1u == (gen + 1u) * nloc) {
            __builtin_amdgcn_fence(__ATOMIC_RELEASE, "agent");
            asm volatile("s_waitcnt vmcnt(0)" ::: "memory");
            const unsigned og = xb_add(&bar[XB_TOP], 1u);
            const unsigned tg = og / nx;
            if (og + 1u == (tg + 1u) * nx) xb_add(&bar[XB_TOPGEN], 1u);
            else XB_SPIN(xb_ld(&bar[XB_TOPGEN]) == tg, bar);
            __builtin_amdgcn_fence(__ATOMIC_ACQUIRE, "agent");
            xb_add(&bar[XB_XGEN(b.x)], 1u);
            asm volatile("s_waitcnt vmcnt(0)" ::: "memory");
        } else {
            XB_SPIN(xb_ld(&bar[XB_XGEN(b.x)]) == gen, bar);
            __builtin_amdgcn_fence(__ATOMIC_ACQUIRE, "agent");
            asm volatile("s_waitcnt vmcnt(0)" ::: "memory");
        }
    }
    __syncthreads();
}

constexpr int N_PHASES = 18;
__global__ void __launch_bounds__(512, 2) mk_fwd(Args a) {
    extern __shared__ __attribute__((aligned(16))) unsigned char lds_raw[];
    Ctx C;
    C.lds = (LAS unsigned char*)lds_raw; C.G = gridDim.x; C.bid = blockIdx.x;
#pragma unroll
    for (int i = 0; i < 26; ++i) C.in[i] = a.in[i];
    C.out = a.out; C.ws = a.ws;
    cg::grid_group grid = cg::this_grid();
    if (threadIdx.x < 64) ((LAS unsigned*)(C.lds + LDS_CTL))[threadIdx.x] = 0u;
    __syncthreads();
    XcdBarrier xbar = xcd_barrier_post(WSP(unsigned, WS_CTL) + 4096, (volatile LAS unsigned*)(C.lds + LDS_CTL + 32));
#pragma unroll 1
    for (int ph = a.ph_lo; ph < a.ph_hi; ++ph) {
        if (ph == a.ph_lo + 1) { grid.sync(); } else if (ph > a.ph_lo) { xcd_barrier(xbar); }
        { int t_ = threadIdx.x; asm volatile("" : "+v"(t_)); C.tid = t_; C.lane = t_ & 63; C.wid = __builtin_amdgcn_readfirstlane(t_ >> 6); }
        if (ph == 0) { if (!(MK_SKIP & 1024)) phase_p0(C); continue; }
        if (ph == N_PHASES - 1) { phase_final(C); continue; }
        const int L = (ph - 1) >> 3, sub = (ph - 1) & 7;
        if (sub == 0) {
            pg8::Gemm g{WSP(const bf16_t, WS_XB), WSP(const bf16_t, WS_WIN + L * SZ_WIN), MT, NINP, 1024}; pg8::StaticOrder S; S.init(MT, NINP, C.G, C.bid);
            EpiIn E{WSP(const float, WS_PART) + (size_t)(2 * L) * MT, WSP(bf16_t, WS_Q), WSP(bf16_t, WS_K), WSP(bf16_t, WS_VT), WSP(bf16_t, WS_Z), WSP(bf16_t, WS_XBC), WSP(bf16_t, WS_G), WSP(float, WS_DT), C.out, L, WSP(bf16_t, WS_HIST)};
            if (!(MK_SKIP & 1)) pg8::gemm_phase<EpiIn, pg8::StaticOrder, true, true>(C.lds, g, S, E);
            if (MK_PROBE & 2) { grid.sync(); pg8::gemm_phase<EpiIn, pg8::StaticOrder, true, true>(C.lds, g, S, E); }
            if (MK_PROBE & 1024) { grid.sync(); EpiNull EN{WSP(float, WS_END - 64)}; pg8::gemm_phase<EpiNull, pg8::StaticOrder, true, true>(C.lds, g, S, EN); }
        } else if (sub == 1) {
            for (int uidx = C.bid; uidx < NCHUNK * 8; uidx += C.G) { { int t_ = threadIdx.x; asm volatile("" : "+v"(t_)); C.tid = t_; C.lane = t_ & 63; C.wid = __builtin_amdgcn_readfirstlane(t_ >> 6); } conv_unit(C, L, uidx >> 3, uidx & 7); }
            if (!(MK_SKIP & 4)) cache_convert(C, L);
            xcd_barrier(xbar);
            for (int uidx = C.bid * 8 + C.wid; uidx < NCHUNK * 32; uidx += C.G * 8) { { int t_ = threadIdx.x; asm volatile("" : "+v"(t_)); C.tid = t_; C.lane = t_ & 63; C.wid = __builtin_amdgcn_readfirstlane(t_ >> 6); } ssd_s1_wave(C, L, uidx >> 5, uidx & 31); }
            if (MK_PROBE & 512) { grid.sync(); for (int uidx = C.bid * 8 + C.wid; uidx < NCHUNK * 32; uidx += C.G * 8) { { int t_ = threadIdx.x; asm volatile("" : "+v"(t_)); C.tid = t_; C.lane = t_ & 63; C.wid = __builtin_amdgcn_readfirstlane(t_ >> 6); } ssd_s1_wave(C, L, uidx >> 5, uidx & 31); } }
        } else if (sub == 2) {
            if (!(MK_SKIP & 8)) ssd_scan(C, L);
        } else if (sub == 3) {
            phase_mix(C, L, 0);
            if (MK_PROBE & 1) { grid.sync(); phase_mix(C, L, 1); }
        } else if (sub == 4) {
            pg8::StaticOrder S; S.init(SEQ, 1024, C.G, C.bid);
            { pg8::Gemm g{WSP(const bf16_t, WS_ATT), WSP(const bf16_t, WS_WBA + L * SZ_WBA), SEQ, 1024, 1024}; EpiBrA E{WSP(const bf16_t, WS_G), WSP(float, WS_Z), 0};
              if (!(MK_SKIP & 64)) pg8::gemm_phase<EpiBrA, pg8::StaticOrder, true, true>(C.lds, g, S, E); }
            { pg8::Gemm g{WSP(const bf16_t, WS_YSSD), WSP(const bf16_t, WS_WBS + L * SZ_WBS), SEQ, 1024, 2048}; EpiBrB E{WSP(const bf16_t, WS_G), WSP(const float, WS_Z), WSP(bf16_t, WS_Q), 0};
              if (!(MK_SKIP & 128)) pg8::gemm_phase<EpiBrB, pg8::StaticOrder, true, true>(C.lds, g, S, E); }
        } else if (sub == 5) {
            pg8::Gemm g{WSP(const bf16_t, WS_Q), WSP(const bf16_t, WS_WOUT + L * SZ_WOUT), SEQ, 1024, 1024}; pg8::StaticOrder S; S.init(SEQ, 1024, C.G, C.bid);
            EpiRes E{WSP(float, WS_X), WSP(bf16_t, WS_XB), WSP(float, WS_PART) + (size_t)(2 * L + 1) * MT, 0};
            if (!(MK_SKIP & 256)) pg8::gemm_phase<EpiRes, pg8::StaticOrder, true, true>(C.lds, g, S, E);
        } else if (sub == 6) {
            pg8::Gemm g{WSP(const bf16_t, WS_XB), WSP(const bf16_t, WS_WGU + L * SZ_WGU), SEQ, 5632, 1024}; pg8::StaticOrder S; S.init(SEQ, 5632, C.G, C.bid);
            EpiGU E{WSP(const float, WS_PART) + (size_t)(2 * L + 1) * MT, WSP(bf16_t, WS_XBC), 0, 0};
            if (!(MK_SKIP & 512)) pg8::gemm_phase<EpiGU, pg8::StaticOrder, true, true>(C.lds, g, S, E);
            if (MK_PROBE & 4) { grid.sync(); pg8::gemm_phase<EpiGU, pg8::StaticOrder, true, true>(C.lds, g, S, E); }
        } else {
            pg8::Gemm g{WSP(const bf16_t, WS_XBC), WSP(const bf16_t, WS_WD + L * SZ_WD), SEQ, 1024, DFF}; pg8::StaticOrder S; S.init(SEQ, 1024, C.G, C.bid);
            EpiRes E{WSP(float, WS_X), WSP(bf16_t, WS_XB), WSP(float, WS_PART) + (size_t)(2 * L + 2) * MT, 0};
            if (!(MK_SKIP & 256)) pg8::gemm_phase<EpiRes, pg8::StaticOrder, true, true>(C.lds, g, S, E);
        }
    }
}

extern "C" void kernel_launch(void* const* d_in, const int* in_sizes, int n_in, void* d_out, int out_size, void* d_ws, size_t ws_size, hipStream_t stream) {
    static int grid = 0;
    if (grid == 0) {
        if (n_in != 26 || (size_t)out_size != O_END || ws_size < WS_END) { fprintf(stderr, "kernel_launch: unexpected shapes (n_in %d, out %d, ws %zu)\n", n_in, out_size, ws_size); grid = -1; return; }
        int dev = 0, cus = 0, per_cu = 0;
        hipGetDevice(&dev); hipDeviceGetAttribute(&cus, hipDeviceAttributeMultiprocessorCount, dev);
        if (hipFuncSetAttribute((const void*)mk_fwd, hipFuncAttributeMaxDynamicSharedMemorySize, LDS_BYTES) != hipSuccess) { fprintf(stderr, "kernel_launch: hipFuncSetAttribute failed\n"); grid = -1; return; }
        if (hipOccupancyMaxActiveBlocksPerMultiprocessor(&per_cu, (const void*)mk_fwd, 512, LDS_BYTES) != hipSuccess || per_cu < 1) per_cu = 1;
        (void)hipGetLastError();
        grid = cus * per_cu;
    }
    if (grid < 0) return;
    hipMemsetAsync((char*)d_ws + WS_CTL, 0, CTL_BYTES, stream);
    Args a{};
    for (int i = 0; i < 26; ++i) a.in[i] = (const float*)d_in[i];
    a.out = (float*)d_out; a.ws = (unsigned char*)d_ws;
#if MK_MULTI
    for (int ph = 0; ph < N_PHASES; ++ph) { a.ph_lo = ph; a.ph_hi = ph + 1; hipLaunchKernelGGL(mk_fwd, dim3(grid), dim3(512), LDS_BYTES, stream, a); }
#else
    a.ph_lo = 0; a.ph_hi = N_PHASES;
    void* args[] = {&a};
    hipError_t e = hipLaunchCooperativeKernel((const void*)mk_fwd, dim3(grid), dim3(512), args, LDS_BYTES, stream);
    if (e != hipSuccess) fprintf(stderr, "cooperative launch failed: %s (grid %d)\n", hipGetErrorString(e), grid);
#endif
}
```

```cpp
#include <hip/hip_runtime.h>
#include <hip/hip_cooperative_groups.h>
#include <cstdio>
#include <cstdint>
#include <cmath>
namespace cg = cooperative_groups;
#ifndef MK_MULTI
#define MK_MULTI 0
#endif
#ifndef MK_SKIP
#define MK_SKIP 0
#endif
#ifndef MK_PROBE
#define MK_PROBE 0
#endif
#ifndef MK_SGB
#define MK_SGB 0
#endif
namespace pg8 {
#define PG8_LAS __attribute__((address_space(3)))
typedef unsigned short bf16_t;
typedef short bf16x8 __attribute__((ext_vector_type(8)));
typedef float f32x4 __attribute__((ext_vector_type(4)));
typedef unsigned u32x4 __attribute__((ext_vector_type(4)));
constexpr int BM = 256, BK = 64, HALF = 128, HTB = HALF * BK * 2  , STAGE_BYTES = 8 * HTB, NXCD = 8, WGM = 8;

__host__ __device__ __forceinline__ int lds_byte(int r, int c) { const int st = (r >> 4) * 2 + (c >> 5), rr = r & 15, cc = c & 31, ob = rr * 64 + cc * 2; return st * 1024 + (ob ^ (((ob >> 9) & 1) << 5)); }
__host__ __device__ __forceinline__ void stage_rc(int b, int& R, int& C) { const int st = b / 1024, sb = b % 1024, swz = sb ^ (((sb >> 9) & 1) << 5); R = (st >> 1) * 16 + swz / 64; C = (st & 1) * 32 + (swz % 64) / 2; }
__host__ __device__ __forceinline__ int perm32(int rho) { const int n = rho >> 4, i = rho & 15; return 8 * (i >> 2) + 4 * n + (i & 3); }

struct Unit { int pm, pn; };
struct Gemm { const bf16_t* A; const bf16_t* Bt; int M, N, K; };

struct StaticOrder {
    int nM, nN, nwg, G, c;
    __host__ __device__ void init(int M, int N, int G_, int c_) { nM = M / BM; nN = N / BM; nwg = nM * nN; G = G_; c = c_; }
    __host__ __device__ bool next(int i, Unit& u) const {
        const long L = (long)i * G + c; if (L >= nwg) return false;
        int wgid = (int)L; { const int q = nwg / NXCD, r = nwg % NXCD, xcd = wgid % NXCD, off = wgid / NXCD; wgid = (xcd < r ? xcd * (q + 1) : r * (q + 1) + (xcd - r) * q) + off; }
        const int nig = WGM * nN, gid = wgid / nig, fm = gid * WGM, gsz = (nM - fm) < WGM ? (nM - fm) : WGM;
        u.pm = fm + ((wgid % nig) % gsz); u.pn = (wgid % nig) / gsz; return true;
    }
    __device__ __forceinline__ void a_ready(const Unit&) const {}
    __device__ __forceinline__ void done(const Unit&) const {}
};

template <class Epi, class Sched, bool ALIGN_EPI = false, bool SP2 = false>
__device__ __forceinline__ void gemm_phase(PG8_LAS unsigned char* lds, const Gemm g, const Sched& S, const Epi& E) {
    int tid_ = threadIdx.x; asm volatile("" : "+v"(tid_)); const int tid = tid_, wid = __builtin_amdgcn_readfirstlane(tid >> 6), lane = tid & 63, wr = wid >> 2, wc = wid & 3, fr = lane & 15, fq = lane >> 4;
    const int K = g.K, nt = K / BK;
    unsigned voffA[2], voffB[2];
#pragma unroll
    for (int i = 0; i < 2; ++i) { int R, C; stage_rc(tid * 16 + i * 8192, R, C); const int Rb = Epi::PERM ? ((R & ~31) + perm32(R & 31)) : R;
        voffA[i] = (unsigned)(R * K + C) * 2u; voffB[i] = (unsigned)(Rb * K + C) * 2u; }
    const size_t kstep = (size_t)(BK * 2);
    const size_t hstep = (size_t)HALF * K * 2;
    const size_t tstep = 2 * hstep;
    const unsigned ldsw = (unsigned)wid * 1024u;
    const int aoff = lds_byte(wr * 64 + fr, fq * 8), boff = lds_byte(wc * 32 + fr, fq * 8);
#define PG8_SA(b, h) (((b) * 2 + (h)) * HTB)
#define PG8_SB(b, h) ((4 + (b) * 2 + (h)) * HTB)
#define PG8_STAGE(bufoff, gbase, voff) do { _Pragma("unroll") for (int _i = 0; _i < 2; ++_i) \
        __builtin_amdgcn_global_load_lds((const unsigned*)((const char*)(gbase) + (voff)[_i]), (PG8_LAS unsigned*)(lds + (bufoff) + ldsw + _i * 8192), 16, 0, 0); } while (0)
#define PG8_LDA(dst, b, h) do { _Pragma("unroll") for (int m = 0; m < 4; ++m) _Pragma("unroll") for (int k = 0; k < 2; ++k) dst[m][k] = *(const PG8_LAS bf16x8*)(lds + PG8_SA(b, h) + aoff + m * 2048 + k * 1024); } while (0)
#define PG8_LDB(dst, b, h) do { _Pragma("unroll") for (int n = 0; n < 2; ++n) _Pragma("unroll") for (int k = 0; k < 2; ++k) dst[n][k] = *(const PG8_LAS bf16x8*)(lds + PG8_SB(b, h) + boff + n * 2048 + k * 1024); } while (0)
#define PG8_MMA(ai, bj, At, Bt) do { __builtin_amdgcn_s_setprio(1); _Pragma("unroll") for (int m = 0; m < 4; ++m) _Pragma("unroll") for (int n = 0; n < 2; ++n) _Pragma("unroll") for (int k = 0; k < 2; ++k) \
        acc[ai][bj][m][n] = __builtin_amdgcn_mfma_f32_16x16x32_bf16(Bt[n][k], At[m][k], acc[ai][bj][m][n], 0, 0, 0); __builtin_amdgcn_s_setprio(0); } while (0)
#define PG8_WAIT_V(n) asm volatile("s_waitcnt vmcnt(" #n ")" ::: "memory")
#define PG8_WAIT_L(n) asm volatile("s_waitcnt lgkmcnt(" #n ")" ::: "memory")
#define PG8_BAR __builtin_amdgcn_s_barrier()
#define PG8_SCHED __builtin_amdgcn_sched_barrier(0)
    Unit cur, nxt; int ui = 0;
    if (!S.next(0, cur)) return;
    f32x4 acc[2][2][4][2];
#pragma unroll
    for (int a = 0; a < 2; ++a)
#pragma unroll
        for (int b = 0; b < 2; ++b)
#pragma unroll
            for (int m = 0; m < 4; ++m)
#pragma unroll
                for (int n = 0; n < 2; ++n) acc[a][b][m][n] = (f32x4){0.f, 0.f, 0.f, 0.f};
    bf16x8 At[4][2], B0[2][2], B1[2][2];
    const char* cA = (const char*)g.A + (size_t)cur.pm * tstep; const char* cB = (const char*)g.Bt + (size_t)cur.pn * tstep;
    S.a_ready(cur);
    if constexpr (SP2) {
        PG8_STAGE(PG8_SB(0, 0), cB, voffB); PG8_STAGE(PG8_SB(0, 1), cB + hstep, voffB); PG8_STAGE(PG8_SA(0, 0), cA, voffA); PG8_STAGE(PG8_SA(0, 1), cA + hstep, voffA);
        if (wr == 1) PG8_BAR;
        PG8_WAIT_V(2); PG8_BAR;
        PG8_STAGE(PG8_SB(1, 0), cB + kstep, voffB); PG8_STAGE(PG8_SA(1, 0), cA + kstep, voffA); PG8_STAGE(PG8_SB(1, 1), cB + hstep + kstep, voffB);
        PG8_WAIT_V(6); PG8_BAR;
    } else {
        PG8_STAGE(PG8_SB(0, 0), cB, voffB); PG8_STAGE(PG8_SA(0, 0), cA, voffA); PG8_STAGE(PG8_SB(0, 1), cB + hstep, voffB); PG8_STAGE(PG8_SA(0, 1), cA + hstep, voffA);
        if (wr == 1) PG8_BAR;
        PG8_WAIT_V(4); PG8_BAR;
        PG8_STAGE(PG8_SB(1, 0), cB + kstep, voffB); PG8_STAGE(PG8_SA(1, 0), cA + kstep, voffA); PG8_STAGE(PG8_SB(1, 1), cB + hstep + kstep, voffB);
        PG8_WAIT_V(6); PG8_BAR;
    }
    for (;;) {
        const bool has_next = S.next(ui + 1, nxt);
        const char* nA = has_next ? (const char*)g.A + (size_t)nxt.pm * tstep : cA; const char* nB = has_next ? (const char*)g.Bt + (size_t)nxt.pn * tstep : cB;
        for (int t = 0; t < nt; t += 2) {
            const bool last = (t == nt - 2);
            const char* a1 = cA + (size_t)(t + 1) * kstep;
            const char* a2 = last ? nA : cA + (size_t)(t + 2) * kstep; const char* b2 = last ? nB : cB + (size_t)(t + 2) * kstep;
            const char* a3 = a2 + kstep; const char* b3 = b2 + kstep;
            if (last && has_next) S.a_ready(nxt);
            if constexpr (SP2) {
            PG8_LDB(B0, 0, 0); PG8_LDB(B1, 0, 1); PG8_SCHED; PG8_LDA(At, 0, 0); PG8_STAGE(PG8_SA(1, 1), a1 + hstep, voffA);
            PG8_WAIT_V(8); PG8_WAIT_L(0); PG8_BAR; PG8_MMA(0, 0, At, B0); PG8_MMA(0, 1, At, B1); PG8_BAR; PG8_SCHED;
            PG8_LDA(At, 0, 1); PG8_STAGE(PG8_SB(0, 0), b2, voffB); PG8_STAGE(PG8_SB(0, 1), b2 + hstep, voffB); PG8_STAGE(PG8_SA(0, 0), a2, voffA);
            PG8_WAIT_V(8); PG8_WAIT_L(0); PG8_BAR; PG8_MMA(1, 0, At, B0); PG8_MMA(1, 1, At, B1); PG8_BAR; PG8_SCHED;
            PG8_LDB(B0, 1, 0); PG8_LDB(B1, 1, 1); PG8_SCHED; PG8_LDA(At, 1, 0); PG8_STAGE(PG8_SA(0, 1), a2 + hstep, voffA);
            PG8_WAIT_V(8); PG8_WAIT_L(0); PG8_BAR; PG8_MMA(0, 0, At, B0); PG8_MMA(0, 1, At, B1); PG8_BAR; PG8_SCHED;
            PG8_LDA(At, 1, 1); PG8_STAGE(PG8_SB(1, 0), b3, voffB); PG8_STAGE(PG8_SB(1, 1), b3 + hstep, voffB); PG8_STAGE(PG8_SA(1, 0), a3, voffA);
            PG8_WAIT_V(8); PG8_WAIT_L(0); PG8_BAR; PG8_MMA(1, 0, At, B0); PG8_MMA(1, 1, At, B1); PG8_BAR; PG8_SCHED;
            } else {
            PG8_LDB(B0, 0, 0); PG8_SCHED; PG8_LDA(At, 0, 0); PG8_STAGE(PG8_SA(1, 1), a1 + hstep, voffA);
            PG8_WAIT_L(8); PG8_BAR; PG8_WAIT_L(0); PG8_MMA(0, 0, At, B0); PG8_BAR; PG8_SCHED;
            PG8_LDB(B1, 0, 1); PG8_STAGE(PG8_SB(0, 0), b2, voffB);
            PG8_BAR; PG8_WAIT_L(0); PG8_MMA(0, 1, At, B1); PG8_BAR;
            PG8_LDA(At, 0, 1); PG8_STAGE(PG8_SA(0, 0), a2, voffA);
            PG8_BAR; PG8_WAIT_L(0); PG8_MMA(1, 0, At, B0); PG8_BAR; PG8_SCHED;
            PG8_STAGE(PG8_SB(0, 1), b2 + hstep, voffB);
            PG8_WAIT_V(6); PG8_BAR; PG8_MMA(1, 1, At, B1); PG8_BAR;
            PG8_LDB(B0, 1, 0); PG8_SCHED; PG8_LDA(At, 1, 0); PG8_STAGE(PG8_SA(0, 1), a2 + hstep, voffA);
            PG8_WAIT_L(8); PG8_BAR; PG8_WAIT_L(0); PG8_MMA(0, 0, At, B0); PG8_BAR; PG8_SCHED;
            PG8_LDB(B1, 1, 1); PG8_STAGE(PG8_SB(1, 0), b3, voffB);
            PG8_BAR; PG8_WAIT_L(0); PG8_MMA(0, 1, At, B1); PG8_BAR;
            PG8_LDA(At, 1, 1); PG8_STAGE(PG8_SA(1, 0), a3, voffA);
            PG8_BAR; PG8_WAIT_L(0); PG8_MMA(1, 0, At, B0); PG8_BAR; PG8_SCHED;
            PG8_STAGE(PG8_SB(1, 1), b3 + hstep, voffB);
            PG8_WAIT_V(6); PG8_BAR; PG8_MMA(1, 1, At, B1); PG8_BAR;
            }
        }
        if constexpr (ALIGN_EPI) { if (wr == 0) PG8_BAR; }
        if constexpr (!Epi::AFTER_DRAIN) { E(acc, cur, wr, wc, fr, fq); S.done(cur); }
        if (!has_next) break;
#pragma unroll
        for (int a = 0; a < 2; ++a)
#pragma unroll
            for (int b = 0; b < 2; ++b)
#pragma unroll
                for (int m = 0; m < 4; ++m)
#pragma unroll
                    for (int n = 0; n < 2; ++n) acc[a][b][m][n] = (f32x4){0.f, 0.f, 0.f, 0.f};
        cur = nxt; cA = nA; cB = nB; ++ui;
        if constexpr (ALIGN_EPI) { if (wr == 1) PG8_BAR; }
    }
    PG8_WAIT_V(0);
    if constexpr (!ALIGN_EPI) { if (wr == 0) PG8_BAR; }
    PG8_BAR;
    if constexpr (Epi::AFTER_DRAIN) { E.fused(acc, cur, wr, wc, fr, fq, lds, wid, lane); S.done(cur); }
#undef PG8_SA
#undef PG8_SB
#undef PG8_STAGE
#undef PG8_LDA
#undef PG8_LDB
#undef PG8_MMA
#undef PG8_WAIT_V
#undef PG8_WAIT_L
#undef PG8_BAR
#undef PG8_SCHED
}
}

#define LAS __attribute__((address_space(3)))
typedef unsigned short bf16_t;
typedef short bf16x8 __attribute__((ext_vector_type(8)));
typedef float f32x4 __attribute__((ext_vector_type(4)));
typedef float f32x16 __attribute__((ext_vector_type(16)));
typedef unsigned u32x4 __attribute__((ext_vector_type(4)));
typedef unsigned u32x2 __attribute__((ext_vector_type(2)));

constexpr int DM = 1024, SEQ = 16384, NSMP = 128, MV = SEQ + NSMP, MT = 16640;
constexpr int NIN = 11296, NINP = 11520, DFF = 2816, DIN = 2048, CONVD = 4096;
constexpr int NCHUNK = 264;
constexpr size_t HPN = 32 * 64 * 128;
constexpr int PAST = 4096;

constexpr size_t O_YP = 0, O_YS = O_YP + (size_t)SEQ * DM, O_KP = O_YS + (size_t)NSMP * DM, O_VP = O_KP + 2ull * SEQ * DM,
                 O_CP = O_VP + 2ull * SEQ * DM, O_SP = O_CP + 2ull * 3 * CONVD, O_KS = O_SP + 2ull * HPN, O_VS = O_KS + 2ull * NSMP * DM,
                 O_CS = O_VS + 2ull * NSMP * DM, O_SS = O_CS + 2ull * 8 * 3 * CONVD, O_END = O_SS + 2ull * 8 * HPN;

constexpr size_t MiB = 1ull << 20;
constexpr size_t SZ_WIN = (size_t)NINP * 1024 * 2, SZ_WBA = 1024ull * 1024 * 2, SZ_WBS = 1024ull * 2048 * 2, SZ_WOUT = SZ_WBA,
                 SZ_WGU = 5632ull * 1024 * 2, SZ_WD = 1024ull * DFF * 2;
constexpr size_t WS_CTL = 0, CTL_BYTES = 65536;
constexpr size_t WS_WIN = 1 * MiB, WS_WBA = WS_WIN + 2 * SZ_WIN, WS_WBS = WS_WBA + 2 * SZ_WBA, WS_WOUT = WS_WBS + 2 * SZ_WBS,
                 WS_WGU = WS_WOUT + 2 * SZ_WOUT, WS_WD = WS_WGU + 2 * SZ_WGU, WS_WEND = WS_WD + 2 * SZ_WD;
constexpr size_t WS_KC = (WS_WEND + MiB - 1) / MiB * MiB;
constexpr size_t WS_VTC = WS_KC + 8ull * PAST * 1024 * 2;
constexpr size_t WS_X = WS_VTC + 8ull * PAST * 1024 * 2;
constexpr size_t WS_XB = WS_X + (size_t)MT * 1024 * 4;
constexpr size_t WS_PART = WS_XB + (size_t)MT * 1024 * 2;
constexpr size_t WS_Q = WS_PART + (size_t)MT * 16 * 4;
constexpr size_t WS_K = WS_Q + (size_t)MT * 1024 * 2;
constexpr size_t WS_VT = WS_K + (size_t)MT * 1024 * 2;
constexpr size_t WS_Z = WS_VT + (size_t)MT * 1024 * 2;
constexpr size_t WS_XBC = WS_Z + (size_t)MT * 2048 * 2;
constexpr size_t WS_G = WS_XBC + (size_t)MT * 4096 * 2;
constexpr size_t WS_DT = WS_G + (size_t)MT * 2048 * 2;
constexpr size_t WS_CS = WS_DT + (size_t)MT * 32 * 4;
constexpr size_t WS_CDEC = WS_CS + (size_t)NCHUNK * HPN * 2;
constexpr size_t WS_ATT = WS_CDEC + 65536;
constexpr size_t WS_YSSD = WS_ATT + (size_t)MT * 1024 * 2;
constexpr size_t WS_HIST = WS_YSSD + (size_t)MT * 2048 * 2;
constexpr size_t WS_XTG = WS_HIST + 256ull * 3 * 4096 * 2;
constexpr size_t WS_BTG = WS_XTG + (size_t)NCHUNK * 2048 * 64 * 2;
constexpr size_t WS_ACTS = WS_BTG + (size_t)NCHUNK * 1024 * 64 * 2;
constexpr size_t WS_DTA = WS_ACTS + 256ull * DFF * 2;
constexpr size_t WS_ACSG = WS_DTA + (size_t)NCHUNK * 32 * 64 * 4;
constexpr size_t WS_END = WS_ACSG + (size_t)NCHUNK * 32 * 64 * 4;
static_assert(WS_END <= 1024ull * MiB, "workspace map must fit 1 GiB");

constexpr int LDS_CTL = 131072, LDS_BYTES = 131072 + 1024;
constexpr int AT_KROW = 272, AT_VROW = 144, AT_KSZ = 64 * AT_KROW, AT_VSZ = 128 * AT_VROW, AT_STAGE = AT_KSZ + AT_VSZ;
constexpr int SD_DT = 0, SD_ACS = 1024, SD_RS = 2048, SD_BT = 4096, SD_XT = SD_BT + 128 * 144, SD_CM = SD_XT + 256 * 144, SD_BM = SD_CM + 64 * 272, SD_END = SD_BM + 64 * 272;
static_assert(SD_END <= 131072 && 2 * AT_STAGE <= 131072, "lds");

struct Args { const float* in[26]; float* out; unsigned char* ws; int ph_lo, ph_hi; };

__device__ __forceinline__ unsigned pk_bf16(float lo, float hi) {
    typedef float f2 __attribute__((ext_vector_type(2))); typedef __bf16 b2 __attribute__((ext_vector_type(2)));
    f2 v = {lo, hi}; b2 b = __builtin_convertvector(v, b2); return __builtin_bit_cast(unsigned, b);
}
__device__ __forceinline__ float bf_lo(unsigned u) { return __uint_as_float(u << 16); }
__device__ __forceinline__ float bf_hi(unsigned u) { return __uint_as_float(u & 0xffff0000u); }
__device__ __forceinline__ float fexp2(float x) { return __builtin_amdgcn_exp2f(x); }
__device__ __forceinline__ float fexp(float x) { return __builtin_amdgcn_exp2f(x * 1.4426950408889634f); }
__device__ __forceinline__ float frcp(float x) { return __builtin_amdgcn_rcpf(x); }
__device__ __forceinline__ float silu_f(float x) { return x * frcp(1.0f + fexp(-x)); }
__device__ __forceinline__ float sigmoid_f(float x) { return frcp(1.0f + fexp(-x)); }
__device__ __forceinline__ float wave_sum(float v) {
#pragma unroll
    for (int o = 1; o < 64; o <<= 1) v += __shfl_xor(v, o);
    return v;
}
__device__ __forceinline__ unsigned my_xcc_id() { return (unsigned)__builtin_amdgcn_s_getreg((3 << 11) | 20) & 0xFu; }
__device__ __forceinline__ int sig5(int i) { return (i & ~12) | ((i & 4) << 1) | ((i & 8) >> 1); }
__device__ __forceinline__ float rstd1(const float* rss, int row, float eps) { return 1.0f / sqrtf(rss[row] * (1.0f / 1024.0f) + eps); }
__device__ __forceinline__ float rstd_row(const float* part, int row, float eps) {
    const f32x4* p = (const f32x4*)(part + (size_t)row * 16);
    const f32x4 a = p[0], b = p[1], c = p[2], d = p[3];
    const float s = ((a.x + a.y) + (a.z + a.w)) + ((b.x + b.y) + (b.z + b.w)) + ((c.x + c.y) + (c.z + c.w)) + ((d.x + d.y) + (d.z + d.w));
    return 1.0f / sqrtf(s * (1.0f / 1024.0f) + eps);
}
__device__ __forceinline__ float max3f(float a, float b, float c) { float r; asm("v_max3_f32 %0, %1, %2, %3" : "=v"(r) : "v"(a), "v"(b), "v"(c)); return r; }
#define MFMA32(a, b, c) __builtin_amdgcn_mfma_f32_32x32x16_bf16((a), (b), (c), 0, 0, 0)

#define EPI_LOOP_ROWS _Pragma("unroll") for (int ai = 0; ai < 2; ++ai) _Pragma("unroll") for (int m = 0; m < 4; ++m)
#define EPI_LOOP_COLS _Pragma("unroll") for (int bj = 0; bj < 2; ++bj) _Pragma("unroll") for (int n = 0; n < 2; ++n)

struct EpiIn {
    static constexpr bool PERM = true, AFTER_DRAIN = false;
    const float* part; bf16_t *Q, *K, *VT, *Z, *XBC, *G; float* DT; float* out; int layer; bf16_t* HIST;
    __device__ __forceinline__ void operator()(const pg8::f32x4 (&acc)[2][2][4][2], const pg8::Unit& u, int wr, int wc, int fr, int fq) const {
        const int pn = u.pn; const int cb = pn * 256 + wc * 32 + 8 * fq;
        float rsv[2][4];
#pragma unroll
        for (int ai = 0; ai < 2; ++ai)
#pragma unroll
            for (int m = 0; m < 4; ++m) rsv[ai][m] = part[u.pm * 256 + ai * 128 + wr * 64 + m * 16 + fr];
#pragma unroll
        for (int ai = 0; ai < 2; ++ai)
#pragma unroll
            for (int m = 0; m < 4; ++m) rsv[ai][m] = 1.0f / sqrtf(rsv[ai][m] * (1.0f / 1024.0f) + 1e-6f);
        EPI_LOOP_ROWS {
            const int row = u.pm * 256 + ai * 128 + wr * 64 + m * 16 + fr;
            const float rs = rsv[ai][m];
#pragma unroll
            for (int bj = 0; bj < 2; ++bj) {
                const pg8::f32x4 v0 = acc[ai][bj][m][0] * rs, v1 = acc[ai][bj][m][1] * rs; const int col = cb + bj * 128;
                if (pn < 4) {
                    const float sc = 0.125f * 1.4426950408889634f;
                    u32x4 w; w.x = pk_bf16(v0[0] * sc, v0[1] * sc); w.y = pk_bf16(v0[2] * sc, v0[3] * sc); w.z = pk_bf16(v1[0] * sc, v1[1] * sc); w.w = pk_bf16(v1[2] * sc, v1[3] * sc);
                    *(u32x4*)(Q + (size_t)row * 1024 + col) = w;
                } else if (pn < 8) {
                    const int c = col - 1024; u32x4 w; w.x = pk_bf16(v0[0], v0[1]); w.y = pk_bf16(v0[2], v0[3]); w.z = pk_bf16(v1[0], v1[1]); w.w = pk_bf16(v1[2], v1[3]);
                    *(u32x4*)(K + (size_t)row * 1024 + c) = w;
                    float* o = nullptr;
                    if (row < SEQ) o = out + O_KP + ((size_t)layer * SEQ + row) * 1024 + c; else if (row < MV) o = out + O_KS + ((size_t)layer * NSMP + (row - SEQ)) * 1024 + c;
                    if (o) { *(pg8::f32x4*)o = v0; *(pg8::f32x4*)(o + 4) = v1; }
                } else if (pn < 12) {
                    const int c = col - 2048;
                    const unsigned w0 = pk_bf16(v0[0], v0[1]), w1 = pk_bf16(v0[2], v0[3]), w2 = pk_bf16(v1[0], v1[1]), w3 = pk_bf16(v1[2], v1[3]);
                    VT[(size_t)(c + 0) * MT + row] = (bf16_t)(w0 & 0xffffu); VT[(size_t)(c + 1) * MT + row] = (bf16_t)(w0 >> 16);
                    VT[(size_t)(c + 2) * MT + row] = (bf16_t)(w1 & 0xffffu); VT[(size_t)(c + 3) * MT + row] = (bf16_t)(w1 >> 16);
                    VT[(size_t)(c + 4) * MT + row] = (bf16_t)(w2 & 0xffffu); VT[(size_t)(c + 5) * MT + row] = (bf16_t)(w2 >> 16);
                    VT[(size_t)(c + 6) * MT + row] = (bf16_t)(w3 & 0xffffu); VT[(size_t)(c + 7) * MT + row] = (bf16_t)(w3 >> 16);
                    float* o = nullptr;
                    if (row < SEQ) o = out + O_VP + ((size_t)layer * SEQ + row) * 1024 + c; else if (row < MV) o = out + O_VS + ((size_t)layer * NSMP + (row - SEQ)) * 1024 + c;
                    if (o) { *(pg8::f32x4*)o = v0; *(pg8::f32x4*)(o + 4) = v1; }
                } else if (pn < 20) {
                    const int c = col - 3072; u32x4 w; w.x = pk_bf16(v0[0], v0[1]); w.y = pk_bf16(v0[2], v0[3]); w.z = pk_bf16(v1[0], v1[1]); w.w = pk_bf16(v1[2], v1[3]);
                    *(u32x4*)(Z + (size_t)row * 2048 + c) = w;
                } else if (pn < 36) {
                    const int c = col - 5120; u32x4 w; w.x = pk_bf16(v0[0], v0[1]); w.y = pk_bf16(v0[2], v0[3]); w.z = pk_bf16(v1[0], v1[1]); w.w = pk_bf16(v1[2], v1[3]);
                    *(u32x4*)(XBC + (size_t)row * 4096 + c) = w;
                    if (row < SEQ && (row & 63) >= 61) *(u32x4*)(HIST + ((size_t)(row >> 6) * 3 + ((row & 63) - 61)) * 4096 + c) = w;
                    float* o = nullptr;
                    if (row >= SEQ - 3 && row < SEQ) o = out + O_CP + ((size_t)layer * 3 + (row - (SEQ - 3))) * 4096 + c;
                    else if (row >= SEQ && row < MV) { const int s = row - SEQ, t = s & 15; if (t >= 13) o = out + O_CS + (((size_t)layer * 8 + (s >> 4)) * 3 + (t - 13)) * 4096 + c; }
                    if (o) { *(pg8::f32x4*)o = v0; *(pg8::f32x4*)(o + 4) = v1; }
                } else if (pn < 44) {
                    const int c = col - 9216; u32x4 w; w.x = pk_bf16(sigmoid_f(v0[0]), sigmoid_f(v0[1])); w.y = pk_bf16(sigmoid_f(v0[2]), sigmoid_f(v0[3]));
                    w.z = pk_bf16(sigmoid_f(v1[0]), sigmoid_f(v1[1])); w.w = pk_bf16(sigmoid_f(v1[2]), sigmoid_f(v1[3]));
                    *(u32x4*)(G + (size_t)row * 2048 + c) = w;
                } else {
                    const int c = col - 11264;
                    if (c < 32) { *(pg8::f32x4*)(DT + (size_t)row * 32 + c) = v0; *(pg8::f32x4*)(DT + (size_t)row * 32 + c + 4) = v1; }
                }
            }
        }
    }
};

struct EpiNull {
    static constexpr bool PERM = false, AFTER_DRAIN = false; float* sink;
    __device__ __forceinline__ void operator()(const pg8::f32x4 (&acc)[2][2][4][2], const pg8::Unit& u, int wr, int wc, int fr, int fq) const {
        pg8::f32x4 s = acc[0][0][0][0];
        EPI_LOOP_ROWS { EPI_LOOP_COLS { s += acc[ai][bj][m][n]; } }
        if (s[0] == 123456.789f) sink[0] = s[1] + s[2] + s[3];
    }
};
struct EpiBrA {
    static constexpr bool PERM = false, AFTER_DRAIN = false;
    const bf16_t* G; float* MF; int row0;
    __device__ __forceinline__ void operator()(const pg8::f32x4 (&acc)[2][2][4][2], const pg8::Unit& u, int wr, int wc, int fr, int fq) const {
        const int cb = u.pn * 256 + wc * 32 + 4 * fq;
        EPI_LOOP_ROWS { const int row = row0 + u.pm * 256 + ai * 128 + wr * 64 + m * 16 + fr;
            EPI_LOOP_COLS { const int col = cb + bj * 128 + n * 16; const u32x2 g = *(const u32x2*)(G + (size_t)row * 2048 + col);
                pg8::f32x4 v = acc[ai][bj][m][n]; v[0] *= bf_lo(g.x); v[1] *= bf_hi(g.x); v[2] *= bf_lo(g.y); v[3] *= bf_hi(g.y);
                *(pg8::f32x4*)(MF + (size_t)row * 1024 + col) = v; } }
    }
};
struct EpiBrB {
    static constexpr bool PERM = false, AFTER_DRAIN = false;
    const bf16_t* G; const float* MF; bf16_t* MB; int row0;
    __device__ __forceinline__ void operator()(const pg8::f32x4 (&acc)[2][2][4][2], const pg8::Unit& u, int wr, int wc, int fr, int fq) const {
        const int cb = u.pn * 256 + wc * 32 + 4 * fq;
        EPI_LOOP_ROWS { const int row = row0 + u.pm * 256 + ai * 128 + wr * 64 + m * 16 + fr;
            EPI_LOOP_COLS { const int col = cb + bj * 128 + n * 16; const u32x2 g = *(const u32x2*)(G + (size_t)row * 2048 + 1024 + col);
                const pg8::f32x4 a = acc[ai][bj][m][n]; const pg8::f32x4 o = *(const pg8::f32x4*)(MF + (size_t)row * 1024 + col);
                u32x2 w; w.x = pk_bf16(o[0] + a[0] * bf_lo(g.x), o[1] + a[1] * bf_hi(g.x)); w.y = pk_bf16(o[2] + a[2] * bf_lo(g.y), o[3] + a[3] * bf_hi(g.y));
                *(u32x2*)(MB + (size_t)row * 1024 + col) = w; } }
    }
};
struct EpiRes {
    static constexpr bool PERM = false, AFTER_DRAIN = false;
    float* X; bf16_t* XB; float* part; int row0;
    __device__ __forceinline__ void operator()(const pg8::f32x4 (&acc)[2][2][4][2], const pg8::Unit& u, int wr, int wc, int fr, int fq) const {
        const int cb = u.pn * 256 + wc * 32 + 4 * fq;
        EPI_LOOP_ROWS { const int row = row0 + u.pm * 256 + ai * 128 + wr * 64 + m * 16 + fr; float ss = 0.f;
            EPI_LOOP_COLS { const int col = cb + bj * 128 + n * 16; float* xp = X + (size_t)row * 1024 + col;
                const pg8::f32x4 x = *(const pg8::f32x4*)xp + acc[ai][bj][m][n];
                *(pg8::f32x4*)xp = x; u32x2 w; w.x = pk_bf16(x[0], x[1]); w.y = pk_bf16(x[2], x[3]); *(u32x2*)(XB + (size_t)row * 1024 + col) = w;
                ss += (x[0] * x[0] + x[1] * x[1]) + (x[2] * x[2] + x[3] * x[3]); }
            ss += __shfl_xor(ss, 16); ss += __shfl_xor(ss, 32);
            if (fq == 0) atomicAdd(part + row, ss); }
    }
};
struct EpiGU {
    static constexpr bool PERM = true, AFTER_DRAIN = false;
    const float* part; bf16_t* ACT; int row0; int act_sub;
    __device__ __forceinline__ void operator()(const pg8::f32x4 (&acc)[2][2][4][2], const pg8::Unit& u, int wr, int wc, int fr, int fq) const {
        const int cb = u.pn * 128 + wc * 32 + 8 * fq;
        float rsv[2][4];
#pragma unroll
        for (int ai = 0; ai < 2; ++ai)
#pragma unroll
            for (int m = 0; m < 4; ++m) rsv[ai][m] = part[row0 + u.pm * 256 + ai * 128 + wr * 64 + m * 16 + fr];
#pragma unroll
        for (int ai = 0; ai < 2; ++ai)
#pragma unroll
            for (int m = 0; m < 4; ++m) rsv[ai][m] = 1.0f / sqrtf(rsv[ai][m] * (1.0f / 1024.0f) + 1e-6f);
        EPI_LOOP_ROWS { const int row = row0 - act_sub + u.pm * 256 + ai * 128 + wr * 64 + m * 16 + fr; const float rs = rsv[ai][m];
            const pg8::f32x4 g0 = acc[ai][0][m][0] * rs, g1 = acc[ai][0][m][1] * rs, u0 = acc[ai][1][m][0] * rs, u1 = acc[ai][1][m][1] * rs;
            u32x4 w; w.x = pk_bf16(silu_f(g0[0]) * u0[0], silu_f(g0[1]) * u0[1]); w.y = pk_bf16(silu_f(g0[2]) * u0[2], silu_f(g0[3]) * u0[3]);
            w.z = pk_bf16(silu_f(g1[0]) * u1[0], silu_f(g1[1]) * u1[1]); w.w = pk_bf16(silu_f(g1[2]) * u1[2], silu_f(g1[3]) * u1[3]);
            *(u32x4*)(ACT + (size_t)row * DFF + cb) = w; }
    }
};

struct Ctx {
    LAS unsigned char* lds; int tid, lane, wid, G, bid;
    const float* in[26]; float* out; unsigned char* ws;
};
#define WSP(T, off) ((T*)(C.ws + (off)))

struct TItem { const float* W; int N, k0, n0; bf16_t* WT; size_t dst_row0; int Kd; const float* kscale; };
struct TRegs { float tv[32]; f32x4 s0, s1; };
__device__ __forceinline__ void tr_load(const TItem& t, TRegs& r, int lane) {
#pragma unroll
    for (int i = 0; i < 32; ++i) r.tv[i] = t.W[(size_t)(t.k0 + 2 * i + (lane >> 5)) * t.N + t.n0 + (lane & 31)];
    if (t.kscale) { r.s0 = *(const f32x4*)(t.kscale + t.k0 + 8 * (lane & 7)); r.s1 = *(const f32x4*)(t.kscale + t.k0 + 8 * (lane & 7) + 4); }
    else { r.s0 = (f32x4){1.f, 1.f, 1.f, 1.f}; r.s1 = r.s0; }
}
__device__ __forceinline__ void tr_finish(const TItem& t, const TRegs& r, LAS float* scr, int lane) {
#pragma unroll
    for (int i = 0; i < 32; ++i) scr[(2 * i + (lane >> 5)) * 33 + (lane & 31)] = r.tv[i];
    asm volatile("s_waitcnt lgkmcnt(0)" ::: "memory");
    const int c = lane & 7;
#pragma unroll
    for (int j = 0; j < 4; ++j) { const int n = (lane >> 3) + 8 * j; const LAS float* s = scr + (8 * c) * 33 + n;
        u32x4 o; o.x = pk_bf16(s[0 * 33] * r.s0.x, s[1 * 33] * r.s0.y); o.y = pk_bf16(s[2 * 33] * r.s0.z, s[3 * 33] * r.s0.w);
        o.z = pk_bf16(s[4 * 33] * r.s1.x, s[5 * 33] * r.s1.y); o.w = pk_bf16(s[6 * 33] * r.s1.z, s[7 * 33] * r.s1.w);
        *(u32x4*)(t.WT + (t.dst_row0 + n) * (size_t)t.Kd + t.k0 + 8 * c) = o; }
    asm volatile("s_waitcnt lgkmcnt(0)" ::: "memory");
}
__device__ __forceinline__ bool p0_item(const Ctx& C, int it, TItem& t) {
    constexpr int I_IN = 16 * 353, I_BA = 16 * 32, I_BS = 32 * 32, I_OUT = 16 * 32, I_GU = 16 * 176, I_D = 44 * 32, I_L = I_IN + I_BA + I_BS + I_OUT + I_GU + I_D;
    if (it >= 2 * I_L) return false;
    const int L = it / I_L; int r = it % I_L; t.kscale = nullptr;
    if (r < I_IN) { const int kb = r / 353, nb = r % 353, n0 = 32 * nb;
        t.W = C.in[7] + (size_t)L * 1024 * NIN; t.N = NIN; t.k0 = 64 * kb; t.n0 = n0; t.WT = WSP(bf16_t, WS_WIN + L * SZ_WIN);
        t.dst_row0 = n0 < 9216 ? n0 : (n0 < 9248 ? 11264 + (n0 - 9216) : 9216 + (n0 - 9248)); t.Kd = 1024; t.kscale = C.in[6] + L * 1024; return true; }
    r -= I_IN;
    if (r < I_BA) { t.W = C.in[19] + (size_t)L * 1024 * 1024; t.N = 1024; t.k0 = 64 * (r / 32); t.n0 = 32 * (r % 32); t.WT = WSP(bf16_t, WS_WBA + L * SZ_WBA); t.dst_row0 = t.n0; t.Kd = 1024; return true; }
    r -= I_BA;
    if (r < I_BS) { t.W = C.in[20] + (size_t)L * 2048 * 1024; t.N = 1024; t.k0 = 64 * (r / 32); t.n0 = 32 * (r % 32); t.WT = WSP(bf16_t, WS_WBS + L * SZ_WBS); t.dst_row0 = t.n0; t.Kd = 2048; return true; }
    r -= I_BS;
    if (r < I_OUT) { t.W = C.in[21] + (size_t)L * 1024 * 1024; t.N = 1024; t.k0 = 64 * (r / 32); t.n0 = 32 * (r % 32); t.WT = WSP(bf16_t, WS_WOUT + L * SZ_WOUT); t.dst_row0 = t.n0; t.Kd = 1024; return true; }
    r -= I_OUT;
    if (r < I_GU) { const int kb = r / 176, nb = r % 176, n0 = 32 * nb; const int ch = n0 % DFF;
        t.W = C.in[23] + (size_t)L * 1024 * 5632; t.N = 5632; t.k0 = 64 * kb; t.n0 = n0; t.WT = WSP(bf16_t, WS_WGU + L * SZ_WGU);
        t.dst_row0 = 256 * (ch / 128) + (ch % 128) + (n0 >= DFF ? 128 : 0); t.Kd = 1024; t.kscale = C.in[22] + L * 1024; return true; }
    r -= I_GU;
    t.W = C.in[24] + (size_t)L * DFF * 1024; t.N = 1024; t.k0 = 64 * (r / 32); t.n0 = 32 * (r % 32); t.WT = WSP(bf16_t, WS_WD + L * SZ_WD); t.dst_row0 = t.n0; t.Kd = DFF; return true;
}

__device__ __forceinline__ void phase_p0(Ctx& C) {
    LAS float* scr = (LAS float*)(C.lds + C.wid * 8704);
    const int gw = C.bid * 8 + C.wid, NGW = C.G * 8;
    {   TItem cur, nxt; TRegs ra, rb; int it = gw;
        bool have = p0_item(C, it, cur); if (have) tr_load(cur, ra, C.lane);
        while (have) { it += NGW; const bool hn = p0_item(C, it, nxt); if (hn) tr_load(nxt, rb, C.lane);
            tr_finish(cur, ra, scr, C.lane); cur = nxt; ra = rb; have = hn; } }
    {   const int nz = 2 * (NINP - NIN) * 1024 / 8;
        for (int i = C.bid * 512 + C.tid; i < nz; i += C.G * 512) { const int L = i / ((NINP - NIN) * 128), r = i % ((NINP - NIN) * 128);
            *(u32x4*)(WSP(bf16_t, WS_WIN + L * SZ_WIN) + (size_t)NIN * 1024 + (size_t)r * 8) = (u32x4){0u, 0u, 0u, 0u}; } }
    float* X = WSP(float, WS_X); bf16_t* XB = WSP(bf16_t, WS_XB); float* PART = WSP(float, WS_PART);
    for (int mrow = gw; mrow < MT; mrow += NGW) {
        f32x4 v[4]; float ss = 0.f;
#pragma unroll
        for (int j = 0; j < 4; ++j) {
            if (mrow < SEQ) v[j] = *(const f32x4*)(C.in[0] + (size_t)mrow * 1024 + 4 * C.lane + 256 * j);
            else if (mrow < MV) v[j] = *(const f32x4*)(C.in[1] + (size_t)(mrow - SEQ) * 1024 + 4 * C.lane + 256 * j);
            else v[j] = (f32x4){0.f, 0.f, 0.f, 0.f};
            ss += (v[j].x * v[j].x + v[j].y * v[j].y) + (v[j].z * v[j].z + v[j].w * v[j].w);
            *(f32x4*)(X + (size_t)mrow * 1024 + 4 * C.lane + 256 * j) = v[j];
            u32x2 w; w.x = pk_bf16(v[j].x, v[j].y); w.y = pk_bf16(v[j].z, v[j].w);
            *(u32x2*)(XB + (size_t)mrow * 1024 + 4 * C.lane + 256 * j) = w;
        }
        ss = wave_sum(ss);
        if (C.lane < 5) PART[(size_t)C.lane * MT + mrow] = (C.lane == 0) ? ss : 0.f;
    }
}

__device__ __forceinline__ void cache_convert(Ctx& C, int L) {
    const float* ck = C.in[2] + (size_t)L * 8 * PAST * 1024; bf16_t* KC = WSP(bf16_t, WS_KC);
    const int ntask = 8 * PAST * 1024 / 8;
    {   const int stride = C.G * 512;
        for (int i0 = C.bid * 512 + C.tid; i0 < ntask; i0 += 4 * stride) { f32x4 a[4], b[4];
#pragma unroll
            for (int j = 0; j < 4; ++j) { const int i = i0 + j * stride; if (i < ntask) { a[j] = *(const f32x4*)(ck + (size_t)i * 8); b[j] = *(const f32x4*)(ck + (size_t)i * 8 + 4); } }
#pragma unroll
            for (int j = 0; j < 4; ++j) { const int i = i0 + j * stride; if (i < ntask) { u32x4 o; o.x = pk_bf16(a[j].x, a[j].y); o.y = pk_bf16(a[j].z, a[j].w); o.z = pk_bf16(b[j].x, b[j].y); o.w = pk_bf16(b[j].z, b[j].w);
                *(u32x4*)(KC + (size_t)i * 8) = o; } } } }
    LAS float* scr = (LAS float*)(C.lds + C.wid * 8704);
    const int gw = C.bid * 8 + C.wid, NGW = C.G * 8;
    {   TItem cur, nxt; TRegs ra, rb; int it = gw;
#define CV_ITEM(IT, T) ((IT) < 8 * 2048 ? ((T).W = C.in[3] + ((size_t)L * 8 + (IT) / 2048) * PAST * 1024, (T).N = 1024, (T).k0 = 64 * (((IT) % 2048) / 32), (T).n0 = 32 * ((IT) % 32), \
            (T).WT = WSP(bf16_t, WS_VTC) + (size_t)((IT) / 2048) * 1024 * PAST, (T).dst_row0 = (size_t)(T).n0, (T).Kd = PAST, (T).kscale = nullptr, true) : false)
        bool have = CV_ITEM(it, cur); if (have) tr_load(cur, ra, C.lane);
        while (have) { it += NGW; const bool hn = CV_ITEM(it, nxt); if (hn) tr_load(nxt, rb, C.lane);
            tr_finish(cur, ra, scr, C.lane); cur = nxt; ra = rb; have = hn; }
#undef CV_ITEM
    }
}

struct ChunkInfo { int base, Lc, mode; const float* hist; };
__device__ __forceinline__ ChunkInfo chunk_info(const Ctx& C, int L, int c) {
    ChunkInfo ci;
    if (c < 256) { ci.base = 64 * c; ci.Lc = 64; ci.mode = (c == 0) ? 1 : 0; ci.hist = nullptr; }
    else { const int b = c - 256; ci.base = SEQ + 16 * b; ci.Lc = 16; ci.mode = 2; ci.hist = C.in[4] + ((size_t)L * 8 + b) * 3 * CONVD; }
    return ci;
}
__device__ __forceinline__ void conv_t8(const bf16_t* XBC, const ChunkInfo& ci, const float* cw, const float* cbias, int col, int l0, float (&o0)[8], float (&o1)[8]) {
    float i0[11], i1[11];
#pragma unroll
    for (int i = 0; i < 11; ++i) { const int rr = l0 - 3 + i;
        if (rr >= 0 || ci.mode == 0) { const unsigned v = *(const unsigned*)(XBC + (size_t)(ci.base + rr) * 4096 + col); i0[i] = bf_lo(v); i1[i] = bf_hi(v); }
        else if (ci.mode == 1) { i0[i] = 0.f; i1[i] = 0.f; }
        else { const float* hp = ci.hist + (size_t)(3 + rr) * 4096 + col; i0[i] = hp[0]; i1[i] = hp[1]; } }
    float w0[4], w1[4];
#pragma unroll
    for (int j = 0; j < 4; ++j) { w0[j] = cw[j * 4096 + col]; w1[j] = cw[j * 4096 + col + 1]; }
    const float b0 = cbias[col], b1 = cbias[col + 1];
#pragma unroll
    for (int k = 0; k < 8; ++k) { float a0 = b0, a1 = b1;
#pragma unroll
        for (int j = 0; j < 4; ++j) { a0 += w0[j] * i0[k + j]; a1 += w1[j] * i1[k + j]; }
        o0[k] = silu_f(a0); o1[k] = silu_f(a1); }
}
__device__ __forceinline__ void conv_n8(const bf16_t* XBC, const ChunkInfo& ci, const float* cw, const float* cbias, int col, int l, float (&o)[8]) {
    { const f32x4 b0 = *(const f32x4*)(cbias + col), b1 = *(const f32x4*)(cbias + col + 4);
      o[0] = b0.x; o[1] = b0.y; o[2] = b0.z; o[3] = b0.w; o[4] = b1.x; o[5] = b1.y; o[6] = b1.z; o[7] = b1.w; }
#pragma unroll
    for (int j = 0; j < 4; ++j) { const int rr = l - 3 + j; float x[8];
        if (rr >= 0 || ci.mode == 0) { const u32x4 v = *(const u32x4*)(XBC + (size_t)(ci.base + rr) * 4096 + col);
            x[0] = bf_lo(v.x); x[1] = bf_hi(v.x); x[2] = bf_lo(v.y); x[3] = bf_hi(v.y); x[4] = bf_lo(v.z); x[5] = bf_hi(v.z); x[6] = bf_lo(v.w); x[7] = bf_hi(v.w); }
        else if (ci.mode == 1) {
#pragma unroll
            for (int q = 0; q < 8; ++q) x[q] = 0.f; }
        else { const float* hp = ci.hist + (size_t)(3 + rr) * 4096 + col; const f32x4 h0 = *(const f32x4*)hp, h1 = *(const f32x4*)(hp + 4);
            x[0] = h0.x; x[1] = h0.y; x[2] = h0.z; x[3] = h0.w; x[4] = h1.x; x[5] = h1.y; x[6] = h1.z; x[7] = h1.w; }
        const f32x4 wa = *(const f32x4*)(cw + j * 4096 + col), wb = *(const f32x4*)(cw + j * 4096 + col + 4);
        o[0] += wa.x * x[0]; o[1] += wa.y * x[1]; o[2] += wa.z * x[2]; o[3] += wa.w * x[3]; o[4] += wb.x * x[4]; o[5] += wb.y * x[5]; o[6] += wb.z * x[6]; o[7] += wb.w * x[7]; }
#pragma unroll
    for (int q = 0; q < 8; ++q) o[q] = silu_f(o[q]);
}
__device__ __forceinline__ void ssd_dt_acs(Ctx& C, int L, const ChunkInfo& ci, int c, int g, bool write_cdec) {
    if (C.wid < 4) { const int h = 4 * g + C.wid, l = C.lane;
        const float raw = WSP(const float, WS_DT)[(size_t)(ci.base + l) * 32 + h] + C.in[15][L * 32 + h];
        float dt = raw > 20.f ? raw : log1pf(expf(raw)); if (l >= ci.Lc) dt = 0.f;
        const float A = -expf(C.in[16][L * 32 + h]); float a = dt * A;
#pragma unroll
        for (int o = 1; o < 64; o <<= 1) { const float t = __shfl_up(a, o); if (l >= o) a += t; }
        ((LAS float*)(C.lds + SD_DT))[C.wid * 64 + l] = dt; ((LAS float*)(C.lds + SD_ACS))[C.wid * 64 + l] = a;
        if (write_cdec && l == 63) WSP(float, WS_CDEC)[c * 32 + h] = expf(a);
    }
}
__device__ __forceinline__ void st8_bf16(LAS unsigned char* p, const float (&o)[8]) {
    u32x4 w; w.x = pk_bf16(o[0], o[1]); w.y = pk_bf16(o[2], o[3]); w.z = pk_bf16(o[4], o[5]); w.w = pk_bf16(o[6], o[7]); *(LAS u32x4*)p = w;
}

__device__ __forceinline__ void conv_unit(Ctx& C, int L, int c, int slab) {
    const ChunkInfo ci = chunk_info(C, L, c);
    bf16_t* XBC = WSP(bf16_t, WS_XBC); const bf16_t* HIST = WSP(const bf16_t, WS_HIST);
    const float* cw = C.in[13] + (size_t)L * 4 * CONVD; const float* cbias = C.in[14] + (size_t)L * CONVD;
    const int col0 = slab * 512;
    {   u32x4 v[8];
#pragma unroll
        for (int k = 0; k < 8; ++k) { const int idx = C.tid + 512 * k; v[k] = *(const u32x4*)(XBC + (size_t)(ci.base + (idx >> 6)) * 4096 + col0 + (idx & 63) * 8); }
        if (C.tid < 192) { const int r = C.tid >> 6, c16 = C.tid & 63; u32x4 hv;
            if (ci.mode == 1) hv = (u32x4){0u, 0u, 0u, 0u};
            else if (ci.mode == 0) hv = *(const u32x4*)(HIST + ((size_t)(c - 1) * 3 + r) * 4096 + col0 + c16 * 8);
            else { const float* hp = ci.hist + (size_t)r * 4096 + col0 + c16 * 8; const f32x4 a = *(const f32x4*)hp, b = *(const f32x4*)(hp + 4);
                hv.x = pk_bf16(a.x, a.y); hv.y = pk_bf16(a.z, a.w); hv.z = pk_bf16(b.x, b.y); hv.w = pk_bf16(b.z, b.w); }
            *(LAS u32x4*)(C.lds + r * 1024 + c16 * 16) = hv; }
#pragma unroll
        for (int k = 0; k < 8; ++k) { const int idx = C.tid + 512 * k; *(LAS u32x4*)(C.lds + (3 + (idx >> 6)) * 1024 + (idx & 63) * 16) = v[k]; }
    }
    __syncthreads();
#pragma unroll 1
    for (int i = 0; i < 4; ++i) { const int task = C.tid + 512 * i, p = task & 255, lb = task >> 8, l0 = 8 * lb, col = col0 + 2 * p;
        float i0[11], i1[11];
#pragma unroll
        for (int k = 0; k < 11; ++k) { const unsigned v = *(const LAS unsigned*)(C.lds + (l0 + k) * 1024 + p * 4); i0[k] = bf_lo(v); i1[k] = bf_hi(v); }
        float w0[4], w1[4];
#pragma unroll
        for (int j = 0; j < 4; ++j) { const float2 w = *(const float2*)(cw + j * 4096 + col); w0[j] = w.x; w1[j] = w.y; }
        const float2 bb = *(const float2*)(cbias + col);
        float o0[8], o1[8];
#pragma unroll
        for (int k = 0; k < 8; ++k) { float a0 = bb.x, a1 = bb.y;
#pragma unroll
            for (int j = 0; j < 4; ++j) { a0 += w0[j] * i0[k + j]; a1 += w1[j] * i1[k + j]; }
            o0[k] = silu_f(a0); o1[k] = silu_f(a1); }
        if (slab < 6) {
            const int ch_ = (slab < 4) ? col : col - 2048;
            bf16_t* dst = ((slab < 4) ? WSP(bf16_t, WS_XTG) + (size_t)c * 2048 * 64 : WSP(bf16_t, WS_BTG) + (size_t)c * 1024 * 64) + ((((size_t)(ch_ >> 5)) * 4 + (lb >> 1)) * 64 + (lb & 1) * 32 + (ch_ & 31)) * 8;
            u32x4 w; w.x = pk_bf16(o0[0], o0[1]); w.y = pk_bf16(o0[2], o0[3]); w.z = pk_bf16(o0[4], o0[5]); w.w = pk_bf16(o0[6], o0[7]); *(u32x4*)dst = w;
            w.x = pk_bf16(o1[0], o1[1]); w.y = pk_bf16(o1[2], o1[3]); w.z = pk_bf16(o1[4], o1[5]); w.w = pk_bf16(o1[6], o1[7]); *(u32x4*)(dst + 8) = w;
        }
        if (slab >= 4) {
#pragma unroll
            for (int k = 0; k < 8; ++k) if (l0 + k < ci.Lc) *(unsigned*)(XBC + (size_t)(ci.base + l0 + k) * 4096 + col) = pk_bf16(o0[k], o1[k]);
        }
    }
    __syncthreads();
}

__device__ __forceinline__ void ssd_s1_wave(Ctx& C, int L, int c, int h) {
    const ChunkInfo ci = chunk_info(C, L, c);
    const int l = C.lane, q32 = C.lane & 31, hi = C.lane >> 5, g = h >> 2;
    const float raw = WSP(const float, WS_DT)[(size_t)(ci.base + l) * 32 + h] + C.in[15][L * 32 + h];
    float dt = raw > 20.f ? raw : log1pf(expf(raw)); if (l >= ci.Lc) dt = 0.f;
    const float A = -expf(C.in[16][L * 32 + h]); float a = dt * A;
#pragma unroll
    for (int o = 1; o < 64; o <<= 1) { const float t = __shfl_up(a, o); if (l >= o) a += t; }
    WSP(float, WS_DTA)[((size_t)c * 32 + h) * 64 + l] = dt; WSP(float, WS_ACSG)[((size_t)c * 32 + h) * 64 + l] = a;
    const float aend = __shfl(a, 63);
    const float w = dt * fexp(aend - a);
    if (l == 63) WSP(float, WS_CDEC)[c * 32 + h] = expf(a);
    const bf16_t* xt = WSP(const bf16_t, WS_XTG) + (size_t)c * 2048 * 64 + ((size_t)(2 * h) * 4 * 64 + C.lane) * 8;
    const bf16_t* bt = WSP(const bf16_t, WS_BTG) + (size_t)c * 1024 * 64 + ((size_t)(4 * g) * 4 * 64 + C.lane) * 8;
    f32x16 acc[2][4];
#pragma unroll
    for (int ph = 0; ph < 2; ++ph)
#pragma unroll
        for (int nt = 0; nt < 4; ++nt) acc[ph][nt] = (f32x16){};
#pragma unroll
    for (int ks = 0; ks < 4; ++ks) {
        float wv[8];
#pragma unroll
        for (int j = 0; j < 8; ++j) wv[j] = __shfl(w, 16 * ks + 8 * hi + j);
        bf16x8 bfr[2];
#pragma unroll
        for (int ph = 0; ph < 2; ++ph) { const u32x4 r = *(const u32x4*)(xt + (ph * 4 + ks) * 512);
            u32x4 o; o.x = pk_bf16(bf_lo(r.x) * wv[0], bf_hi(r.x) * wv[1]); o.y = pk_bf16(bf_lo(r.y) * wv[2], bf_hi(r.y) * wv[3]);
            o.z = pk_bf16(bf_lo(r.z) * wv[4], bf_hi(r.z) * wv[5]); o.w = pk_bf16(bf_lo(r.w) * wv[6], bf_hi(r.w) * wv[7]); bfr[ph] = __builtin_bit_cast(bf16x8, o); }
#pragma unroll
        for (int nt = 0; nt < 4; ++nt) { const bf16x8 afr = *(const bf16x8*)(bt + (nt * 4 + ks) * 512);
            acc[0][nt] = MFMA32(afr, bfr[0], acc[0][nt]); acc[1][nt] = MFMA32(afr, bfr[1], acc[1][nt]); }
    }
#pragma unroll
    for (int ph = 0; ph < 2; ++ph) { bf16_t* dst = WSP(bf16_t, WS_CS) + ((size_t)c * 32 + h) * 8192;
#pragma unroll
        for (int nt = 0; nt < 4; ++nt)
#pragma unroll
            for (int rq = 0; rq < 4; ++rq) { u32x2 o; o.x = pk_bf16(acc[ph][nt][4 * rq], acc[ph][nt][4 * rq + 1]); o.y = pk_bf16(acc[ph][nt][4 * rq + 2], acc[ph][nt][4 * rq + 3]);
                *(u32x2*)(dst + ((ph * 8 + 2 * nt + (rq >> 1)) * 64 + (rq & 1) * 32 + q32) * 8 + 4 * hi) = o; } }
}

__device__ __forceinline__ void ssd_s1_unit(Ctx& C, int L, int c, int g) {
    const ChunkInfo ci = chunk_info(C, L, c);
    const bf16_t* XBC = WSP(const bf16_t, WS_XBC); const float* cw = C.in[13] + (size_t)L * 4 * CONVD; const float* cbias = C.in[14] + (size_t)L * CONVD;
    ssd_dt_acs(C, L, ci, c, g, true);
    __syncthreads();
    {
        const int cp = C.tid & 63, lb = C.tid >> 6; float o0[8], o1[8];
        conv_t8(XBC, ci, cw, cbias, 2048 + g * 128 + 2 * cp, 8 * lb, o0, o1);
        st8_bf16(C.lds + SD_BT + (2 * cp) * 144 + lb * 16, o0); st8_bf16(C.lds + SD_BT + (2 * cp + 1) * 144 + lb * 16, o1);
    }
#pragma unroll 1
    for (int i = 0; i < 2; ++i) {
        const int task = C.tid + 512 * i, cp = task & 127, lb = task >> 7, hh = cp >> 5; float o0[8], o1[8];
        conv_t8(XBC, ci, cw, cbias, g * 256 + 2 * cp, 8 * lb, o0, o1);
        const LAS float* dts = (const LAS float*)(C.lds + SD_DT) + hh * 64 + 8 * lb; const LAS float* acs = (const LAS float*)(C.lds + SD_ACS) + hh * 64;
        const float aend = acs[63];
#pragma unroll
        for (int k = 0; k < 8; ++k) { const float w = dts[k] * fexp(aend - acs[8 * lb + k]); o0[k] *= w; o1[k] *= w; }
        st8_bf16(C.lds + SD_XT + (2 * cp) * 144 + lb * 16, o0); st8_bf16(C.lds + SD_XT + (2 * cp + 1) * 144 + lb * 16, o1);
    }
    __syncthreads();
    {   const int hh = C.wid >> 1, ph = C.wid & 1, q32 = C.lane & 31, hi = C.lane >> 5, h = 4 * g + hh;
        f32x16 acc[4];
#pragma unroll
        for (int nt = 0; nt < 4; ++nt) acc[nt] = (f32x16){};
#pragma unroll
        for (int ks = 0; ks < 4; ++ks) { const bf16x8 bfr = *(const LAS bf16x8*)(C.lds + SD_XT + (hh * 64 + ph * 32 + q32) * 144 + ks * 32 + hi * 16);
#pragma unroll
            for (int nt = 0; nt < 4; ++nt) { const bf16x8 afr = *(const LAS bf16x8*)(C.lds + SD_BT + (nt * 32 + q32) * 144 + ks * 32 + hi * 16); acc[nt] = MFMA32(afr, bfr, acc[nt]); } }
        bf16_t* dst = WSP(bf16_t, WS_CS) + (((size_t)c * 32 + h) * 64 + ph * 32 + q32) * 128;
#pragma unroll
        for (int nt = 0; nt < 4; ++nt)
#pragma unroll
            for (int rq = 0; rq < 4; ++rq) { u32x2 w; w.x = pk_bf16(acc[nt][4 * rq], acc[nt][4 * rq + 1]); w.y = pk_bf16(acc[nt][4 * rq + 2], acc[nt][4 * rq + 3]);
                *(u32x2*)(dst + 32 * nt + 8 * rq + 4 * hi) = w; }
    }
    __syncthreads();
}

__device__ __forceinline__ void ssd_scan(Ctx& C, int L) {
    bf16_t* CS = WSP(bf16_t, WS_CS); const float* CDEC = WSP(const float, WS_CDEC);
    for (int gid = C.bid * 512 + C.tid; gid < (int)(HPN / 2); gid += C.G * 512) {
        const int h = gid >> 12; float s0 = 0.f, s1 = 0.f; unsigned* p = (unsigned*)CS + gid;
#pragma unroll 1
        for (int c0 = 0; c0 < 256; c0 += 16) { unsigned v[16]; float d[16];
#pragma unroll
            for (int j = 0; j < 16; ++j) { v[j] = p[(size_t)(c0 + j) * (HPN / 2)]; d[j] = CDEC[(c0 + j) * 32 + h]; }
#pragma unroll
            for (int j = 0; j < 16; ++j) { p[(size_t)(c0 + j) * (HPN / 2)] = pk_bf16(s0, s1); s0 = d[j] * s0 + bf_lo(v[j]); s1 = d[j] * s1 + bf_hi(v[j]); } }
        const int e_ = 2 * (gid & 4095), lane_ = (e_ >> 3) & 63;
        const size_t nat = (size_t)h * 8192 + (size_t)(32 * (e_ >> 12) + (lane_ & 31)) * 128 + 16 * ((e_ >> 9) & 7) + 8 * (lane_ >> 5) + (e_ & 7);
        float* o = C.out + O_SP + (size_t)L * HPN + nat; o[0] = s0; o[1] = s1;
#pragma unroll
        for (int b = 0; b < 8; ++b) { const float* ip = C.in[5] + ((size_t)L * 8 + b) * HPN + nat; const float i0 = ip[0], i1 = ip[1];
            unsigned* q = p + (size_t)(256 + b) * (HPN / 2); const unsigned v = *q; const float d = CDEC[(256 + b) * 32 + h];
            *q = pk_bf16(i0, i1);
            float* os = C.out + O_SS + ((size_t)L * 8 + b) * HPN + nat; os[0] = d * i0 + bf_lo(v); os[1] = d * i1 + bf_hi(v); }
    }
}

__device__ __forceinline__ void ssd_s3_unit(Ctx& C, int L, int c, int g) {
    const ChunkInfo ci = chunk_info(C, L, c);
    const bf16_t* XBC = WSP(const bf16_t, WS_XBC); const float* cw = C.in[13] + (size_t)L * 4 * CONVD; const float* cbias = C.in[14] + (size_t)L * CONVD;
    const int hh = C.wid >> 1, ph = C.wid & 1, q32 = C.lane & 31, hi = C.lane >> 5, h = 4 * g + hh;
    const int chb = h * 64 + ph * 32 + 4 * hi;
    bf16x8 pf[8], xf[3][2]; u32x2 zf[2][4];
    {   const bf16_t* prev = WSP(const bf16_t, WS_CS) + ((size_t)c * 32 + h) * 8192 + ((size_t)(ph * 8) * 64 + C.lane) * 8;
#pragma unroll
        for (int ks = 0; ks < 8; ++ks) pf[ks] = *(const bf16x8*)(prev + ks * 512);
#pragma unroll
        for (int tile = 0; tile < 3; ++tile)
#pragma unroll
            for (int sp = 0; sp < 2; ++sp) xf[tile][sp] = *(const bf16x8*)(WSP(const bf16_t, WS_XTG) + (size_t)c * 2048 * 64 + ((size_t)((2 * h + ph) * 4 + 2 * (tile >> 1) + sp) * 64 + C.lane) * 8);
#pragma unroll
        for (int lh = 0; lh < 2; ++lh)
#pragma unroll
            for (int rq = 0; rq < 4; ++rq) zf[lh][rq] = *(const u32x2*)(WSP(const bf16_t, WS_Z) + (size_t)(ci.base + lh * 32 + q32) * 2048 + chb + 8 * rq);
    }
    if (C.tid < 256) { const size_t o = ((size_t)c * 32 + 4 * g + (C.tid >> 6)) * 64 + (C.tid & 63); const float dtv = WSP(const float, WS_DTA)[o], av = WSP(const float, WS_ACSG)[o];
        ((LAS float*)(C.lds + SD_DT))[C.tid] = dtv; ((LAS float*)(C.lds + SD_ACS))[C.tid] = av; }
#pragma unroll
    for (int i = 0; i < 2; ++i) {
        const int task = C.tid + 512 * i, c8 = task & 15, l = task >> 4;
        const u32x4 vc = *(const u32x4*)(XBC + (size_t)(ci.base + l) * 4096 + 3072 + g * 128 + c8 * 8), vb = *(const u32x4*)(XBC + (size_t)(ci.base + l) * 4096 + 2048 + g * 128 + c8 * 8);
        *(LAS u32x4*)(C.lds + SD_CM + l * 272 + c8 * 16) = vc; *(LAS u32x4*)(C.lds + SD_BM + ((l & 32) | sig5(l & 31)) * 272 + c8 * 16) = vb;
    }
    __syncthreads();
    const LAS float* dts = (const LAS float*)(C.lds + SD_DT) + hh * 64; const LAS float* acs = (const LAS float*)(C.lds + SD_ACS) + hh * 64;
    f32x16 acc[2]; acc[0] = (f32x16){}; acc[1] = (f32x16){};
    {
#pragma unroll
        for (int ks = 0; ks < 8; ++ks) { const bf16x8 afr = pf[ks];
#pragma unroll
            for (int lh = 0; lh < 2; ++lh) { const bf16x8 bfr = *(const LAS bf16x8*)(C.lds + SD_CM + (lh * 32 + q32) * 272 + ks * 32 + hi * 16); acc[lh] = MFMA32(afr, bfr, acc[lh]); } }
#pragma unroll
        for (int lh = 0; lh < 2; ++lh) { const float e = fexp(acs[lh * 32 + q32]);
#pragma unroll
            for (int r = 0; r < 16; ++r) acc[lh][r] *= e; }
    }
    const float Dh = C.in[17][L * 32 + h];
#pragma unroll
    for (int tile = 0; tile < 3; ++tile) {
        const int sh = tile >> 1, lh = (tile + 1) >> 1;
        f32x16 T = (f32x16){};
#pragma unroll
        for (int ks = 0; ks < 8; ++ks) { const bf16x8 afr = *(const LAS bf16x8*)(C.lds + SD_BM + (sh * 32 + q32) * 272 + ks * 32 + hi * 16);
            const bf16x8 bfr = *(const LAS bf16x8*)(C.lds + SD_CM + (lh * 32 + q32) * 272 + ks * 32 + hi * 16); T = MFMA32(afr, bfr, T); }
        const int l = lh * 32 + q32; const float al = acs[l];
        unsigned pk[8];
#pragma unroll
        for (int r2 = 0; r2 < 8; ++r2) { float mv[2];
#pragma unroll
            for (int q = 0; q < 2; ++q) { const int r = 2 * r2 + q; const int s = sh * 32 + 16 * (r >> 3) + 8 * hi + (r & 7);
                float w = 0.f; if (s <= l) w = fexp(al - acs[s]) * dts[s];
                mv[q] = T[r] * w + ((s == l) ? Dh : 0.f); }
            pk[r2] = pk_bf16(mv[0], mv[1]); }
#pragma unroll
        for (int sp = 0; sp < 2; ++sp) { const bf16x8 afr = xf[tile][sp];
            const u32x4 bw = {pk[4 * sp], pk[4 * sp + 1], pk[4 * sp + 2], pk[4 * sp + 3]};
            acc[lh] = MFMA32(afr, __builtin_bit_cast(bf16x8, bw), acc[lh]); }
    }
#pragma unroll
    for (int lh = 0; lh < 2; ++lh) { const int l = lh * 32 + q32; float ss = 0.f;
#pragma unroll
        for (int rq = 0; rq < 4; ++rq) { const u32x2 z = zf[lh][rq];
            acc[lh][4 * rq + 0] *= silu_f(bf_lo(z.x)); acc[lh][4 * rq + 1] *= silu_f(bf_hi(z.x)); acc[lh][4 * rq + 2] *= silu_f(bf_lo(z.y)); acc[lh][4 * rq + 3] *= silu_f(bf_hi(z.y));
#pragma unroll
            for (int q = 0; q < 4; ++q) ss += acc[lh][4 * rq + q] * acc[lh][4 * rq + q]; }
        ss += __shfl_xor(ss, 32);
        if (hi == 0) ((LAS float*)(C.lds + SD_RS))[C.wid * 64 + l] = ss; }
    __syncthreads();
    const float* nw = C.in[18] + (size_t)L * DIN; bf16_t* Y = WSP(bf16_t, WS_YSSD);
#pragma unroll
    for (int lh = 0; lh < 2; ++lh) { const int l = lh * 32 + q32; float tot = 0.f;
#pragma unroll
        for (int w = 0; w < 8; ++w) tot += ((const LAS float*)(C.lds + SD_RS))[w * 64 + l];
        const float rs = 1.0f / sqrtf(tot * (1.0f / 256.0f) + 1e-5f);
        if (l < ci.Lc) {
#pragma unroll
            for (int rq = 0; rq < 4; ++rq) { const f32x4 wv = *(const f32x4*)(nw + chb + 8 * rq);
                u32x2 o; o.x = pk_bf16(acc[lh][4 * rq] * rs * wv.x, acc[lh][4 * rq + 1] * rs * wv.y); o.y = pk_bf16(acc[lh][4 * rq + 2] * rs * wv.z, acc[lh][4 * rq + 3] * rs * wv.w);
                *(u32x2*)(Y + (size_t)(ci.base + l) * 2048 + chb + 8 * rq) = o; } } }
    __syncthreads();
}

struct AttnUnit { int qrow0, h, NT, ncache, krow0, kvalid, b, nt_base, sample; };
constexpr int AT_ST = 32768;
__device__ __forceinline__ void attn_unit(Ctx& C, int L, const AttnUnit u, const int rep) {
    const int mp = C.wid >> 2, wq = C.wid & 3, q32 = C.lane & 31, hi = C.lane >> 5;
    const bf16_t* Qb = WSP(const bf16_t, WS_Q); const bf16_t* Kb = WSP(const bf16_t, WS_K); const bf16_t* VT = WSP(const bf16_t, WS_VT);
    const bf16_t* KC = WSP(const bf16_t, WS_KC); const bf16_t* VTC = WSP(const bf16_t, WS_VTC);
    float lam; const float lam_init = (L == 0) ? 0.2f : 0.35550906f;
    { const float s1 = wave_sum(C.in[8][L * 64 + C.lane] * C.in[9][L * 64 + C.lane]), s2 = wave_sum(C.in[10][L * 64 + C.lane] * C.in[11][L * 64 + C.lane]);
      lam = expf(s1) - expf(s2) + lam_init; }
    const bool active = u.sample ? (wq == 0) : true;
    const int ntw = u.sample ? u.NT : (u.nt_base + (wq >> 1));
    bf16x8 qf[4];
    { const bf16_t* qp = Qb + (size_t)(u.qrow0 + 32 * wq + q32) * 1024 + u.h * 128 + mp * 64 + hi * 8;
#pragma unroll
      for (int ds = 0; ds < 4; ++ds) qf[ds] = *(const bf16x8*)(qp + ds * 16); }
    asm volatile("" : "+v"(qf[0]), "+v"(qf[1]), "+v"(qf[2]), "+v"(qf[3]));
    f32x16 O[4];
#pragma unroll
    for (int eb = 0; eb < 4; ++eb) O[eb] = (f32x16){};
    float m_run = 0.f, l_run = 0.f; f32x16 negm = (f32x16){};
    int koff[2], ve[2], vc[2];
#pragma unroll
    for (int i = 0; i < 2; ++i) { const int j = C.wid + 8 * i;
        const int r = 4 * j + (C.lane >> 4), c = (C.lane & 15) ^ (r & 15); koff[i] = ((r & 32) | sig5(r & 31)) * 1024 + c * 8;
        const int e = 8 * j + (C.lane >> 3), cv = (C.lane & 7) ^ ((e >> 1) & 7); ve[i] = e; vc[i] = cv * 8; }
    int kso[4], vso[4];
#pragma unroll
    for (int ds = 0; ds < 4; ++ds) { kso[ds] = ((mp * 8 + ds * 2 + hi) ^ (q32 & 15)) * 16; vso[ds] = ((ds * 2 + hi) ^ ((q32 >> 1) & 7)) * 16; }
#define AT_ISSUE(t, st) do { const int t_ = (t); \
        const bf16_t* kp_ = (t_ < u.ncache) ? KC + ((size_t)u.b * PAST + 64 * t_) * 1024 + u.h * 128 : Kb + ((size_t)u.krow0 + 64 * (t_ - u.ncache)) * 1024 + u.h * 128; \
        const bf16_t* vp_; int vs_; \
        if (t_ < u.ncache) { vp_ = VTC + ((size_t)u.b * 1024 + u.h * 128) * PAST + 64 * t_; vs_ = PAST; } else { vp_ = VT + (size_t)(u.h * 128) * MT + u.krow0 + 64 * (t_ - u.ncache); vs_ = MT; } \
        _Pragma("unroll") for (int i_ = 0; i_ < 2; ++i_) { \
            __builtin_amdgcn_global_load_lds((const unsigned*)(kp_ + koff[i_]), (LAS unsigned*)(C.lds + (st) * AT_ST + (C.wid + 8 * i_) * 1024), 16, 0, 0); \
            __builtin_amdgcn_global_load_lds((const unsigned*)(vp_ + (size_t)ve[i_] * vs_ + vc[i_]), (LAS unsigned*)(C.lds + (st) * AT_ST + 16384 + (C.wid + 8 * i_) * 1024), 16, 0, 0); } } while (0)
    AT_ISSUE(0, 0); AT_ISSUE(1, 1);
    int st_cur = 0, st_nxt2 = 2;
#pragma unroll 1
    for (int t = 0; t < u.NT; ++t) {
        if (t + 1 < u.NT) asm volatile("s_waitcnt vmcnt(4)\n\ts_barrier" ::: "memory");
        else asm volatile("s_waitcnt vmcnt(0)\n\ts_barrier" ::: "memory");
        if (t + 2 < u.NT) AT_ISSUE(t + 2, st_nxt2);
        if (active && t < ntw) {
            const LAS unsigned char* kb = C.lds + st_cur * AT_ST + q32 * 256;
            const LAS unsigned char* vb = C.lds + st_cur * AT_ST + 16384 + q32 * 128;
            bf16x8 ka[8];
#pragma unroll
            for (int ds = 0; ds < 4; ++ds) { ka[ds] = *(const LAS bf16x8*)(kb + kso[ds]); ka[4 + ds] = *(const LAS bf16x8*)(kb + 8192 + kso[ds]); }
            f32x16 S0 = MFMA32(ka[0], qf[0], negm);
#pragma unroll
            for (int ds = 1; ds < 4; ++ds) S0 = MFMA32(ka[ds], qf[ds], S0);
            f32x16 S1 = MFMA32(ka[4], qf[0], negm);
#pragma unroll
            for (int ds = 1; ds < 4; ++ds) S1 = MFMA32(ka[4 + ds], qf[ds], S1);
            bf16x8 va[4];
#pragma unroll
            for (int eb = 0; eb < 4; ++eb) va[eb] = *(const LAS bf16x8*)(vb + eb * 4096 + vso[0]);
            float mx = max3f(S0[0], S0[1], S0[2]);
#pragma unroll
            for (int r = 3; r < 15; r += 2) mx = max3f(mx, S0[r], S0[r + 1]);
            mx = max3f(mx, S0[15], S0[15]);
#pragma unroll
            for (int r = 0; r < 16; ++r) S0[r] = fexp2(S0[r]);
            float mx1 = max3f(S1[0], S1[1], S1[2]);
#pragma unroll
            for (int r = 3; r < 15; r += 2) mx1 = max3f(mx1, S1[r], S1[r + 1]);
            mx = max3f(mx, mx1, S1[15]);
            mx = max3f(mx, __shfl_xor(mx, 32), mx);
            if (t == 0 || __any(mx > 8.0f)) {
                const float dl = (t == 0) ? mx : fmaxf(mx, 0.f);
                m_run += dl;
                const float f = fexp2(-dl); l_run *= f;
#pragma unroll
                for (int r = 0; r < 16; ++r) { S0[r] *= f; S1[r] -= dl; negm[r] = -m_run; }
#pragma unroll
                for (int eb = 0; eb < 4; ++eb)
#pragma unroll
                    for (int r = 0; r < 16; ++r) O[eb][r] *= f;
            }
            if (t == u.NT - 1 && u.kvalid < 64) {
#pragma unroll
                for (int r = 0; r < 16; ++r) { const int kv = 16 * (r >> 3) + 8 * hi + (r & 7); if (kv >= u.kvalid) S0[r] = 0.f; if (kv + 32 >= u.kvalid) S1[r] = -INFINITY; } }
            u32x4 pk[4];
#pragma unroll
            for (int sp = 0; sp < 2; ++sp)
                pk[sp] = (u32x4){pk_bf16(S0[8 * sp], S0[8 * sp + 1]), pk_bf16(S0[8 * sp + 2], S0[8 * sp + 3]), pk_bf16(S0[8 * sp + 4], S0[8 * sp + 5]), pk_bf16(S0[8 * sp + 6], S0[8 * sp + 7])};
#pragma unroll
            for (int eb = 0; eb < 4; ++eb) O[eb] = MFMA32(va[eb], __builtin_bit_cast(bf16x8, pk[0]), O[eb]);
#pragma unroll
            for (int eb = 0; eb < 4; ++eb) va[eb] = *(const LAS bf16x8*)(vb + eb * 4096 + vso[1]);
#pragma unroll
            for (int r = 0; r < 16; ++r) S1[r] = fexp2(S1[r]);
#pragma unroll
            for (int eb = 0; eb < 4; ++eb) O[eb] = MFMA32(va[eb], __builtin_bit_cast(bf16x8, pk[1]), O[eb]);
#pragma unroll
            for (int eb = 0; eb < 4; ++eb) va[eb] = *(const LAS bf16x8*)(vb + eb * 4096 + vso[2]);
#pragma unroll
            for (int sp = 0; sp < 2; ++sp)
                pk[2 + sp] = (u32x4){pk_bf16(S1[8 * sp], S1[8 * sp + 1]), pk_bf16(S1[8 * sp + 2], S1[8 * sp + 3]), pk_bf16(S1[8 * sp + 4], S1[8 * sp + 5]), pk_bf16(S1[8 * sp + 6], S1[8 * sp + 7])};
#pragma unroll
            for (int eb = 0; eb < 4; ++eb) O[eb] = MFMA32(va[eb], __builtin_bit_cast(bf16x8, pk[2]), O[eb]);
#pragma unroll
            for (int eb = 0; eb < 4; ++eb) va[eb] = *(const LAS bf16x8*)(vb + eb * 4096 + vso[3]);
            float sum = 0.f, sum2 = 0.f;
#pragma unroll
            for (int r = 0; r < 16; ++r) { sum += S0[r]; sum2 += S1[r]; }
            l_run += sum + sum2;
#pragma unroll
            for (int eb = 0; eb < 4; ++eb) O[eb] = MFMA32(va[eb], __builtin_bit_cast(bf16x8, pk[3]), O[eb]);
#if MK_SGB
#pragma unroll
            for (int i_ = 0; i_ < 16; ++i_) { __builtin_amdgcn_sched_group_barrier(0x008, 1, 0); __builtin_amdgcn_sched_group_barrier(0x100, 1, 0); __builtin_amdgcn_sched_group_barrier(0x002, 5, 0); }
#endif
        }
        st_cur = (st_cur == 2) ? 0 : st_cur + 1; st_nxt2 = (st_nxt2 == 2) ? 0 : st_nxt2 + 1;
    }
#undef AT_ISSUE
    asm volatile("s_waitcnt lgkmcnt(0)\n\ts_barrier" ::: "memory");
    const float ltot = l_run + __shfl_xor(l_run, 32); const float inv = 1.0f / ltot;
    LAS float* EX = (LAS float*)C.lds + wq * 4096;
    if (mp == 1 && active) {
#pragma unroll
        for (int eb = 0; eb < 4; ++eb)
#pragma unroll
            for (int r = 0; r < 16; ++r) EX[(32 * eb + 8 * (r >> 2) + 4 * hi + (r & 3)) * 32 + q32] = O[eb][r] * inv;
    }
    __syncthreads();
    if (mp == 0 && active) {
        float ss = 0.f;
#pragma unroll
        for (int eb = 0; eb < 4; ++eb)
#pragma unroll
            for (int r = 0; r < 16; ++r) { const float d = O[eb][r] * inv - lam * EX[(32 * eb + 8 * (r >> 2) + 4 * hi + (r & 3)) * 32 + q32]; O[eb][r] = d; ss += d * d; }
        ss += __shfl_xor(ss, 32);
        const float rs = (1.0f / sqrtf(ss * (1.0f / 128.0f) + 1e-5f)) * (1.0f - lam_init);
        const float* sw = C.in[12] + L * 128;
        if (!u.sample || q32 < 16) {
            bf16_t* dst = WSP(bf16_t, WS_ATT) + (size_t)(u.qrow0 + 32 * wq + q32) * 1024 + u.h * 128 + 4 * hi;
#pragma unroll
            for (int eb = 0; eb < 4; ++eb)
#pragma unroll
                for (int rq = 0; rq < 4; ++rq) { const f32x4 wv = *(const f32x4*)(sw + 32 * eb + 8 * rq + 4 * hi);
                    u32x2 o; o.x = pk_bf16(O[eb][4 * rq] * rs * wv.x, O[eb][4 * rq + 1] * rs * wv.y); o.y = pk_bf16(O[eb][4 * rq + 2] * rs * wv.z, O[eb][4 * rq + 3] * rs * wv.w);
                    *(u32x2*)(dst + 32 * eb + 8 * rq) = o; }
        }
    }
    __syncthreads();
}

struct OneUnit { int pm, pn;
    __device__ __forceinline__ bool next(int i, pg8::Unit& u) const { if (i) return false; u.pm = pm; u.pn = pn; return true; }
    __device__ __forceinline__ void a_ready(const pg8::Unit&) const {}
    __device__ __forceinline__ void done(const pg8::Unit&) const {} };
__device__ __forceinline__ void flag_publish(unsigned* cnt, int tid) {
    asm volatile("s_waitcnt vmcnt(0)" ::: "memory"); __syncthreads();
    if (tid == 0) { __builtin_amdgcn_fence(__ATOMIC_RELEASE, "agent"); asm volatile("s_waitcnt vmcnt(0)" ::: "memory"); __hip_atomic_fetch_add(cnt, 1u, __ATOMIC_RELAXED, __HIP_MEMORY_SCOPE_AGENT); }
}
__device__ __forceinline__ void flag_wait(unsigned* cnt, unsigned target, int tid) {
    if (tid == 0) { unsigned sp = 0; while (__hip_atomic_load(cnt, __ATOMIC_RELAXED, __HIP_MEMORY_SCOPE_AGENT) < target) { __builtin_amdgcn_s_sleep(16); if (++sp > (1u << 24)) break; } }
    __syncthreads();
    __builtin_amdgcn_fence(__ATOMIC_ACQUIRE, "agent"); asm volatile("s_waitcnt vmcnt(0)" ::: "memory");
    __syncthreads();
}
__device__ __forceinline__ void chain_item(Ctx& C, int L, int kind, int idx) {
    unsigned* cnt = WSP(unsigned, WS_CTL) + 64 * (20 + 4 * L);
    if (kind == 0) {
        flag_wait(cnt, 128u, C.tid);
        OneUnit S{0, idx};
        { pg8::Gemm g{WSP(const bf16_t, WS_ATT) + (size_t)SEQ * 1024, WSP(const bf16_t, WS_WBA + L * SZ_WBA), 256, 1024, 1024}; EpiBrA E{WSP(const bf16_t, WS_G), WSP(float, WS_Z), SEQ};
          pg8::gemm_phase<EpiBrA, OneUnit, true, true>(C.lds, g, S, E); }
        { pg8::Gemm g{WSP(const bf16_t, WS_YSSD) + (size_t)SEQ * 2048, WSP(const bf16_t, WS_WBS + L * SZ_WBS), 256, 1024, 2048}; EpiBrB E{WSP(const bf16_t, WS_G), WSP(const float, WS_Z), WSP(bf16_t, WS_Q), SEQ};
          pg8::gemm_phase<EpiBrB, OneUnit, true, true>(C.lds, g, S, E); }
        flag_publish(cnt + 64, C.tid);
    } else if (kind == 1) {
        flag_wait(cnt + 64, 4u, C.tid);
        OneUnit S{0, idx};
        pg8::Gemm g{WSP(const bf16_t, WS_Q) + (size_t)SEQ * 1024, WSP(const bf16_t, WS_WOUT + L * SZ_WOUT), 256, 1024, 1024};
        EpiRes E{WSP(float, WS_X), WSP(bf16_t, WS_XB), WSP(float, WS_PART) + (size_t)(2 * L + 1) * MT, SEQ};
        pg8::gemm_phase<EpiRes, OneUnit, true, true>(C.lds, g, S, E);
        flag_publish(cnt + 128, C.tid);
    } else if (kind == 2) {
        flag_wait(cnt + 128, 4u, C.tid);
        OneUnit S{0, idx};
        pg8::Gemm g{WSP(const bf16_t, WS_XB) + (size_t)SEQ * 1024, WSP(const bf16_t, WS_WGU + L * SZ_WGU), 256, 5632, 1024};
        EpiGU E{WSP(const float, WS_PART) + (size_t)(2 * L + 1) * MT, WSP(bf16_t, WS_ACTS), SEQ, SEQ};
        pg8::gemm_phase<EpiGU, OneUnit, true, true>(C.lds, g, S, E);
        flag_publish(cnt + 192, C.tid);
    } else {
        flag_wait(cnt + 192, 22u, C.tid);
        OneUnit S{0, idx};
        pg8::Gemm g{WSP(const bf16_t, WS_ACTS), WSP(const bf16_t, WS_WD + L * SZ_WD), 256, 1024, DFF};
        EpiRes E{WSP(float, WS_X), WSP(bf16_t, WS_XB), WSP(float, WS_PART) + (size_t)(2 * L + 2) * MT, SEQ};
        pg8::gemm_phase<EpiRes, OneUnit, true, true>(C.lds, g, S, E);
    }
    __syncthreads();
}

__device__ __forceinline__ void phase_mix(Ctx& C, int L, int rep) {
    unsigned* counter = WSP(unsigned, WS_CTL) + 64 * (1 + L + 4 * rep);
    unsigned* cntA = WSP(unsigned, WS_CTL) + 64 * (20 + 4 * L);
    volatile LAS int* slot = (volatile LAS int*)(C.lds + LDS_CTL);
    constexpr int N_SMP = 64, N_S3S = 64, N_MID = 1024 + 34, N_S3 = 2048, N_ALL = N_SMP + N_S3S + N_MID + N_S3;
    for (;;) {
        __syncthreads();
        if (C.tid == 0) slot[0] = (int)atomicAdd(counter, 1u);
        __syncthreads();
        const int item = slot[0];
        if (item >= N_ALL) break;
        { int t_ = threadIdx.x; asm volatile("" : "+v"(t_)); C.tid = t_; C.lane = t_ & 63; C.wid = __builtin_amdgcn_readfirstlane(t_ >> 6); }
        if (item < N_SMP) { AttnUnit u; u.sample = 1; u.b = item >> 3; u.h = item & 7; u.qrow0 = SEQ + 16 * u.b; u.NT = 65; u.ncache = 64; u.krow0 = SEQ + 16 * u.b; u.kvalid = 16; u.nt_base = 65;
            attn_unit(C, L, u, rep); flag_publish(cntA, C.tid); }
        else if (item < N_SMP + N_S3S) { const int j = 2048 + (item - N_SMP); ssd_s3_unit(C, L, j >> 3, j & 7); flag_publish(cntA, C.tid); }
        else if (item < N_SMP + N_S3S + N_MID) { const int mi = item - N_SMP - N_S3S; int j = -1, kind = -1, idx = 0;
            if (mi < 400) j = mi; else if (mi < 404) { kind = 0; idx = mi - 400; } else if (mi < 560) j = mi - 4; else if (mi < 564) { kind = 1; idx = mi - 560; }
            else if (mi < 720) j = mi - 8; else if (mi < 742) { kind = 2; idx = mi - 720; } else if (mi < 880) j = mi - 30; else if (mi < 884) { kind = 3; idx = mi - 880; } else j = mi - 34;
            if (kind >= 0) chain_item(C, L, kind, idx);
            else {
                __syncthreads();
                if (C.tid == 0) { unsigned* hc = WSP(unsigned, WS_CTL) + 64 * (40 + 8 * L); int hsel = (int)(my_xcc_id() & 7u), rsel = -1;
                    for (int k = 0; k < 8; ++k) { const int hh_ = (hsel + k) & 7; if (__hip_atomic_load(hc + 64 * hh_, __ATOMIC_RELAXED, __HIP_MEMORY_SCOPE_AGENT) < 128u) { const unsigned r_ = atomicAdd(hc + 64 * hh_, 1u); if (r_ < 128u) { hsel = hh_; rsel = (int)r_; break; } } }
                    slot[1] = hsel; slot[2] = rsel; }
                __syncthreads();
                const int hsel = slot[1], rsel = slot[2];
                if (rsel >= 0) { const int qb = 127 - rsel; j = hsel; AttnUnit u; u.sample = 0; u.b = 0; u.h = j & 7; u.qrow0 = 128 * qb; u.NT = 2 * qb + 2; u.ncache = 0; u.krow0 = 0; u.kvalid = 64; u.nt_base = 2 * qb + 1; attn_unit(C, L, u, rep); } } }
        else { const int j = item - N_SMP - N_S3S - N_MID; ssd_s3_unit(C, L, j >> 3, j & 7); }
    }
}

__device__ __forceinline__ void phase_final(Ctx& C) {
    const float* X = WSP(const float, WS_X); const float* PART = WSP(const float, WS_PART); const float* nw = C.in[25];
    const int gw = C.bid * 8 + C.wid, NGW = C.G * 8;
    for (int row = gw; row < MV; row += NGW) { const float rs = rstd1(PART + 4 * MT, row, 1e-6f);
#pragma unroll
        for (int j = 0; j < 4; ++j) { const int col = 4 * C.lane + 256 * j; const f32x4 x = *(const f32x4*)(X + (size_t)row * 1024 + col); const f32x4 w = *(const f32x4*)(nw + col);
            *(f32x4*)(C.out + O_YP + (size_t)row * 1024 + col) = (x * rs) * w; } }
}

#define XB_TMO      128
#define XB_XCNT(j)  (256  + 64 * (j))
#define XB_XSUB(j)  (1280 + 64 * (j))
#define XB_XGEN(j)  (2304 + 64 * (j))
#define XB_TOP      3328
#define XB_TOPGEN   3392
#define XCD_BAR_WORDS 3456
#define XB_SPIN_CAP (1u << 23)

__device__ __forceinline__ unsigned xb_ld(unsigned* p)              { return __hip_atomic_load(p, __ATOMIC_RELAXED, __HIP_MEMORY_SCOPE_AGENT); }
__device__ __forceinline__ unsigned xb_add(unsigned* p, unsigned v) { return __hip_atomic_fetch_add(p, v, __ATOMIC_RELAXED, __HIP_MEMORY_SCOPE_AGENT); }
__device__ __forceinline__ unsigned xb_xcc_id() { return (unsigned)__builtin_amdgcn_s_getreg((3 << 11) | 20) & 0xFu; }
#define XB_SPIN(cond, bar) do { unsigned _sp = 0; while (cond) { __builtin_amdgcn_s_sleep(1); \
    if ((++_sp & 255u) == 0u) { if (xb_ld(&(bar)[XB_TMO])) break; if (_sp > XB_SPIN_CAP) { atomicAdd(&(bar)[XB_TMO], 1u); break; } } } } while (0)

struct XcdBarrier {
    unsigned* bar; unsigned x;
    volatile LAS unsigned* st;
};

__device__ __forceinline__ XcdBarrier xcd_barrier_post(unsigned* bar, volatile LAS unsigned* st) {
    XcdBarrier b; b.bar = bar; b.x = xb_xcc_id(); b.st = st;
    if (threadIdx.x == 0) (void)xb_add(&bar[XB_XCNT(b.x)], 1u);
    return b;
}
__device__ __forceinline__ void xcd_barrier_complete(unsigned* bar, unsigned x, unsigned& nloc, unsigned& nx) {
    const unsigned G = gridDim.x * gridDim.y * gridDim.z;
    unsigned sum, cnt, mine, sp = 0u;
    for (;;) {
        sum = 0u; cnt = 0u; mine = 0u;
#pragma unroll
        for (unsigned j = 0; j < 16; ++j) { const unsigned c = xb_ld(&bar[XB_XCNT(j)]); sum += c; cnt += (c > 0u) ? 1u : 0u; mine = (j == x) ? c : mine; }
        if (sum == G) break;
        __builtin_amdgcn_s_sleep(1);
        if ((++sp & 255u) == 0u) { if (xb_ld(&bar[XB_TMO])) break; if (sp > XB_SPIN_CAP) { atomicAdd(&bar[XB_TMO], 1u); break; } }
    }
    nloc = mine > 0u ? mine : 1u; nx = cnt > 0u ? cnt : 1u;
}

__device__ __forceinline__ void xcd_barrier(const XcdBarrier& b) {
    asm volatile("s_waitcnt vmcnt(0)" ::: "memory");
    __syncthreads();
    if (threadIdx.x == 0) {
        unsigned* bar = b.bar;
        __builtin_amdgcn_s_waitcnt(0);
        unsigned nloc = b.st[0], nx = b.st[1];
        if (nloc == 0u) { xcd_barrier_complete(bar, b.x, nloc, nx); b.st[0] = nloc; b.st[1] = nx; }
        const unsigned old = xb_add(&bar[XB_XSUB(b.x)], 1u);
        const unsigned gen = old / nloc;
        if (old + 1u == (gen + 1u) * nloc) {
            __builtin_amdgcn_fence(__ATOMIC_RELEASE, "agent");
            asm volatile("s_waitcnt vmcnt(0)" ::: "memory");
            const unsigned og = xb_add(&bar[XB_TOP], 1u);
            const unsigned tg = og / nx;
            if (og + 1u == (tg + 1u) * nx) xb_add(&bar[XB_TOPGEN], 1u);
            else XB_SPIN(xb_ld(&bar[XB_TOPGEN]) == tg, bar);
            __builtin_amdgcn_fence(__ATOMIC_ACQUIRE, "agent");
            xb_add(&bar[XB_XGEN(b.x)], 1u);
            asm volatile("s_waitcnt vmcnt(0)" ::: "memory");
        } else {
            XB_SPIN(xb_ld(&bar[XB_XGEN(b.x)]) == gen, bar);
            __builtin_amdgcn_fence(__ATOMIC_ACQUIRE, "agent");
            asm volatile("s_waitcnt vmcnt(0)" ::: "memory");
        }
    }
    __syncthreads();
}

constexpr int N_PHASES = 18;
__global__ void __launch_bounds__(512, 2) mk_fwd(Args a) {
    extern __shared__ __attribute__((aligned(16))) unsigned char lds_raw[];
    Ctx C;
    C.lds = (LAS unsigned char*)lds_raw; C.G = gridDim.x; C.bid = blockIdx.x;
#pragma unroll
    for (int i = 0; i < 26; ++i) C.in[i] = a.in[i];
    C.out = a.out; C.ws = a.ws;
    cg::grid_group grid = cg::this_grid();
    if (threadIdx.x < 64) ((LAS unsigned*)(C.lds + LDS_CTL))[threadIdx.x] = 0u;
    __syncthreads();
    XcdBarrier xbar = xcd_barrier_post(WSP(unsigned, WS_CTL) + 4096, (volatile LAS unsigned*)(C.lds + LDS_CTL + 32));
#pragma unroll 1
    for (int ph = a.ph_lo; ph < a.ph_hi; ++ph) {
        if (ph == a.ph_lo + 1) { grid.sync(); } else if (ph > a.ph_lo) { xcd_barrier(xbar); }
        { int t_ = threadIdx.x; asm volatile("" : "+v"(t_)); C.tid = t_; C.lane = t_ & 63; C.wid = __builtin_amdgcn_readfirstlane(t_ >> 6); }
        if (ph == 0) { if (!(MK_SKIP & 1024)) phase_p0(C); continue; }
        if (ph == N_PHASES - 1) { phase_final(C); continue; }
        const int L = (ph - 1) >> 3, sub = (ph - 1) & 7;
        if (sub == 0) {
            pg8::Gemm g{WSP(const bf16_t, WS_XB), WSP(const bf16_t, WS_WIN + L * SZ_WIN), MT, NINP, 1024}; pg8::StaticOrder S; S.init(MT, NINP, C.G, C.bid);
            EpiIn E{WSP(const float, WS_PART) + (size_t)(2 * L) * MT, WSP(bf16_t, WS_Q), WSP(bf16_t, WS_K), WSP(bf16_t, WS_VT), WSP(bf16_t, WS_Z), WSP(bf16_t, WS_XBC), WSP(bf16_t, WS_G), WSP(float, WS_DT), C.out, L, WSP(bf16_t, WS_HIST)};
            if (!(MK_SKIP & 1)) pg8::gemm_phase<EpiIn, pg8::StaticOrder, true, true>(C.lds, g, S, E);
            if (MK_PROBE & 2) { grid.sync(); pg8::gemm_phase<EpiIn, pg8::StaticOrder, true, true>(C.lds, g, S, E); }
            if (MK_PROBE & 1024) { grid.sync(); EpiNull EN{WSP(float, WS_END - 64)}; pg8::gemm_phase<EpiNull, pg8::StaticOrder, true, true>(C.lds, g, S, EN); }
        } else if (sub == 1) {
            for (int uidx = C.bid; uidx < NCHUNK * 8; uidx += C.G) { { int t_ = threadIdx.x; asm volatile("" : "+v"(t_)); C.tid = t_; C.lane = t_ & 63; C.wid = __builtin_amdgcn_readfirstlane(t_ >> 6); } conv_unit(C, L, uidx >> 3, uidx & 7); }
            if (!(MK_SKIP & 4)) cache_convert(C, L);
            xcd_barrier(xbar);
            for (int uidx = C.bid * 8 + C.wid; uidx < NCHUNK * 32; uidx += C.G * 8) { { int t_ = threadIdx.x; asm volatile("" : "+v"(t_)); C.tid = t_; C.lane = t_ & 63; C.wid = __builtin_amdgcn_readfirstlane(t_ >> 6); } ssd_s1_wave(C, L, uidx >> 5, uidx & 31); }
            if (MK_PROBE & 512) { grid.sync(); for (int uidx = C.bid * 8 + C.wid; uidx < NCHUNK * 32; uidx += C.G * 8) { { int t_ = threadIdx.x; asm volatile("" : "+v"(t_)); C.tid = t_; C.lane = t_ & 63; C.wid = __builtin_amdgcn_readfirstlane(t_ >> 6); } ssd_s1_wave(C, L, uidx >> 5, uidx & 31); } }
        } else if (sub == 2) {
            if (!(MK_SKIP & 8)) ssd_scan(C, L);
        } else if (sub == 3) {
            phase_mix(C, L, 0);
            if (MK_PROBE & 1) { grid.sync(); phase_mix(C, L, 1); }
        } else if (sub == 4) {
            pg8::StaticOrder S; S.init(SEQ, 1024, C.G, C.bid);
            { pg8::Gemm g{WSP(const bf16_t, WS_ATT), WSP(const bf16_t, WS_WBA + L * SZ_WBA), SEQ, 1024, 1024}; EpiBrA E{WSP(const bf16_t, WS_G), WSP(float, WS_Z), 0};
              if (!(MK_SKIP & 64)) pg8::gemm_phase<EpiBrA, pg8::StaticOrder, true, true>(C.lds, g, S, E); }
            { pg8::Gemm g{WSP(const bf16_t, WS_YSSD), WSP(const bf16_t, WS_WBS + L * SZ_WBS), SEQ, 1024, 2048}; EpiBrB E{WSP(const bf16_t, WS_G), WSP(const float, WS_Z), WSP(bf16_t, WS_Q), 0};
              if (!(MK_SKIP & 128)) pg8::gemm_phase<EpiBrB, pg8::StaticOrder, true, true>(C.lds, g, S, E); }
        } else if (sub == 5) {
            pg8::Gemm g{WSP(const bf16_t, WS_Q), WSP(const bf16_t, WS_WOUT + L * SZ_WOUT), SEQ, 1024, 1024}; pg8::StaticOrder S; S.init(SEQ, 1024, C.G, C.bid);
            EpiRes E{WSP(float, WS_X), WSP(bf16_t, WS_XB), WSP(float, WS_PART) + (size_t)(2 * L + 1) * MT, 0};
            if (!(MK_SKIP & 256)) pg8::gemm_phase<EpiRes, pg8::StaticOrder, true, true>(C.lds, g, S, E);
        } else if (sub == 6) {
            pg8::Gemm g{WSP(const bf16_t, WS_XB), WSP(const bf16_t, WS_WGU + L * SZ_WGU), SEQ, 5632, 1024}; pg8::StaticOrder S; S.init(SEQ, 5632, C.G, C.bid);
            EpiGU E{WSP(const float, WS_PART) + (size_t)(2 * L + 1) * MT, WSP(bf16_t, WS_XBC), 0, 0};
            if (!(MK_SKIP & 512)) pg8::gemm_phase<EpiGU, pg8::StaticOrder, true, true>(C.lds, g, S, E);
            if (MK_PROBE & 4) { grid.sync(); pg8::gemm_phase<EpiGU, pg8::StaticOrder, true, true>(C.lds, g, S, E); }
        } else {
            pg8::Gemm g{WSP(const bf16_t, WS_XBC), WSP(const bf16_t, WS_WD + L * SZ_WD), SEQ, 1024, DFF}; pg8::StaticOrder S; S.init(SEQ, 1024, C.G, C.bid);
            EpiRes E{WSP(float, WS_X), WSP(bf16_t, WS_XB), WSP(float, WS_PART) + (size_t)(2 * L + 2) * MT, 0};
            if (!(MK_SKIP & 256)) pg8::gemm_phase<EpiRes, pg8::StaticOrder, true, true>(C.lds, g, S, E);
        }
    }
}

extern "C" void kernel_launch(void* const* d_in, const int* in_sizes, int n_in, void* d_out, int out_size, void* d_ws, size_t ws_size, hipStream_t stream) {
    static int grid = 0;
    if (grid == 0) {
        if (n_in != 26 || (size_t)out_size != O_END || ws_size < WS_END) { fprintf(stderr, "kernel_launch: unexpected shapes (n_in %d, out %d, ws %zu)\n", n_in, out_size, ws_size); grid = -1; return; }
        int dev = 0, cus = 0, per_cu = 0;
        hipGetDevice(&dev); hipDeviceGetAttribute(&cus, hipDeviceAttributeMultiprocessorCount, dev);
        if (hipFuncSetAttribute((const void*)mk_fwd, hipFuncAttributeMaxDynamicSharedMemorySize, LDS_BYTES) != hipSuccess) { fprintf(stderr, "kernel_launch: hipFuncSetAttribute failed\n"); grid = -1; return; }
        if (hipOccupancyMaxActiveBlocksPerMultiprocessor(&per_cu, (const void*)mk_fwd, 512, LDS_BYTES) != hipSuccess || per_cu < 1) per_cu = 1;
        (void)hipGetLastError();
        grid = cus * per_cu;
    }
    if (grid < 0) return;
    hipMemsetAsync((char*)d_ws + WS_CTL, 0, CTL_BYTES, stream);
    Args a{};
    for (int i = 0; i < 26; ++i) a.in[i] = (const float*)d_in[i];
    a.out = (float*)d_out; a.ws = (unsigned char*)d_ws;
#if MK_MULTI
    for (int ph = 0; ph < N_PHASES; ++ph) { a.ph_lo = ph; a.ph_hi = ph + 1; hipLaunchKernelGGL(mk_fwd, dim3(grid), dim3(512), LDS_BYTES, stream, a); }
#else
    a.ph_lo = 0; a.ph_hi = N_PHASES;
    void* args[] = {&a};
    hipError_t e = hipLaunchCooperativeKernel((const void*)mk_fwd, dim3(grid), dim3(512), args, LDS_BYTES, stream);
    if (e != hipSuccess) fprintf(stderr, "cooperative launch failed: %s (grid %d)\n", hipGetErrorString(e), grid);
#endif
}
```

```cpp
#include <hip/hip_runtime.h>
#include <hip/hip_cooperative_groups.h>
#include <cstdio>
#include <cstdint>
#include <cmath>
namespace cg = cooperative_groups;
#ifndef MK_MULTI
#define MK_MULTI 0
#endif
#ifndef MK_SKIP
#define MK_SKIP 0
#endif
#ifndef MK_PROBE
#define MK_PROBE 0
#endif
#ifndef MK_SGB
#define MK_SGB 0
#endif
namespace pg8 {
#define PG8_LAS __attribute__((address_space(3)))
typedef unsigned short bf16_t;
typedef short bf16x8 __attribute__((ext_vector_type(8)));
typedef float f32x4 __attribute__((ext_vector_type(4)));
typedef unsigned u32x4 __attribute__((ext_vector_type(4)));
constexpr int BM = 256, BK = 64, HALF = 128, HTB = HALF * BK * 2  , STAGE_BYTES = 8 * HTB, NXCD = 8, WGM = 8;

__host__ __device__ __forceinline__ int lds_byte(int r, int c) { const int st = (r >> 4) * 2 + (c >> 5), rr = r & 15, cc = c & 31, ob = rr * 64 + cc * 2; return st * 1024 + (ob ^ (((ob >> 9) & 1) << 5)); }
__host__ __device__ __forceinline__ void stage_rc(int b, int& R, int& C) { const int st = b / 1024, sb = b % 1024, swz = sb ^ (((sb >> 9) & 1) << 5); R = (st >> 1) * 16 + swz / 64; C = (st & 1) * 32 + (swz % 64) / 2; }
__host__ __device__ __forceinline__ int perm32(int rho) { const int n = rho >> 4, i = rho & 15; return 8 * (i >> 2) + 4 * n + (i & 3); }

struct Unit { int pm, pn; };
struct Gemm { const bf16_t* A; const bf16_t* Bt; int M, N, K; };

struct StaticOrder {
    int nM, nN, nwg, G, c;
    __host__ __device__ void init(int M, int N, int G_, int c_) { nM = M / BM; nN = N / BM; nwg = nM * nN; G = G_; c = c_; }
    __host__ __device__ bool next(int i, Unit& u) const {
        const long L = (long)i * G + c; if (L >= nwg) return false;
        int wgid = (int)L; { const int q = nwg / NXCD, r = nwg % NXCD, xcd = wgid % NXCD, off = wgid / NXCD; wgid = (xcd < r ? xcd * (q + 1) : r * (q + 1) + (xcd - r) * q) + off; }
        const int nig = WGM * nN, gid = wgid / nig, fm = gid * WGM, gsz = (nM - fm) < WGM ? (nM - fm) : WGM;
        u.pm = fm + ((wgid % nig) % gsz); u.pn = (wgid % nig) / gsz; return true;
    }
    __device__ __forceinline__ void a_ready(const Unit&) const {}
    __device__ __forceinline__ void done(const Unit&) const {}
};

template <class Epi, class Sched, bool ALIGN_EPI = false, bool SP2 = false>
__device__ __forceinline__ void gemm_phase(PG8_LAS unsigned char* lds, const Gemm g, const Sched& S, const Epi& E) {
    int tid_ = threadIdx.x; asm volatile("" : "+v"(tid_)); const int tid = tid_, wid = __builtin_amdgcn_readfirstlane(tid >> 6), lane = tid & 63, wr = wid >> 2, wc = wid & 3, fr = lane & 15, fq = lane >> 4;
    const int K = g.K, nt = K / BK;
    unsigned voffA[2], voffB[2];
#pragma unroll
    for (int i = 0; i < 2; ++i) { int R, C; stage_rc(tid * 16 + i * 8192, R, C); const int Rb = Epi::PERM ? ((R & ~31) + perm32(R & 31)) : R;
        voffA[i] = (unsigned)(R * K + C) * 2u; voffB[i] = (unsigned)(Rb * K + C) * 2u; }
    const size_t kstep = (size_t)(BK * 2);
    const size_t hstep = (size_t)HALF * K * 2;
    const size_t tstep = 2 * hstep;
    const unsigned ldsw = (unsigned)wid * 1024u;
    const int aoff = lds_byte(wr * 64 + fr, fq * 8), boff = lds_byte(wc * 32 + fr, fq * 8);
#define PG8_SA(b, h) (((b) * 2 + (h)) * HTB)
#define PG8_SB(b, h) ((4 + (b) * 2 + (h)) * HTB)
#define PG8_STAGE(bufoff, gbase, voff) do { _Pragma("unroll") for (int _i = 0; _i < 2; ++_i) \
        __builtin_amdgcn_global_load_lds((const unsigned*)((const char*)(gbase) + (voff)[_i]), (PG8_LAS unsigned*)(lds + (bufoff) + ldsw + _i * 8192), 16, 0, 0); } while (0)
#define PG8_LDA(dst, b, h) do { _Pragma("unroll") for (int m = 0; m < 4; ++m) _Pragma("unroll") for (int k = 0; k < 2; ++k) dst[m][k] = *(const PG8_LAS bf16x8*)(lds + PG8_SA(b, h) + aoff + m * 2048 + k * 1024); } while (0)
#define PG8_LDB(dst, b, h) do { _Pragma("unroll") for (int n = 0; n < 2; ++n) _Pragma("unroll") for (int k = 0; k < 2; ++k) dst[n][k] = *(const PG8_LAS bf16x8*)(lds + PG8_SB(b, h) + boff + n * 2048 + k * 1024); } while (0)
#define PG8_MMA(ai, bj, At, Bt) do { __builtin_amdgcn_s_setprio(1); _Pragma("unroll") for (int m = 0; m < 4; ++m) _Pragma("unroll") for (int n = 0; n < 2; ++n) _Pragma("unroll") for (int k = 0; k < 2; ++k) \
        acc[ai][bj][m][n] = __builtin_amdgcn_mfma_f32_16x16x32_bf16(Bt[n][k], At[m][k], acc[ai][bj][m][n], 0, 0, 0); __builtin_amdgcn_s_setprio(0); } while (0)
#define PG8_WAIT_V(n) asm volatile("s_waitcnt vmcnt(" #n ")" ::: "memory")
#define PG8_WAIT_L(n) asm volatile("s_waitcnt lgkmcnt(" #n ")" ::: "memory")
#define PG8_BAR __builtin_amdgcn_s_barrier()
#define PG8_SCHED __builtin_amdgcn_sched_barrier(0)
    Unit cur, nxt; int ui = 0;
    if (!S.next(0, cur)) return;
    f32x4 acc[2][2][4][2];
#pragma unroll
    for (int a = 0; a < 2; ++a)
#pragma unroll
        for (int b = 0; b < 2; ++b)
#pragma unroll
            for (int m = 0; m < 4; ++m)
#pragma unroll
                for (int n = 0; n < 2; ++n) acc[a][b][m][n] = (f32x4){0.f, 0.f, 0.f, 0.f};
    bf16x8 At[4][2], B0[2][2], B1[2][2];
    const char* cA = (const char*)g.A + (size_t)cur.pm * tstep; const char* cB = (const char*)g.Bt + (size_t)cur.pn * tstep;
    S.a_ready(cur);
    if constexpr (SP2) {
        PG8_STAGE(PG8_SB(0, 0), cB, voffB); PG8_STAGE(PG8_SB(0, 1), cB + hstep, voffB); PG8_STAGE(PG8_SA(0, 0), cA, voffA); PG8_STAGE(PG8_SA(0, 1), cA + hstep, voffA);
        if (wr == 1) PG8_BAR;
        PG8_WAIT_V(2); PG8_BAR;
        PG8_STAGE(PG8_SB(1, 0), cB + kstep, voffB); PG8_STAGE(PG8_SA(1, 0), cA + kstep, voffA); PG8_STAGE(PG8_SB(1, 1), cB + hstep + kstep, voffB);
        PG8_WAIT_V(6); PG8_BAR;
    } else {
        PG8_STAGE(PG8_SB(0, 0), cB, voffB); PG8_STAGE(PG8_SA(0, 0), cA, voffA); PG8_STAGE(PG8_SB(0, 1), cB + hstep, voffB); PG8_STAGE(PG8_SA(0, 1), cA + hstep, voffA);
        if (wr == 1) PG8_BAR;
        PG8_WAIT_V(4); PG8_BAR;
        PG8_STAGE(PG8_SB(1, 0), cB + kstep, voffB); PG8_STAGE(PG8_SA(1, 0), cA + kstep, voffA); PG8_STAGE(PG8_SB(1, 1), cB + hstep + kstep, voffB);
        PG8_WAIT_V(6); PG8_BAR;
    }
    for (;;) {
        const bool has_next = S.next(ui + 1, nxt);
        const char* nA = has_next ? (const char*)g.A + (size_t)nxt.pm * tstep : cA; const char* nB = has_next ? (const char*)g.Bt + (size_t)nxt.pn * tstep : cB;
        for (int t = 0; t < nt; t += 2) {
            const bool last = (t == nt - 2);
            const char* a1 = cA + (size_t)(t + 1) * kstep;
            const char* a2 = last ? nA : cA + (size_t)(t + 2) * kstep; const char* b2 = last ? nB : cB + (size_t)(t + 2) * kstep;
            const char* a3 = a2 + kstep; const char* b3 = b2 + kstep;
            if (last && has_next) S.a_ready(nxt);
            if constexpr (SP2) {
            PG8_LDB(B0, 0, 0); PG8_LDB(B1, 0, 1); PG8_SCHED; PG8_LDA(At, 0, 0); PG8_STAGE(PG8_SA(1, 1), a1 + hstep, voffA);
            PG8_WAIT_V(8); PG8_WAIT_L(0); PG8_BAR; PG8_MMA(0, 0, At, B0); PG8_MMA(0, 1, At, B1); PG8_BAR; PG8_SCHED;
            PG8_LDA(At, 0, 1); PG8_STAGE(PG8_SB(0, 0), b2, voffB); PG8_STAGE(PG8_SB(0, 1), b2 + hstep, voffB); PG8_STAGE(PG8_SA(0, 0), a2, voffA);
            PG8_WAIT_V(8); PG8_WAIT_L(0); PG8_BAR; PG8_MMA(1, 0, At, B0); PG8_MMA(1, 1, At, B1); PG8_BAR; PG8_SCHED;
            PG8_LDB(B0, 1, 0); PG8_LDB(B1, 1, 1); PG8_SCHED; PG8_LDA(At, 1, 0); PG8_STAGE(PG8_SA(0, 1), a2 + hstep, voffA);
            PG8_WAIT_V(8); PG8_WAIT_L(0); PG8_BAR; PG8_MMA(0, 0, At, B0); PG8_MMA(0, 1, At, B1); PG8_BAR; PG8_SCHED;
            PG8_LDA(At, 1, 1); PG8_STAGE(PG8_SB(1, 0), b3, voffB); PG8_STAGE(PG8_SB(1, 1), b3 + hstep, voffB); PG8_STAGE(PG8_SA(1, 0), a3, voffA);
            PG8_WAIT_V(8); PG8_WAIT_L(0); PG8_BAR; PG8_MMA(1, 0, At, B0); PG8_MMA(1, 1, At, B1); PG8_BAR; PG8_SCHED;
            } else {
            PG8_LDB(B0, 0, 0); PG8_SCHED; PG8_LDA(At, 0, 0); PG8_STAGE(PG8_SA(1, 1), a1 + hstep, voffA);
            PG8_WAIT_L(8); PG8_BAR; PG8_WAIT_L(0); PG8_MMA(0, 0, At, B0); PG8_BAR; PG8_SCHED;
            PG8_LDB(B1, 0, 1); PG8_STAGE(PG8_SB(0, 0), b2, voffB);
            PG8_BAR; PG8_WAIT_L(0); PG8_MMA(0, 1, At, B1); PG8_BAR;
            PG8_LDA(At, 0, 1); PG8_STAGE(PG8_SA(0, 0), a2, voffA);
            PG8_BAR; PG8_WAIT_L(0); PG8_MMA(1, 0, At, B0); PG8_BAR; PG8_SCHED;
            PG8_STAGE(PG8_SB(0, 1), b2 + hstep, voffB);
            PG8_WAIT_V(6); PG8_BAR; PG8_MMA(1, 1, At, B1); PG8_BAR;
            PG8_LDB(B0, 1, 0); PG8_SCHED; PG8_LDA(At, 1, 0); PG8_STAGE(PG8_SA(0, 1), a2 + hstep, voffA);
            PG8_WAIT_L(8); PG8_BAR; PG8_WAIT_L(0); PG8_MMA(0, 0, At, B0); PG8_BAR; PG8_SCHED;
            PG8_LDB(B1, 1, 1); PG8_STAGE(PG8_SB(1, 0), b3, voffB);
            PG8_BAR; PG8_WAIT_L(0); PG8_MMA(0, 1, At, B1); PG8_BAR;
            PG8_LDA(At, 1, 1); PG8_STAGE(PG8_SA(1, 0), a3, voffA);
            PG8_BAR; PG8_WAIT_L(0); PG8_MMA(1, 0, At, B0); PG8_BAR; PG8_SCHED;
            PG8_STAGE(PG8_SB(1, 1), b3 + hstep, voffB);
            PG8_WAIT_V(6); PG8_BAR; PG8_MMA(1, 1, At, B1); PG8_BAR;
            }
        }
        if constexpr (ALIGN_EPI) { if (wr == 0) PG8_BAR; }
        if constexpr (!Epi::AFTER_DRAIN) { E(acc, cur, wr, wc, fr, fq); S.done(cur); }
        if (!has_next) break;
#pragma unroll
        for (int a = 0; a < 2; ++a)
#pragma unroll
            for (int b = 0; b < 2; ++b)
#pragma unroll
                for (int m = 0; m < 4; ++m)
#pragma unroll
                    for (int n = 0; n < 2; ++n) acc[a][b][m][n] = (f32x4){0.f, 0.f, 0.f, 0.f};
        cur = nxt; cA = nA; cB = nB; ++ui;
        if constexpr (ALIGN_EPI) { if (wr == 1) PG8_BAR; }
    }
    PG8_WAIT_V(0);
    if constexpr (!ALIGN_EPI) { if (wr == 0) PG8_BAR; }
    PG8_BAR;
    if constexpr (Epi::AFTER_DRAIN) { E.fused(acc, cur, wr, wc, fr, fq, lds, wid, lane); S.done(cur); }
#undef PG8_SA
#undef PG8_SB
#undef PG8_STAGE
#undef PG8_LDA
#undef PG8_LDB
#undef PG8_MMA
#undef PG8_WAIT_V
#undef PG8_WAIT_L
#undef PG8_BAR
#undef PG8_SCHED
}
}

#define LAS __attribute__((address_space(3)))
typedef unsigned short bf16_t;
typedef short bf16x8 __attribute__((ext_vector_type(8)));
typedef float f32x4 __attribute__((ext_vector_type(4)));
typedef float f32x16 __attribute__((ext_vector_type(16)));
typedef unsigned u32x4 __attribute__((ext_vector_type(4)));
typedef unsigned u32x2 __attribute__((ext_vector_type(2)));

constexpr int DM = 1024, SEQ = 16384, NSMP = 128, MV = SEQ + NSMP, MT = 16640;
constexpr int NIN = 11296, NINP = 11520, DFF = 2816, DIN = 2048, CONVD = 4096;
constexpr int NCHUNK = 264;
constexpr size_t HPN = 32 * 64 * 128;
constexpr int PAST = 4096;

constexpr size_t O_YP = 0, O_YS = O_YP + (size_t)SEQ * DM, O_KP = O_YS + (size_t)NSMP * DM, O_VP = O_KP + 2ull * SEQ * DM,
                 O_CP = O_VP + 2ull * SEQ * DM, O_SP = O_CP + 2ull * 3 * CONVD, O_KS = O_SP + 2ull * HPN, O_VS = O_KS + 2ull * NSMP * DM,
                 O_CS = O_VS + 2ull * NSMP * DM, O_SS = O_CS + 2ull * 8 * 3 * CONVD, O_END = O_SS + 2ull * 8 * HPN;

constexpr size_t MiB = 1ull << 20;
constexpr size_t SZ_WIN = (size_t)NINP * 1024 * 2, SZ_WBA = 1024ull * 1024 * 2, SZ_WBS = 1024ull * 2048 * 2, SZ_WOUT = SZ_WBA,
                 SZ_WGU = 5632ull * 1024 * 2, SZ_WD = 1024ull * DFF * 2;
constexpr size_t WS_CTL = 0, CTL_BYTES = 65536;
constexpr size_t WS_WIN = 1 * MiB, WS_WBA = WS_WIN + 2 * SZ_WIN, WS_WBS = WS_WBA + 2 * SZ_WBA, WS_WOUT = WS_WBS + 2 * SZ_WBS,
                 WS_WGU = WS_WOUT + 2 * SZ_WOUT, WS_WD = WS_WGU + 2 * SZ_WGU, WS_WEND = WS_WD + 2 * SZ_WD;
constexpr size_t WS_KC = (WS_WEND + MiB - 1) / MiB * MiB;
constexpr size_t WS_VTC = WS_KC + 8ull * PAST * 1024 * 2;
constexpr size_t WS_X = WS_VTC + 8ull * PAST * 1024 * 2;
constexpr size_t WS_XB = WS_X + (size_t)MT * 1024 * 4;
constexpr size_t WS_PART = WS_XB + (size_t)MT * 1024 * 2;
constexpr size_t WS_Q = WS_PART + (size_t)MT * 16 * 4;
constexpr size_t WS_K = WS_Q + (size_t)MT * 1024 * 2;
constexpr size_t WS_VT = WS_K + (size_t)MT * 1024 * 2;
constexpr size_t WS_Z = WS_VT + (size_t)MT * 1024 * 2;
constexpr size_t WS_XBC = WS_Z + (size_t)MT * 2048 * 2;
constexpr size_t WS_G = WS_XBC + (size_t)MT * 4096 * 2;
constexpr size_t WS_DT = WS_G + (size_t)MT * 2048 * 2;
constexpr size_t WS_CS = WS_DT + (size_t)MT * 32 * 4;
constexpr size_t WS_CDEC = WS_CS + (size_t)NCHUNK * HPN * 2;
constexpr size_t WS_ATT = WS_CDEC + 65536;
constexpr size_t WS_YSSD = WS_ATT + (size_t)MT * 1024 * 2;
constexpr size_t WS_HIST = WS_YSSD + (size_t)MT * 2048 * 2;
constexpr size_t WS_XTG = WS_HIST + 256ull * 3 * 4096 * 2;
constexpr size_t WS_BTG = WS_XTG + (size_t)NCHUNK * 2048 * 64 * 2;
constexpr size_t WS_ACTS = WS_BTG + (size_t)NCHUNK * 1024 * 64 * 2;
constexpr size_t WS_DTA = WS_ACTS + 256ull * DFF * 2;
constexpr size_t WS_ACSG = WS_DTA + (size_t)NCHUNK * 32 * 64 * 4;
constexpr size_t WS_END = WS_ACSG + (size_t)NCHUNK * 32 * 64 * 4;
static_assert(WS_END <= 1024ull * MiB, "workspace map must fit 1 GiB");

constexpr int LDS_CTL = 131072, LDS_BYTES = 131072 + 1024;
constexpr int AT_KROW = 272, AT_VROW = 144, AT_KSZ = 64 * AT_KROW, AT_VSZ = 128 * AT_VROW, AT_STAGE = AT_KSZ + AT_VSZ;
constexpr int SD_DT = 0, SD_ACS = 1024, SD_RS = 2048, SD_BT = 4096, SD_XT = SD_BT + 128 * 144, SD_CM = SD_XT + 256 * 144, SD_BM = SD_CM + 64 * 272, SD_END = SD_BM + 64 * 272;
static_assert(SD_END <= 131072 && 2 * AT_STAGE <= 131072, "lds");

struct Args { const float* in[26]; float* out; unsigned char* ws; int ph_lo, ph_hi; };

__device__ __forceinline__ unsigned pk_bf16(float lo, float hi) {
    typedef float f2 __attribute__((ext_vector_type(2))); typedef __bf16 b2 __attribute__((ext_vector_type(2)));
    f2 v = {lo, hi}; b2 b = __builtin_convertvector(v, b2); return __builtin_bit_cast(unsigned, b);
}
__device__ __forceinline__ float bf_lo(unsigned u) { return __uint_as_float(u << 16); }
__device__ __forceinline__ float bf_hi(unsigned u) { return __uint_as_float(u & 0xffff0000u); }
__device__ __forceinline__ float fexp2(float x) { return __builtin_amdgcn_exp2f(x); }
__device__ __forceinline__ float fexp(float x) { return __builtin_amdgcn_exp2f(x * 1.4426950408889634f); }
__device__ __forceinline__ float frcp(float x) { return __builtin_amdgcn_rcpf(x); }
__device__ __forceinline__ float silu_f(float x) { return x * frcp(1.0f + fexp(-x)); }
__device__ __forceinline__ float sigmoid_f(float x) { return frcp(1.0f + fexp(-x)); }
__device__ __forceinline__ float wave_sum(float v) {
#pragma unroll
    for (int o = 1; o < 64; o <<= 1) v += __shfl_xor(v, o);
    return v;
}
__device__ __forceinline__ unsigned my_xcc_id() { return (unsigned)__builtin_amdgcn_s_getreg((3 << 11) | 20) & 0xFu; }
__device__ __forceinline__ int sig5(int i) { return (i & ~12) | ((i & 4) << 1) | ((i & 8) >> 1); }
__device__ __forceinline__ float rstd1(const float* rss, int row, float eps) { return 1.0f / sqrtf(rss[row] * (1.0f / 1024.0f) + eps); }
__device__ __forceinline__ float rstd_row(const float* part, int row, float eps) {
    const f32x4* p = (const f32x4*)(part + (size_t)row * 16);
    const f32x4 a = p[0], b = p[1], c = p[2], d = p[3];
    const float s = ((a.x + a.y) + (a.z + a.w)) + ((b.x + b.y) + (b.z + b.w)) + ((c.x + c.y) + (c.z + c.w)) + ((d.x + d.y) + (d.z + d.w));
    return 1.0f / sqrtf(s * (1.0f / 1024.0f) + eps);
}
__device__ __forceinline__ float max3f(float a, float b, float c) { float r; asm("v_max3_f32 %0, %1, %2, %3" : "=v"(r) : "v"(a), "v"(b), "v"(c)); return r; }
#define MFMA32(a, b, c) __builtin_amdgcn_mfma_f32_32x32x16_bf16((a), (b), (c), 0, 0, 0)

#define EPI_LOOP_ROWS _Pragma("unroll") for (int ai = 0; ai < 2; ++ai) _Pragma("unroll") for (int m = 0; m < 4; ++m)
#define EPI_LOOP_COLS _Pragma("unroll") for (int bj = 0; bj < 2; ++bj) _Pragma("unroll") for (int n = 0; n < 2; ++n)

struct EpiIn {
    static constexpr bool PERM = true, AFTER_DRAIN = false;
    const float* part; bf16_t *Q, *K, *VT, *Z, *XBC, *G; float* DT; float* out; int layer; bf16_t* HIST;
    __device__ __forceinline__ void operator()(const pg8::f32x4 (&acc)[2][2][4][2], const pg8::Unit& u, int wr, int wc, int fr, int fq) const {
        const int pn = u.pn; const int cb = pn * 256 + wc * 32 + 8 * fq;
        float rsv[2][4];
#pragma unroll
        for (int ai = 0; ai < 2; ++ai)
#pragma unroll
            for (int m = 0; m < 4; ++m) rsv[ai][m] = part[u.pm * 256 + ai * 128 + wr * 64 + m * 16 + fr];
#pragma unroll
        for (int ai = 0; ai < 2; ++ai)
#pragma unroll
            for (int m = 0; m < 4; ++m) rsv[ai][m] = 1.0f / sqrtf(rsv[ai][m] * (1.0f / 1024.0f) + 1e-6f);
        EPI_LOOP_ROWS {
            const int row = u.pm * 256 + ai * 128 + wr * 64 + m * 16 + fr;
            const float rs = rsv[ai][m];
#pragma unroll
            for (int bj = 0; bj < 2; ++bj) {
                const pg8::f32x4 v0 = acc[ai][bj][m][0] * rs, v1 = acc[ai][bj][m][1] * rs; const int col = cb + bj * 128;
                if (pn < 4) {
                    const float sc = 0.125f * 1.4426950408889634f;
                    u32x4 w; w.x = pk_bf16(v0[0] * sc, v0[1] * sc); w.y = pk_bf16(v0[2] * sc, v0[3] * sc); w.z = pk_bf16(v1[0] * sc, v1[1] * sc); w.w = pk_bf16(v1[2] * sc, v1[3] * sc);
                    *(u32x4*)(Q + (size_t)row * 1024 + col) = w;
                } else if (pn < 8) {
                    const int c = col - 1024; u32x4 w; w.x = pk_bf16(v0[0], v0[1]); w.y = pk_bf16(v0[2], v0[3]); w.z = pk_bf16(v1[0], v1[1]); w.w = pk_bf16(v1[2], v1[3]);
                    *(u32x4*)(K + (size_t)row * 1024 + c) = w;
                    float* o = nullptr;
                    if (row < SEQ) o = out + O_KP + ((size_t)layer * SEQ + row) * 1024 + c; else if (row < MV) o = out + O_KS + ((size_t)layer * NSMP + (row - SEQ)) * 1024 + c;
                    if (o) { *(pg8::f32x4*)o = v0; *(pg8::f32x4*)(o + 4) = v1; }
                } else if (pn < 12) {
                    const int c = col - 2048;
                    const unsigned w0 = pk_bf16(v0[0], v0[1]), w1 = pk_bf16(v0[2], v0[3]), w2 = pk_bf16(v1[0], v1[1]), w3 = pk_bf16(v1[2], v1[3]);
                    VT[(size_t)(c + 0) * MT + row] = (bf16_t)(w0 & 0xffffu); VT[(size_t)(c + 1) * MT + row] = (bf16_t)(w0 >> 16);
                    VT[(size_t)(c + 2) * MT + row] = (bf16_t)(w1 & 0xffffu); VT[(size_t)(c + 3) * MT + row] = (bf16_t)(w1 >> 16);
                    VT[(size_t)(c + 4) * MT + row] = (bf16_t)(w2 & 0xffffu); VT[(size_t)(c + 5) * MT + row] = (bf16_t)(w2 >> 16);
                    VT[(size_t)(c + 6) * MT + row] = (bf16_t)(w3 & 0xffffu); VT[(size_t)(c + 7) * MT + row] = (bf16_t)(w3 >> 16);
                    float* o = nullptr;
                    if (row < SEQ) o = out + O_VP + ((size_t)layer * SEQ + row) * 1024 + c; else if (row < MV) o = out + O_VS + ((size_t)layer * NSMP + (row - SEQ)) * 1024 + c;
                    if (o) { *(pg8::f32x4*)o = v0; *(pg8::f32x4*)(o + 4) = v1; }
                } else if (pn < 20) {
                    const int c = col - 3072; u32x4 w; w.x = pk_bf16(v0[0], v0[1]); w.y = pk_bf16(v0[2], v0[3]); w.z = pk_bf16(v1[0], v1[1]); w.w = pk_bf16(v1[2], v1[3]);
                    *(u32x4*)(Z + (size_t)row * 2048 + c) = w;
                } else if (pn < 36) {
                    const int c = col - 5120; u32x4 w; w.x = pk_bf16(v0[0], v0[1]); w.y = pk_bf16(v0[2], v0[3]); w.z = pk_bf16(v1[0], v1[1]); w.w = pk_bf16(v1[2], v1[3]);
                    *(u32x4*)(XBC + (size_t)row * 4096 + c) = w;
                    if (row < SEQ && (row & 63) >= 61) *(u32x4*)(HIST + ((size_t)(row >> 6) * 3 + ((row & 63) - 61)) * 4096 + c) = w;
                    float* o = nullptr;
                    if (row >= SEQ - 3 && row < SEQ) o = out + O_CP + ((size_t)layer * 3 + (row - (SEQ - 3))) * 4096 + c;
                    else if (row >= SEQ && row < MV) { const int s = row - SEQ, t = s & 15; if (t >= 13) o = out + O_CS + (((size_t)layer * 8 + (s >> 4)) * 3 + (t - 13)) * 4096 + c; }
                    if (o) { *(pg8::f32x4*)o = v0; *(pg8::f32x4*)(o + 4) = v1; }
                } else if (pn < 44) {
                    const int c = col - 9216; u32x4 w; w.x = pk_bf16(sigmoid_f(v0[0]), sigmoid_f(v0[1])); w.y = pk_bf16(sigmoid_f(v0[2]), sigmoid_f(v0[3]));
                    w.z = pk_bf16(sigmoid_f(v1[0]), sigmoid_f(v1[1])); w.w = pk_bf16(sigmoid_f(v1[2]), sigmoid_f(v1[3]));
                    *(u32x4*)(G + (size_t)row * 2048 + c) = w;
                } else {
                    const int c = col - 11264;
                    if (c < 32) { *(pg8::f32x4*)(DT + (size_t)row * 32 + c) = v0; *(pg8::f32x4*)(DT + (size_t)row * 32 + c + 4) = v1; }
                }
            }
        }
    }
};

struct EpiNull {
    static constexpr bool PERM = false, AFTER_DRAIN = false; float* sink;
    __device__ __forceinline__ void operator()(const pg8::f32x4 (&acc)[2][2][4][2], const pg8::Unit& u, int wr, int wc, int fr, int fq) const {
        pg8::f32x4 s = acc[0][0][0][0];
        EPI_LOOP_ROWS { EPI_LOOP_COLS { s += acc[ai][bj][m][n]; } }
        if (s[0] == 123456.789f) sink[0] = s[1] + s[2] + s[3];
    }
};
struct EpiBrA {
    static constexpr bool PERM = false, AFTER_DRAIN = false;
    const bf16_t* G; float* MF; int row0;
    __device__ __forceinline__ void operator()(const pg8::f32x4 (&acc)[2][2][4][2], const pg8::Unit& u, int wr, int wc, int fr, int fq) const {
        const int cb = u.pn * 256 + wc * 32 + 4 * fq;
        EPI_LOOP_ROWS { const int row = row0 + u.pm * 256 + ai * 128 + wr * 64 + m * 16 + fr;
            EPI_LOOP_COLS { const int col = cb + bj * 128 + n * 16; const u32x2 g = *(const u32x2*)(G + (size_t)row * 2048 + col);
                pg8::f32x4 v = acc[ai][bj][m][n]; v[0] *= bf_lo(g.x); v[1] *= bf_hi(g.x); v[2] *= bf_lo(g.y); v[3] *= bf_hi(g.y);
                *(pg8::f32x4*)(MF + (size_t)row * 1024 + col) = v; } }
    }
};
struct EpiBrB {
    static constexpr bool PERM = false, AFTER_DRAIN = false;
    const bf16_t* G; const float* MF; bf16_t* MB; int row0;
    __device__ __forceinline__ void operator()(const pg8::f32x4 (&acc)[2][2][4][2], const pg8::Unit& u, int wr, int wc, int fr, int fq) const {
        const int cb = u.pn * 256 + wc * 32 + 4 * fq;
        EPI_LOOP_ROWS { const int row = row0 + u.pm * 256 + ai * 128 + wr * 64 + m * 16 + fr;
            EPI_LOOP_COLS { const int col = cb + bj * 128 + n * 16; const u32x2 g = *(const u32x2*)(G + (size_t)row * 2048 + 1024 + col);
                const pg8::f32x4 a = acc[ai][bj][m][n]; const pg8::f32x4 o = *(const pg8::f32x4*)(MF + (size_t)row * 1024 + col);
                u32x2 w; w.x = pk_bf16(o[0] + a[0] * bf_lo(g.x), o[1] + a[1] * bf_hi(g.x)); w.y = pk_bf16(o[2] + a[2] * bf_lo(g.y), o[3] + a[3] * bf_hi(g.y));
                *(u32x2*)(MB + (size_t)row * 1024 + col) = w; } }
    }
};
struct EpiRes {
    static constexpr bool PERM = false, AFTER_DRAIN = false;
    float* X; bf16_t* XB; float* part; int row0;
    __device__ __forceinline__ void operator()(const pg8::f32x4 (&acc)[2][2][4][2], const pg8::Unit& u, int wr, int wc, int fr, int fq) const {
        const int cb = u.pn * 256 + wc * 32 + 4 * fq;
        EPI_LOOP_ROWS { const int row = row0 + u.pm * 256 + ai * 128 + wr * 64 + m * 16 + fr; float ss = 0.f;
            EPI_LOOP_COLS { const int col = cb + bj * 128 + n * 16; float* xp = X + (size_t)row * 1024 + col;
                const pg8::f32x4 x = *(const pg8::f32x4*)xp + acc[ai][bj][m][n];
                *(pg8::f32x4*)xp = x; u32x2 w; w.x = pk_bf16(x[0], x[1]); w.y = pk_bf16(x[2], x[3]); *(u32x2*)(XB + (size_t)row * 1024 + col) = w;
                ss += (x[0] * x[0] + x[1] * x[1]) + (x[2] * x[2] + x[3] * x[3]); }
            ss += __shfl_xor(ss, 16); ss += __shfl_xor(ss, 32);
            if (fq == 0) atomicAdd(part + row, ss); }
    }
};
struct EpiGU {
    static constexpr bool PERM = true, AFTER_DRAIN = false;
    const float* part; bf16_t* ACT; int row0; int act_sub;
    __device__ __forceinline__ void operator()(const pg8::f32x4 (&acc)[2][2][4][2], const pg8::Unit& u, int wr, int wc, int fr, int fq) const {
        const int cb = u.pn * 128 + wc * 32 + 8 * fq;
        float rsv[2][4];
#pragma unroll
        for (int ai = 0; ai < 2; ++ai)
#pragma unroll
            for (int m = 0; m < 4; ++m) rsv[ai][m] = part[row0 + u.pm * 256 + ai * 128 + wr * 64 + m * 16 + fr];
#pragma unroll
        for (int ai = 0; ai < 2; ++ai)
#pragma unroll
            for (int m = 0; m < 4; ++m) rsv[ai][m] = 1.0f / sqrtf(rsv[ai][m] * (1.0f / 1024.0f) + 1e-6f);
        EPI_LOOP_ROWS { const int row = row0 - act_sub + u.pm * 256 + ai * 128 + wr * 64 + m * 16 + fr; const float rs = rsv[ai][m];
            const pg8::f32x4 g0 = acc[ai][0][m][0] * rs, g1 = acc[ai][0][m][1] * rs, u0 = acc[ai][1][m][0] * rs, u1 = acc[ai][1][m][1] * rs;
            u32x4 w; w.x = pk_bf16(silu_f(g0[0]) * u0[0], silu_f(g0[1]) * u0[1]); w.y = pk_bf16(silu_f(g0[2]) * u0[2], silu_f(g0[3]) * u0[3]);
            w.z = pk_bf16(silu_f(g1[0]) * u1[0], silu_f(g1[1]) * u1[1]); w.w = pk_bf16(silu_f(g1[2]) * u1[2], silu_f(g1[3]) * u1[3]);
            *(u32x4*)(ACT + (size_t)row * DFF + cb) = w; }
    }
};

struct Ctx {
    LAS unsigned char* lds; int tid, lane, wid, G, bid;
    const float* in[26]; float* out; unsigned char* ws;
};
#define WSP(T, off) ((T*)(C.ws + (off)))

struct TItem { const float* W; int N, k0, n0; bf16_t* WT; size_t dst_row0; int Kd; const float* kscale; };
struct TRegs { float tv[32]; f32x4 s0, s1; };
__device__ __forceinline__ void tr_load(const TItem& t, TRegs& r, int lane) {
#pragma unroll
    for (int i = 0; i < 32; ++i) r.tv[i] = t.W[(size_t)(t.k0 + 2 * i + (lane >> 5)) * t.N + t.n0 + (lane & 31)];
    if (t.kscale) { r.s0 = *(const f32x4*)(t.kscale + t.k0 + 8 * (lane & 7)); r.s1 = *(const f32x4*)(t.kscale + t.k0 + 8 * (lane & 7) + 4); }
    else { r.s0 = (f32x4){1.f, 1.f, 1.f, 1.f}; r.s1 = r.s0; }
}
__device__ __forceinline__ void tr_finish(const TItem& t, const TRegs& r, LAS float* scr, int lane) {
#pragma unroll
    for (int i = 0; i < 32; ++i) scr[(2 * i + (lane >> 5)) * 33 + (lane & 31)] = r.tv[i];
    asm volatile("s_waitcnt lgkmcnt(0)" ::: "memory");
    const int c = lane & 7;
#pragma unroll
    for (int j = 0; j < 4; ++j) { const int n = (lane >> 3) + 8 * j; const LAS float* s = scr + (8 * c) * 33 + n;
        u32x4 o; o.x = pk_bf16(s[0 * 33] * r.s0.x, s[1 * 33] * r.s0.y); o.y = pk_bf16(s[2 * 33] * r.s0.z, s[3 * 33] * r.s0.w);
        o.z = pk_bf16(s[4 * 33] * r.s1.x, s[5 * 33] * r.s1.y); o.w = pk_bf16(s[6 * 33] * r.s1.z, s[7 * 33] * r.s1.w);
        *(u32x4*)(t.WT + (t.dst_row0 + n) * (size_t)t.Kd + t.k0 + 8 * c) = o; }
    asm volatile("s_waitcnt lgkmcnt(0)" ::: "memory");
}
__device__ __forceinline__ bool p0_item(const Ctx& C, int it, TItem& t) {
    constexpr int I_IN = 16 * 353, I_BA = 16 * 32, I_BS = 32 * 32, I_OUT = 16 * 32, I_GU = 16 * 176, I_D = 44 * 32, I_L = I_IN + I_BA + I_BS + I_OUT + I_GU + I_D;
    if (it >= 2 * I_L) return false;
    const int L = it / I_L; int r = it % I_L; t.kscale = nullptr;
    if (r < I_IN) { const int kb = r / 353, nb = r % 353, n0 = 32 * nb;
        t.W = C.in[7] + (size_t)L * 1024 * NIN; t.N = NIN; t.k0 = 64 * kb; t.n0 = n0; t.WT = WSP(bf16_t, WS_WIN + L * SZ_WIN);
        t.dst_row0 = n0 < 9216 ? n0 : (n0 < 9248 ? 11264 + (n0 - 9216) : 9216 + (n0 - 9248)); t.Kd = 1024; t.kscale = C.in[6] + L * 1024; return true; }
    r -= I_IN;
    if (r < I_BA) { t.W = C.in[19] + (size_t)L * 1024 * 1024; t.N = 1024; t.k0 = 64 * (r / 32); t.n0 = 32 * (r % 32); t.WT = WSP(bf16_t, WS_WBA + L * SZ_WBA); t.dst_row0 = t.n0; t.Kd = 1024; return true; }
    r -= I_BA;
    if (r < I_BS) { t.W = C.in[20] + (size_t)L * 2048 * 1024; t.N = 1024; t.k0 = 64 * (r / 32); t.n0 = 32 * (r % 32); t.WT = WSP(bf16_t, WS_WBS + L * SZ_WBS); t.dst_row0 = t.n0; t.Kd = 2048; return true; }
    r -= I_BS;
    if (r < I_OUT) { t.W = C.in[21] + (size_t)L * 1024 * 1024; t.N = 1024; t.k0 = 64 * (r / 32); t.n0 = 32 * (r % 32); t.WT = WSP(bf16_t, WS_WOUT + L * SZ_WOUT); t.dst_row0 = t.n0; t.Kd = 1024; return true; }
    r -= I_OUT;
    if (r < I_GU) { const int kb = r / 176, nb = r % 176, n0 = 32 * nb; const int ch = n0 % DFF;
        t.W = C.in[23] + (size_t)L * 1024 * 5632; t.N = 5632; t.k0 = 64 * kb; t.n0 = n0; t.WT = WSP(bf16_t, WS_WGU + L * SZ_WGU);
        t.dst_row0 = 256 * (ch / 128) + (ch % 128) + (n0 >= DFF ? 128 : 0); t.Kd = 1024; t.kscale = C.in[22] + L * 1024; return true; }
    r -= I_GU;
    t.W = C.in[24] + (size_t)L * DFF * 1024; t.N = 1024; t.k0 = 64 * (r / 32); t.n0 = 32 * (r % 32); t.WT = WSP(bf16_t, WS_WD + L * SZ_WD); t.dst_row0 = t.n0; t.Kd = DFF; return true;
}

__device__ __forceinline__ void phase_p0(Ctx& C) {
    LAS float* scr = (LAS float*)(C.lds + C.wid * 8704);
    const int gw = C.bid * 8 + C.wid, NGW = C.G * 8;
    {   TItem cur, nxt; TRegs ra, rb; int it = gw;
        bool have = p0_item(C, it, cur); if (have) tr_load(cur, ra, C.lane);
        while (have) { it += NGW; const bool hn = p0_item(C, it, nxt); if (hn) tr_load(nxt, rb, C.lane);
            tr_finish(cur, ra, scr, C.lane); cur = nxt; ra = rb; have = hn; } }
    {   const int nz = 2 * (NINP - NIN) * 1024 / 8;
        for (int i = C.bid * 512 + C.tid; i < nz; i += C.G * 512) { const int L = i / ((NINP - NIN) * 128), r = i % ((NINP - NIN) * 128);
            *(u32x4*)(WSP(bf16_t, WS_WIN + L * SZ_WIN) + (size_t)NIN * 1024 + (size_t)r * 8) = (u32x4){0u, 0u, 0u, 0u}; } }
    float* X = WSP(float, WS_X); bf16_t* XB = WSP(bf16_t, WS_XB); float* PART = WSP(float, WS_PART);
    for (int mrow = gw; mrow < MT; mrow += NGW) {
        f32x4 v[4]; float ss = 0.f;
#pragma unroll
        for (int j = 0; j < 4; ++j) {
            if (mrow < SEQ) v[j] = *(const f32x4*)(C.in[0] + (size_t)mrow * 1024 + 4 * C.lane + 256 * j);
            else if (mrow < MV) v[j] = *(const f32x4*)(C.in[1] + (size_t)(mrow - SEQ) * 1024 + 4 * C.lane + 256 * j);
            else v[j] = (f32x4){0.f, 0.f, 0.f, 0.f};
            ss += (v[j].x * v[j].x + v[j].y * v[j].y) + (v[j].z * v[j].z + v[j].w * v[j].w);
            *(f32x4*)(X + (size_t)mrow * 1024 + 4 * C.lane + 256 * j) = v[j];
            u32x2 w; w.x = pk_bf16(v[j].x, v[j].y); w.y = pk_bf16(v[j].z, v[j].w);
            *(u32x2*)(XB + (size_t)mrow * 1024 + 4 * C.lane + 256 * j) = w;
        }
        ss = wave_sum(ss);
        if (C.lane < 5) PART[(size_t)C.lane * MT + mrow] = (C.lane == 0) ? ss : 0.f;
    }
}

__device__ __forceinline__ void cache_convert(Ctx& C, int L) {
    const float* ck = C.in[2] + (size_t)L * 8 * PAST * 1024; bf16_t* KC = WSP(bf16_t, WS_KC);
    const int ntask = 8 * PAST * 1024 / 8;
    {   const int stride = C.G * 512;
        for (int i0 = C.bid * 512 + C.tid; i0 < ntask; i0 += 4 * stride) { f32x4 a[4], b[4];
#pragma unroll
            for (int j = 0; j < 4; ++j) { const int i = i0 + j * stride; if (i < ntask) { a[j] = *(const f32x4*)(ck + (size_t)i * 8); b[j] = *(const f32x4*)(ck + (size_t)i * 8 + 4); } }
#pragma unroll
            for (int j = 0; j < 4; ++j) { const int i = i0 + j * stride; if (i < ntask) { u32x4 o; o.x = pk_bf16(a[j].x, a[j].y); o.y = pk_bf16(a[j].z, a[j].w); o.z = pk_bf16(b[j].x, b[j].y); o.w = pk_bf16(b[j].z, b[j].w);
                *(u32x4*)(KC + (size_t)i * 8) = o; } } } }
    LAS float* scr = (LAS float*)(C.lds + C.wid * 8704);
    const int gw = C.bid * 8 + C.wid, NGW = C.G * 8;
    {   TItem cur, nxt; TRegs ra, rb; int it = gw;
#define CV_ITEM(IT, T) ((IT) < 8 * 2048 ? ((T).W = C.in[3] + ((size_t)L * 8 + (IT) / 2048) * PAST * 1024, (T).N = 1024, (T).k0 = 64 * (((IT) % 2048) / 32), (T).n0 = 32 * ((IT) % 32), \
            (T).WT = WSP(bf16_t, WS_VTC) + (size_t)((IT) / 2048) * 1024 * PAST, (T).dst_row0 = (size_t)(T).n0, (T).Kd = PAST, (T).kscale = nullptr, true) : false)
        bool have = CV_ITEM(it, cur); if (have) tr_load(cur, ra, C.lane);
        while (have) { it += NGW; const bool hn = CV_ITEM(it, nxt); if (hn) tr_load(nxt, rb, C.lane);
            tr_finish(cur, ra, scr, C.lane); cur = nxt; ra = rb; have = hn; }
#undef CV_ITEM
    }
}

struct ChunkInfo { int base, Lc, mode; const float* hist; };
__device__ __forceinline__ ChunkInfo chunk_info(const Ctx& C, int L, int c) {
    ChunkInfo ci;
    if (c < 256) { ci.base = 64 * c; ci.Lc = 64; ci.mode = (c == 0) ? 1 : 0; ci.hist = nullptr; }
    else { const int b = c - 256; ci.base = SEQ + 16 * b; ci.Lc = 16; ci.mode = 2; ci.hist = C.in[4] + ((size_t)L * 8 + b) * 3 * CONVD; }
    return ci;
}
__device__ __forceinline__ void conv_t8(const bf16_t* XBC, const ChunkInfo& ci, const float* cw, const float* cbias, int col, int l0, float (&o0)[8], float (&o1)[8]) {
    float i0[11], i1[11];
#pragma unroll
    for (int i = 0; i < 11; ++i) { const int rr = l0 - 3 + i;
        if (rr >= 0 || ci.mode == 0) { const unsigned v = *(const unsigned*)(XBC + (size_t)(ci.base + rr) * 4096 + col); i0[i] = bf_lo(v); i1[i] = bf_hi(v); }
        else if (ci.mode == 1) { i0[i] = 0.f; i1[i] = 0.f; }
        else { const float* hp = ci.hist + (size_t)(3 + rr) * 4096 + col; i0[i] = hp[0]; i1[i] = hp[1]; } }
    float w0[4], w1[4];
#pragma unroll
    for (int j = 0; j < 4; ++j) { w0[j] = cw[j * 4096 + col]; w1[j] = cw[j * 4096 + col + 1]; }
    const float b0 = cbias[col], b1 = cbias[col + 1];
#pragma unroll
    for (int k = 0; k < 8; ++k) { float a0 = b0, a1 = b1;
#pragma unroll
        for (int j = 0; j < 4; ++j) { a0 += w0[j] * i0[k + j]; a1 += w1[j] * i1[k + j]; }
        o0[k] = silu_f(a0); o1[k] = silu_f(a1); }
}
__device__ __forceinline__ void conv_n8(const bf16_t* XBC, const ChunkInfo& ci, const float* cw, const float* cbias, int col, int l, float (&o)[8]) {
    { const f32x4 b0 = *(const f32x4*)(cbias + col), b1 = *(const f32x4*)(cbias + col + 4);
      o[0] = b0.x; o[1] = b0.y; o[2] = b0.z; o[3] = b0.w; o[4] = b1.x; o[5] = b1.y; o[6] = b1.z; o[7] = b1.w; }
#pragma unroll
    for (int j = 0; j < 4; ++j) { const int rr = l - 3 + j; float x[8];
        if (rr >= 0 || ci.mode == 0) { const u32x4 v = *(const u32x4*)(XBC + (size_t)(ci.base + rr) * 4096 + col);
            x[0] = bf_lo(v.x); x[1] = bf_hi(v.x); x[2] = bf_lo(v.y); x[3] = bf_hi(v.y); x[4] = bf_lo(v.z); x[5] = bf_hi(v.z); x[6] = bf_lo(v.w); x[7] = bf_hi(v.w); }
        else if (ci.mode == 1) {
#pragma unroll
            for (int q = 0; q < 8; ++q) x[q] = 0.f; }
        else { const float* hp = ci.hist + (size_t)(3 + rr) * 4096 + col; const f32x4 h0 = *(const f32x4*)hp, h1 = *(const f32x4*)(hp + 4);
            x[0] = h0.x; x[1] = h0.y; x[2] = h0.z; x[3] = h0.w; x[4] = h1.x; x[5] = h1.y; x[6] = h1.z; x[7] = h1.w; }
        const f32x4 wa = *(const f32x4*)(cw + j * 4096 + col), wb = *(const f32x4*)(cw + j * 4096 + col + 4);
        o[0] += wa.x * x[0]; o[1] += wa.y * x[1]; o[2] += wa.z * x[2]; o[3] += wa.w * x[3]; o[4] += wb.x * x[4]; o[5] += wb.y * x[5]; o[6] += wb.z * x[6]; o[7] += wb.w * x[7]; }
#pragma unroll
    for (int q = 0; q < 8; ++q) o[q] = silu_f(o[q]);
}
__device__ __forceinline__ void ssd_dt_acs(Ctx& C, int L, const ChunkInfo& ci, int c, int g, bool write_cdec) {
    if (C.wid < 4) { const int h = 4 * g + C.wid, l = C.lane;
        const float raw = WSP(const float, WS_DT)[(size_t)(ci.base + l) * 32 + h] + C.in[15][L * 32 + h];
        float dt = raw > 20.f ? raw : log1pf(expf(raw)); if (l >= ci.Lc) dt = 0.f;
        const float A = -expf(C.in[16][L * 32 + h]); float a = dt * A;
#pragma unroll
        for (int o = 1; o < 64; o <<= 1) { const float t = __shfl_up(a, o); if (l >= o) a += t; }
        ((LAS float*)(C.lds + SD_DT))[C.wid * 64 + l] = dt; ((LAS float*)(C.lds + SD_ACS))[C.wid * 64 + l] = a;
        if (write_cdec && l == 63) WSP(float, WS_CDEC)[c * 32 + h] = expf(a);
    }
}
__device__ __forceinline__ void st8_bf16(LAS unsigned char* p, const float (&o)[8]) {
    u32x4 w; w.x = pk_bf16(o[0], o[1]); w.y = pk_bf16(o[2], o[3]); w.z = pk_bf16(o[4], o[5]); w.w = pk_bf16(o[6], o[7]); *(LAS u32x4*)p = w;
}

__device__ __forceinline__ void conv_unit(Ctx& C, int L, int c, int slab) {
    const ChunkInfo ci = chunk_info(C, L, c);
    bf16_t* XBC = WSP(bf16_t, WS_XBC); const bf16_t* HIST = WSP(const bf16_t, WS_HIST);
    const float* cw = C.in[13] + (size_t)L * 4 * CONVD; const float* cbias = C.in[14] + (size_t)L * CONVD;
    const int col0 = slab * 512;
    {   u32x4 v[8];
#pragma unroll
        for (int k = 0; k < 8; ++k) { const int idx = C.tid + 512 * k; v[k] = *(const u32x4*)(XBC + (size_t)(ci.base + (idx >> 6)) * 4096 + col0 + (idx & 63) * 8); }
        if (C.tid < 192) { const int r = C.tid >> 6, c16 = C.tid & 63; u32x4 hv;
            if (ci.mode == 1) hv = (u32x4){0u, 0u, 0u, 0u};
            else if (ci.mode == 0) hv = *(const u32x4*)(HIST + ((size_t)(c - 1) * 3 + r) * 4096 + col0 + c16 * 8);
            else { const float* hp = ci.hist + (size_t)r * 4096 + col0 + c16 * 8; const f32x4 a = *(const f32x4*)hp, b = *(const f32x4*)(hp + 4);
                hv.x = pk_bf16(a.x, a.y); hv.y = pk_bf16(a.z, a.w); hv.z = pk_bf16(b.x, b.y); hv.w = pk_bf16(b.z, b.w); }
            *(LAS u32x4*)(C.lds + r * 1024 + c16 * 16) = hv; }
#pragma unroll
        for (int k = 0; k < 8; ++k) { const int idx = C.tid + 512 * k; *(LAS u32x4*)(C.lds + (3 + (idx >> 6)) * 1024 + (idx & 63) * 16) = v[k]; }
    }
    __syncthreads();
#pragma unroll 1
    for (int i = 0; i < 4; ++i) { const int task = C.tid + 512 * i, p = task & 255, lb = task >> 8, l0 = 8 * lb, col = col0 + 2 * p;
        float i0[11], i1[11];
#pragma unroll
        for (int k = 0; k < 11; ++k) { const unsigned v = *(const LAS unsigned*)(C.lds + (l0 + k) * 1024 + p * 4); i0[k] = bf_lo(v); i1[k] = bf_hi(v); }
        float w0[4], w1[4];
#pragma unroll
        for (int j = 0; j < 4; ++j) { const float2 w = *(const float2*)(cw + j * 4096 + col); w0[j] = w.x; w1[j] = w.y; }
        const float2 bb = *(const float2*)(cbias + col);
        float o0[8], o1[8];
#pragma unroll
        for (int k = 0; k < 8; ++k) { float a0 = bb.x, a1 = bb.y;
#pragma unroll
            for (int j = 0; j < 4; ++j) { a0 += w0[j] * i0[k + j]; a1 += w1[j] * i1[k + j]; }
            o0[k] = silu_f(a0); o1[k] = silu_f(a1); }
        if (slab < 6) {
            const int ch_ = (slab < 4) ? col : col - 2048;
            bf16_t* dst = ((slab < 4) ? WSP(bf16_t, WS_XTG) + (size_t)c * 2048 * 64 : WSP(bf16_t, WS_BTG) + (size_t)c * 1024 * 64) + ((((size_t)(ch_ >> 5)) * 4 + (lb >> 1)) * 64 + (lb & 1) * 32 + (ch_ & 31)) * 8;
            u32x4 w; w.x = pk_bf16(o0[0], o0[1]); w.y = pk_bf16(o0[2], o0[3]); w.z = pk_bf16(o0[4], o0[5]); w.w = pk_bf16(o0[6], o0[7]); *(u32x4*)dst = w;
            w.x = pk_bf16(o1[0], o1[1]); w.y = pk_bf16(o1[2], o1[3]); w.z = pk_bf16(o1[4], o1[5]); w.w = pk_bf16(o1[6], o1[7]); *(u32x4*)(dst + 8) = w;
        }
        if (slab >= 4) {
#pragma unroll
            for (int k = 0; k < 8; ++k) if (l0 + k < ci.Lc) *(unsigned*)(XBC + (size_t)(ci.base + l0 + k) * 4096 + col) = pk_bf16(o0[k], o1[k]);
        }
    }
    __syncthreads();
}

__device__ __forceinline__ void ssd_s1_wave(Ctx& C, int L, int c, int h) {
    const ChunkInfo ci = chunk_info(C, L, c);
    const int l = C.lane, q32 = C.lane & 31, hi = C.lane >> 5, g = h >> 2;
    const float raw = WSP(const float, WS_DT)[(size_t)(ci.base + l) * 32 + h] + C.in[15][L * 32 + h];
    float dt = raw > 20.f ? raw : log1pf(expf(raw)); if (l >= ci.Lc) dt = 0.f;
    const float A = -expf(C.in[16][L * 32 + h]); float a = dt * A;
#pragma unroll
    for (int o = 1; o < 64; o <<= 1) { const float t = __shfl_up(a, o); if (l >= o) a += t; }
    WSP(float, WS_DTA)[((size_t)c * 32 + h) * 64 + l] = dt; WSP(float, WS_ACSG)[((size_t)c * 32 + h) * 64 + l] = a;
    const float aend = __shfl(a, 63);
    const float w = dt * fexp(aend - a);
    if (l == 63) WSP(float, WS_CDEC)[c * 32 + h] = expf(a);
    const bf16_t* xt = WSP(const bf16_t, WS_XTG) + (size_t)c * 2048 * 64 + ((size_t)(2 * h) * 4 * 64 + C.lane) * 8;
    const bf16_t* bt = WSP(const bf16_t, WS_BTG) + (size_t)c * 1024 * 64 + ((size_t)(4 * g) * 4 * 64 + C.lane) * 8;
    f32x16 acc[2][4];
#pragma unroll
    for (int ph = 0; ph < 2; ++ph)
#pragma unroll
        for (int nt = 0; nt < 4; ++nt) acc[ph][nt] = (f32x16){};
#pragma unroll
    for (int ks = 0; ks < 4; ++ks) {
        float wv[8];
#pragma unroll
        for (int j = 0; j < 8; ++j) wv[j] = __shfl(w, 16 * ks + 8 * hi + j);
        bf16x8 bfr[2];
#pragma unroll
        for (int ph = 0; ph < 2; ++ph) { const u32x4 r = *(const u32x4*)(xt + (ph * 4 + ks) * 512);
            u32x4 o; o.x = pk_bf16(bf_lo(r.x) * wv[0], bf_hi(r.x) * wv[1]); o.y = pk_bf16(bf_lo(r.y) * wv[2], bf_hi(r.y) * wv[3]);
            o.z = pk_bf16(bf_lo(r.z) * wv[4], bf_hi(r.z) * wv[5]); o.w = pk_bf16(bf_lo(r.w) * wv[6], bf_hi(r.w) * wv[7]); bfr[ph] = __builtin_bit_cast(bf16x8, o); }
#pragma unroll
        for (int nt = 0; nt < 4; ++nt) { const bf16x8 afr = *(const bf16x8*)(bt + (nt * 4 + ks) * 512);
            acc[0][nt] = MFMA32(afr, bfr[0], acc[0][nt]); acc[1][nt] = MFMA32(afr, bfr[1], acc[1][nt]); }
    }
#pragma unroll
    for (int ph = 0; ph < 2; ++ph) { bf16_t* dst = WSP(bf16_t, WS_CS) + ((size_t)c * 32 + h) * 8192;
#pragma unroll
        for (int nt = 0; nt < 4; ++nt)
#pragma unroll
            for (int rq = 0; rq < 4; ++rq) { u32x2 o; o.x = pk_bf16(acc[ph][nt][4 * rq], acc[ph][nt][4 * rq + 1]); o.y = pk_bf16(acc[ph][nt][4 * rq + 2], acc[ph][nt][4 * rq + 3]);
                *(u32x2*)(dst + ((ph * 8 + 2 * nt + (rq >> 1)) * 64 + (rq & 1) * 32 + q32) * 8 + 4 * hi) = o; } }
}

__device__ __forceinline__ void ssd_s1_unit(Ctx& C, int L, int c, int g) {
    const ChunkInfo ci = chunk_info(C, L, c);
    const bf16_t* XBC = WSP(const bf16_t, WS_XBC); const float* cw = C.in[13] + (size_t)L * 4 * CONVD; const float* cbias = C.in[14] + (size_t)L * CONVD;
    ssd_dt_acs(C, L, ci, c, g, true);
    __syncthreads();
    {
        const int cp = C.tid & 63, lb = C.tid >> 6; float o0[8], o1[8];
        conv_t8(XBC, ci, cw, cbias, 2048 + g * 128 + 2 * cp, 8 * lb, o0, o1);
        st8_bf16(C.lds + SD_BT + (2 * cp) * 144 + lb * 16, o0); st8_bf16(C.lds + SD_BT + (2 * cp + 1) * 144 + lb * 16, o1);
    }
#pragma unroll 1
    for (int i = 0; i < 2; ++i) {
        const int task = C.tid + 512 * i, cp = task & 127, lb = task >> 7, hh = cp >> 5; float o0[8], o1[8];
        conv_t8(XBC, ci, cw, cbias, g * 256 + 2 * cp, 8 * lb, o0, o1);
        const LAS float* dts = (const LAS float*)(C.lds + SD_DT) + hh * 64 + 8 * lb; const LAS float* acs = (const LAS float*)(C.lds + SD_ACS) + hh * 64;
        const float aend = acs[63];
#pragma unroll
        for (int k = 0; k < 8; ++k) { const float w = dts[k] * fexp(aend - acs[8 * lb + k]); o0[k] *= w; o1[k] *= w; }
        st8_bf16(C.lds + SD_XT + (2 * cp) * 144 + lb * 16, o0); st8_bf16(C.lds + SD_XT + (2 * cp + 1) * 144 + lb * 16, o1);
    }
    __syncthreads();
    {   const int hh = C.wid >> 1, ph = C.wid & 1, q32 = C.lane & 31, hi = C.lane >> 5, h = 4 * g + hh;
        f32x16 acc[4];
#pragma unroll
        for (int nt = 0; nt < 4; ++nt) acc[nt] = (f32x16){};
#pragma unroll
        for (int ks = 0; ks < 4; ++ks) { const bf16x8 bfr = *(const LAS bf16x8*)(C.lds + SD_XT + (hh * 64 + ph * 32 + q32) * 144 + ks * 32 + hi * 16);
#pragma unroll
            for (int nt = 0; nt < 4; ++nt) { const bf16x8 afr = *(const LAS bf16x8*)(C.lds + SD_BT + (nt * 32 + q32) * 144 + ks * 32 + hi * 16); acc[nt] = MFMA32(afr, bfr, acc[nt]); } }
        bf16_t* dst = WSP(bf16_t, WS_CS) + (((size_t)c * 32 + h) * 64 + ph * 32 + q32) * 128;
#pragma unroll
        for (int nt = 0; nt < 4; ++nt)
#pragma unroll
            for (int rq = 0; rq < 4; ++rq) { u32x2 w; w.x = pk_bf16(acc[nt][4 * rq], acc[nt][4 * rq + 1]); w.y = pk_bf16(acc[nt][4 * rq + 2], acc[nt][4 * rq + 3]);
                *(u32x2*)(dst + 32 * nt + 8 * rq + 4 * hi) = w; }
    }
    __syncthreads();
}

__device__ __forceinline__ void ssd_scan(Ctx& C, int L) {
    bf16_t* CS = WSP(bf16_t, WS_CS); const float* CDEC = WSP(const float, WS_CDEC);
    for (int gid = C.bid * 512 + C.tid; gid < (int)(HPN / 2); gid += C.G * 512) {
        const int h = gid >> 12; float s0 = 0.f, s1 = 0.f; unsigned* p = (unsigned*)CS + gid;
#pragma unroll 1
        for (int c0 = 0; c0 < 256; c0 += 16) { unsigned v[16]; float d[16];
#pragma unroll
            for (int j = 0; j < 16; ++j) { v[j] = p[(size_t)(c0 + j) * (HPN / 2)]; d[j] = CDEC[(c0 + j) * 32 + h]; }
#pragma unroll
            for (int j = 0; j < 16; ++j) { p[(size_t)(c0 + j) * (HPN / 2)] = pk_bf16(s0, s1); s0 = d[j] * s0 + bf_lo(v[j]); s1 = d[j] * s1 + bf_hi(v[j]); } }
        const int e_ = 2 * (gid & 4095), lane_ = (e_ >> 3) & 63;
        const size_t nat = (size_t)h * 8192 + (size_t)(32 * (e_ >> 12) + (lane_ & 31)) * 128 + 16 * ((e_ >> 9) & 7) + 8 * (lane_ >> 5) + (e_ & 7);
        float* o = C.out + O_SP + (size_t)L * HPN + nat; o[0] = s0; o[1] = s1;
#pragma unroll
        for (int b = 0; b < 8; ++b) { const float* ip = C.in[5] + ((size_t)L * 8 + b) * HPN + nat; const float i0 = ip[0], i1 = ip[1];
            unsigned* q = p + (size_t)(256 + b) * (HPN / 2); const unsigned v = *q; const float d = CDEC[(256 + b) * 32 + h];
            *q = pk_bf16(i0, i1);
            float* os = C.out + O_SS + ((size_t)L * 8 + b) * HPN + nat; os[0] = d * i0 + bf_lo(v); os[1] = d * i1 + bf_hi(v); }
    }
}

__device__ __forceinline__ void ssd_s3_unit(Ctx& C, int L, int c, int g) {
    const ChunkInfo ci = chunk_info(C, L, c);
    const bf16_t* XBC = WSP(const bf16_t, WS_XBC); const float* cw = C.in[13] + (size_t)L * 4 * CONVD; const float* cbias = C.in[14] + (size_t)L * CONVD;
    const int hh = C.wid >> 1, ph = C.wid & 1, q32 = C.lane & 31, hi = C.lane >> 5, h = 4 * g + hh;
    const int chb = h * 64 + ph * 32 + 4 * hi;
    bf16x8 pf[8], xf[3][2]; u32x2 zf[2][4];
    {   const bf16_t* prev = WSP(const bf16_t, WS_CS) + ((size_t)c * 32 + h) * 8192 + ((size_t)(ph * 8) * 64 + C.lane) * 8;
#pragma unroll
        for (int ks = 0; ks < 8; ++ks) pf[ks] = *(const bf16x8*)(prev + ks * 512);
#pragma unroll
        for (int tile = 0; tile < 3; ++tile)
#pragma unroll
            for (int sp = 0; sp < 2; ++sp) xf[tile][sp] = *(const bf16x8*)(WSP(const bf16_t, WS_XTG) + (size_t)c * 2048 * 64 + ((size_t)((2 * h + ph) * 4 + 2 * (tile >> 1) + sp) * 64 + C.lane) * 8);
#pragma unroll
        for (int lh = 0; lh < 2; ++lh)
#pragma unroll
            for (int rq = 0; rq < 4; ++rq) zf[lh][rq] = *(const u32x2*)(WSP(const bf16_t, WS_Z) + (size_t)(ci.base + lh * 32 + q32) * 2048 + chb + 8 * rq);
    }
    if (C.tid < 256) { const size_t o = ((size_t)c * 32 + 4 * g + (C.tid >> 6)) * 64 + (C.tid & 63); const float dtv = WSP(const float, WS_DTA)[o], av = WSP(const float, WS_ACSG)[o];
        ((LAS float*)(C.lds + SD_DT))[C.tid] = dtv; ((LAS float*)(C.lds + SD_ACS))[C.tid] = av; }
#pragma unroll
    for (int i = 0; i < 2; ++i) {
        const int task = C.tid + 512 * i, c8 = task & 15, l = task >> 4;
        const u32x4 vc = *(const u32x4*)(XBC + (size_t)(ci.base + l) * 4096 + 3072 + g * 128 + c8 * 8), vb = *(const u32x4*)(XBC + (size_t)(ci.base + l) * 4096 + 2048 + g * 128 + c8 * 8);
        *(LAS u32x4*)(C.lds + SD_CM + l * 272 + c8 * 16) = vc; *(LAS u32x4*)(C.lds + SD_BM + ((l & 32) | sig5(l & 31)) * 272 + c8 * 16) = vb;
    }
    __syncthreads();
    const LAS float* dts = (const LAS float*)(C.lds + SD_DT) + hh * 64; const LAS float* acs = (const LAS float*)(C.lds + SD_ACS) + hh * 64;
    f32x16 acc[2]; acc[0] = (f32x16){}; acc[1] = (f32x16){};
    {
#pragma unroll
        for (int ks = 0; ks < 8; ++ks) { const bf16x8 afr = pf[ks];
#pragma unroll
            for (int lh = 0; lh < 2; ++lh) { const bf16x8 bfr = *(const LAS bf16x8*)(C.lds + SD_CM + (lh * 32 + q32) * 272 + ks * 32 + hi * 16); acc[lh] = MFMA32(afr, bfr, acc[lh]); } }
#pragma unroll
        for (int lh = 0; lh < 2; ++lh) { const float e = fexp(acs[lh * 32 + q32]);
#pragma unroll
            for (int r = 0; r < 16; ++r) acc[lh][r] *= e; }
    }
    const float Dh = C.in[17][L * 32 + h];
#pragma unroll
    for (int tile = 0; tile < 3; ++tile) {
        const int sh = tile >> 1, lh = (tile + 1) >> 1;
        f32x16 T = (f32x16){};
#pragma unroll
        for (int ks = 0; ks < 8; ++ks) { const bf16x8 afr = *(const LAS bf16x8*)(C.lds + SD_BM + (sh * 32 + q32) * 272 + ks * 32 + hi * 16);
            const bf16x8 bfr = *(const LAS bf16x8*)(C.lds + SD_CM + (lh * 32 + q32) * 272 + ks * 32 + hi * 16); T = MFMA32(afr, bfr, T); }
        const int l = lh * 32 + q32; const float al = acs[l];
        unsigned pk[8];
#pragma unroll
        for (int r2 = 0; r2 < 8; ++r2) { float mv[2];
#pragma unroll
            for (int q = 0; q < 2; ++q) { const int r = 2 * r2 + q; const int s = sh * 32 + 16 * (r >> 3) + 8 * hi + (r & 7);
                float w = 0.f; if (s <= l) w = fexp(al - acs[s]) * dts[s];
                mv[q] = T[r] * w + ((s == l) ? Dh : 0.f); }
            pk[r2] = pk_bf16(mv[0], mv[1]); }
#pragma unroll
        for (int sp = 0; sp < 2; ++sp) { const bf16x8 afr = xf[tile][sp];
            const u32x4 bw = {pk[4 * sp], pk[4 * sp + 1], pk[4 * sp + 2], pk[4 * sp + 3]};
            acc[lh] = MFMA32(afr, __builtin_bit_cast(bf16x8, bw), acc[lh]); }
    }
#pragma unroll
    for (int lh = 0; lh < 2; ++lh) { const int l = lh * 32 + q32; float ss = 0.f;
#pragma unroll
        for (int rq = 0; rq < 4; ++rq) { const u32x2 z = zf[lh][rq];
            acc[lh][4 * rq + 0] *= silu_f(bf_lo(z.x)); acc[lh][4 * rq + 1] *= silu_f(bf_hi(z.x)); acc[lh][4 * rq + 2] *= silu_f(bf_lo(z.y)); acc[lh][4 * rq + 3] *= silu_f(bf_hi(z.y));
#pragma unroll
            for (int q = 0; q < 4; ++q) ss += acc[lh][4 * rq + q] * acc[lh][4 * rq + q]; }
        ss += __shfl_xor(ss, 32);
        if (hi == 0) ((LAS float*)(C.lds + SD_RS))[C.wid * 64 + l] = ss; }
    __syncthreads();
    const float* nw = C.in[18] + (size_t)L * DIN; bf16_t* Y = WSP(bf16_t, WS_YSSD);
#pragma unroll
    for (int lh = 0; lh < 2; ++lh) { const int l = lh * 32 + q32; float tot = 0.f;
#pragma unroll
        for (int w = 0; w < 8; ++w) tot += ((const LAS float*)(C.lds + SD_RS))[w * 64 + l];
        const float rs = 1.0f / sqrtf(tot * (1.0f / 256.0f) + 1e-5f);
        if (l < ci.Lc) {
#pragma unroll
            for (int rq = 0; rq < 4; ++rq) { const f32x4 wv = *(const f32x4*)(nw + chb + 8 * rq);
                u32x2 o; o.x = pk_bf16(acc[lh][4 * rq] * rs * wv.x, acc[lh][4 * rq + 1] * rs * wv.y); o.y = pk_bf16(acc[lh][4 * rq + 2] * rs * wv.z, acc[lh][4 * rq + 3] * rs * wv.w);
                *(u32x2*)(Y + (size_t)(ci.base + l) * 2048 + chb + 8 * rq) = o; } } }
    __syncthreads();
}

struct AttnUnit { int qrow0, h, NT, ncache, krow0, kvalid, b, nt_base, sample; };
constexpr int AT_ST = 32768;
__device__ __forceinline__ void attn_unit(Ctx& C, int L, const AttnUnit u, const int rep) {
    const int mp = C.wid >> 2, wq = C.wid & 3, q32 = C.lane & 31, hi = C.lane >> 5;
    const bf16_t* Qb = WSP(const bf16_t, WS_Q); const bf16_t* Kb = WSP(const bf16_t, WS_K); const bf16_t* VT = WSP(const bf16_t, WS_VT);
    const bf16_t* KC = WSP(const bf16_t, WS_KC); const bf16_t* VTC = WSP(const bf16_t, WS_VTC);
    float lam; const float lam_init = (L == 0) ? 0.2f : 0.35550906f;
    { const float s1 = wave_sum(C.in[8][L * 64 + C.lane] * C.in[9][L * 64 + C.lane]), s2 = wave_sum(C.in[10][L * 64 + C.lane] * C.in[11][L * 64 + C.lane]);
      lam = expf(s1) - expf(s2) + lam_init; }
    const bool active = u.sample ? (wq == 0) : true;
    const int ntw = u.sample ? u.NT : (u.nt_base + (wq >> 1));
    bf16x8 qf[4];
    { const bf16_t* qp = Qb + (size_t)(u.qrow0 + 32 * wq + q32) * 1024 + u.h * 128 + mp * 64 + hi * 8;
#pragma unroll
      for (int ds = 0; ds < 4; ++ds) qf[ds] = *(const bf16x8*)(qp + ds * 16); }
    asm volatile("" : "+v"(qf[0]), "+v"(qf[1]), "+v"(qf[2]), "+v"(qf[3]));
    f32x16 O[4];
#pragma unroll
    for (int eb = 0; eb < 4; ++eb) O[eb] = (f32x16){};
    float m_run = 0.f, l_run = 0.f; f32x16 negm = (f32x16){};
    int koff[2], ve[2], vc[2];
#pragma unroll
    for (int i = 0; i < 2; ++i) { const int j = C.wid + 8 * i;
        const int r = 4 * j + (C.lane >> 4), c = (C.lane & 15) ^ (r & 15); koff[i] = ((r & 32) | sig5(r & 31)) * 1024 + c * 8;
        const int e = 8 * j + (C.lane >> 3), cv = (C.lane & 7) ^ ((e >> 1) & 7); ve[i] = e; vc[i] = cv * 8; }
    int kso[4], vso[4];
#pragma unroll
    for (int ds = 0; ds < 4; ++ds) { kso[ds] = ((mp * 8 + ds * 2 + hi) ^ (q32 & 15)) * 16; vso[ds] = ((ds * 2 + hi) ^ ((q32 >> 1) & 7)) * 16; }
#define AT_ISSUE(t, st) do { const int t_ = (t); \
        const bf16_t* kp_ = (t_ < u.ncache) ? KC + ((size_t)u.b * PAST + 64 * t_) * 1024 + u.h * 128 : Kb + ((size_t)u.krow0 + 64 * (t_ - u.ncache)) * 1024 + u.h * 128; \
        const bf16_t* vp_; int vs_; \
        if (t_ < u.ncache) { vp_ = VTC + ((size_t)u.b * 1024 + u.h * 128) * PAST + 64 * t_; vs_ = PAST; } else { vp_ = VT + (size_t)(u.h * 128) * MT + u.krow0 + 64 * (t_ - u.ncache); vs_ = MT; } \
        if (t_ < u.ncache) {   \
        _Pragma("unroll") for (int i_ = 0; i_ < 2; ++i_) { \
            __builtin_amdgcn_global_load_lds((const unsigned*)(kp_ + koff[i_]), (LAS unsigned*)(C.lds + (st) * AT_ST + (C.wid + 8 * i_) * 1024), 16, 0, 2); \
            __builtin_amdgcn_global_load_lds((const unsigned*)(vp_ + (size_t)ve[i_] * vs_ + vc[i_]), (LAS unsigned*)(C.lds + (st) * AT_ST + 16384 + (C.wid + 8 * i_) * 1024), 16, 0, 2); } } else { \
        _Pragma("unroll") for (int i_ = 0; i_ < 2; ++i_) { \
            __builtin_amdgcn_global_load_lds((const unsigned*)(kp_ + koff[i_]), (LAS unsigned*)(C.lds + (st) * AT_ST + (C.wid + 8 * i_) * 1024), 16, 0, 0); \
            __builtin_amdgcn_global_load_lds((const unsigned*)(vp_ + (size_t)ve[i_] * vs_ + vc[i_]), (LAS unsigned*)(C.lds + (st) * AT_ST + 16384 + (C.wid + 8 * i_) * 1024), 16, 0, 0); } } } while (0)
    AT_ISSUE(0, 0); AT_ISSUE(1, 1);
    int st_cur = 0, st_nxt2 = 2;
#pragma unroll 1
    for (int t = 0; t < u.NT; ++t) {
        if (t + 1 < u.NT) asm volatile("s_waitcnt vmcnt(4)\n\ts_barrier" ::: "memory");
        else asm volatile("s_waitcnt vmcnt(0)\n\ts_barrier" ::: "memory");
        if (t + 2 < u.NT) AT_ISSUE(t + 2, st_nxt2);
        if (active && t < ntw) {
            const LAS unsigned char* kb = C.lds + st_cur * AT_ST + q32 * 256;
            const LAS unsigned char* vb = C.lds + st_cur * AT_ST + 16384 + q32 * 128;
            bf16x8 ka[8];
#pragma unroll
            for (int ds = 0; ds < 4; ++ds) { ka[ds] = *(const LAS bf16x8*)(kb + kso[ds]); ka[4 + ds] = *(const LAS bf16x8*)(kb + 8192 + kso[ds]); }
            f32x16 S0 = MFMA32(ka[0], qf[0], negm);
#pragma unroll
            for (int ds = 1; ds < 4; ++ds) S0 = MFMA32(ka[ds], qf[ds], S0);
            f32x16 S1 = MFMA32(ka[4], qf[0], negm);
#pragma unroll
            for (int ds = 1; ds < 4; ++ds) S1 = MFMA32(ka[4 + ds], qf[ds], S1);
            bf16x8 va[4];
#pragma unroll
            for (int eb = 0; eb < 4; ++eb) va[eb] = *(const LAS bf16x8*)(vb + eb * 4096 + vso[0]);
            float mx = max3f(S0[0], S0[1], S0[2]);
#pragma unroll
            for (int r = 3; r < 15; r += 2) mx = max3f(mx, S0[r], S0[r + 1]);
            mx = max3f(mx, S0[15], S0[15]);
#pragma unroll
            for (int r = 0; r < 16; ++r) S0[r] = fexp2(S0[r]);
            float mx1 = max3f(S1[0], S1[1], S1[2]);
#pragma unroll
            for (int r = 3; r < 15; r += 2) mx1 = max3f(mx1, S1[r], S1[r + 1]);
            mx = max3f(mx, mx1, S1[15]);
            mx = max3f(mx, __shfl_xor(mx, 32), mx);
            if (t == 0 || __any(mx > 8.0f)) {
                const float dl = (t == 0) ? mx : fmaxf(mx, 0.f);
                m_run += dl;
                const float f = fexp2(-dl); l_run *= f;
#pragma unroll
                for (int r = 0; r < 16; ++r) { S0[r] *= f; S1[r] -= dl; negm[r] = -m_run; }
#pragma unroll
                for (int eb = 0; eb < 4; ++eb)
#pragma unroll
                    for (int r = 0; r < 16; ++r) O[eb][r] *= f;
            }
            if (t == u.NT - 1 && u.kvalid < 64) {
#pragma unroll
                for (int r = 0; r < 16; ++r) { const int kv = 16 * (r >> 3) + 8 * hi + (r & 7); if (kv >= u.kvalid) S0[r] = 0.f; if (kv + 32 >= u.kvalid) S1[r] = -INFINITY; } }
            u32x4 pk[4];
#pragma unroll
            for (int sp = 0; sp < 2; ++sp)
                pk[sp] = (u32x4){pk_bf16(S0[8 * sp], S0[8 * sp + 1]), pk_bf16(S0[8 * sp + 2], S0[8 * sp + 3]), pk_bf16(S0[8 * sp + 4], S0[8 * sp + 5]), pk_bf16(S0[8 * sp + 6], S0[8 * sp + 7])};
#pragma unroll
            for (int eb = 0; eb < 4; ++eb) O[eb] = MFMA32(va[eb], __builtin_bit_cast(bf16x8, pk[0]), O[eb]);
#pragma unroll
            for (int eb = 0; eb < 4; ++eb) va[eb] = *(const LAS bf16x8*)(vb + eb * 4096 + vso[1]);
#pragma unroll
            for (int r = 0; r < 16; ++r) S1[r] = fexp2(S1[r]);
#pragma unroll
            for (int eb = 0; eb < 4; ++eb) O[eb] = MFMA32(va[eb], __builtin_bit_cast(bf16x8, pk[1]), O[eb]);
#pragma unroll
            for (int eb = 0; eb < 4; ++eb) va[eb] = *(const LAS bf16x8*)(vb + eb * 4096 + vso[2]);
#pragma unroll
            for (int sp = 0; sp < 2; ++sp)
                pk[2 + sp] = (u32x4){pk_bf16(S1[8 * sp], S1[8 * sp + 1]), pk_bf16(S1[8 * sp + 2], S1[8 * sp + 3]), pk_bf16(S1[8 * sp + 4], S1[8 * sp + 5]), pk_bf16(S1[8 * sp + 6], S1[8 * sp + 7])};
#pragma unroll
            for (int eb = 0; eb < 4; ++eb) O[eb] = MFMA32(va[eb], __builtin_bit_cast(bf16x8, pk[2]), O[eb]);
#pragma unroll
            for (int eb = 0; eb < 4; ++eb) va[eb] = *(const LAS bf16x8*)(vb + eb * 4096 + vso[3]);
            float sum = 0.f, sum2 = 0.f;
#pragma unroll
            for (int r = 0; r < 16; ++r) { sum += S0[r]; sum2 += S1[r]; }
            l_run += sum + sum2;
#pragma unroll
            for (int eb = 0; eb < 4; ++eb) O[eb] = MFMA32(va[eb], __builtin_bit_cast(bf16x8, pk[3]), O[eb]);
#if MK_SGB
#pragma unroll
            for (int i_ = 0; i_ < 16; ++i_) { __builtin_amdgcn_sched_group_barrier(0x008, 1, 0); __builtin_amdgcn_sched_group_barrier(0x100, 1, 0); __builtin_amdgcn_sched_group_barrier(0x002, 5, 0); }
#endif
        }
        st_cur = (st_cur == 2) ? 0 : st_cur + 1; st_nxt2 = (st_nxt2 == 2) ? 0 : st_nxt2 + 1;
    }
#undef AT_ISSUE
    asm volatile("s_waitcnt lgkmcnt(0)\n\ts_barrier" ::: "memory");
    const float ltot = l_run + __shfl_xor(l_run, 32); const float inv = 1.0f / ltot;
    LAS float* EX = (LAS float*)C.lds + wq * 4096;
    if (mp == 1 && active) {
#pragma unroll
        for (int eb = 0; eb < 4; ++eb)
#pragma unroll
            for (int r = 0; r < 16; ++r) EX[(32 * eb + 8 * (r >> 2) + 4 * hi + (r & 3)) * 32 + q32] = O[eb][r] * inv;
    }
    __syncthreads();
    if (mp == 0 && active) {
        float ss = 0.f;
#pragma unroll
        for (int eb = 0; eb < 4; ++eb)
#pragma unroll
            for (int r = 0; r < 16; ++r) { const float d = O[eb][r] * inv - lam * EX[(32 * eb + 8 * (r >> 2) + 4 * hi + (r & 3)) * 32 + q32]; O[eb][r] = d; ss += d * d; }
        ss += __shfl_xor(ss, 32);
        const float rs = (1.0f / sqrtf(ss * (1.0f / 128.0f) + 1e-5f)) * (1.0f - lam_init);
        const float* sw = C.in[12] + L * 128;
        if (!u.sample || q32 < 16) {
            bf16_t* dst = WSP(bf16_t, WS_ATT) + (size_t)(u.qrow0 + 32 * wq + q32) * 1024 + u.h * 128 + 4 * hi;
#pragma unroll
            for (int eb = 0; eb < 4; ++eb)
#pragma unroll
                for (int rq = 0; rq < 4; ++rq) { const f32x4 wv = *(const f32x4*)(sw + 32 * eb + 8 * rq + 4 * hi);
                    u32x2 o; o.x = pk_bf16(O[eb][4 * rq] * rs * wv.x, O[eb][4 * rq + 1] * rs * wv.y); o.y = pk_bf16(O[eb][4 * rq + 2] * rs * wv.z, O[eb][4 * rq + 3] * rs * wv.w);
                    *(u32x2*)(dst + 32 * eb + 8 * rq) = o; }
        }
    }
    __syncthreads();
}

struct OneUnit { int pm, pn;
    __device__ __forceinline__ bool next(int i, pg8::Unit& u) const { if (i) return false; u.pm = pm; u.pn = pn; return true; }
    __device__ __forceinline__ void a_ready(const pg8::Unit&) const {}
    __device__ __forceinline__ void done(const pg8::Unit&) const {} };
__device__ __forceinline__ void flag_publish(unsigned* cnt, int tid) {
    asm volatile("s_waitcnt vmcnt(0)" ::: "memory"); __syncthreads();
    if (tid == 0) { __builtin_amdgcn_fence(__ATOMIC_RELEASE, "agent"); asm volatile("s_waitcnt vmcnt(0)" ::: "memory"); __hip_atomic_fetch_add(cnt, 1u, __ATOMIC_RELAXED, __HIP_MEMORY_SCOPE_AGENT); }
}
__device__ __forceinline__ void flag_wait(unsigned* cnt, unsigned target, int tid) {
    if (tid == 0) { unsigned sp = 0; while (__hip_atomic_load(cnt, __ATOMIC_RELAXED, __HIP_MEMORY_SCOPE_AGENT) < target) { __builtin_amdgcn_s_sleep(16); if (++sp > (1u << 24)) break; } }
    __syncthreads();
    __builtin_amdgcn_fence(__ATOMIC_ACQUIRE, "agent"); asm volatile("s_waitcnt vmcnt(0)" ::: "memory");
    __syncthreads();
}
__device__ __forceinline__ void chain_item(Ctx& C, int L, int kind, int idx) {
    unsigned* cnt = WSP(unsigned, WS_CTL) + 64 * (20 + 4 * L);
    if (kind == 0) {
        flag_wait(cnt, 128u, C.tid);
        OneUnit S{0, idx};
        { pg8::Gemm g{WSP(const bf16_t, WS_ATT) + (size_t)SEQ * 1024, WSP(const bf16_t, WS_WBA + L * SZ_WBA), 256, 1024, 1024}; EpiBrA E{WSP(const bf16_t, WS_G), WSP(float, WS_Z), SEQ};
          pg8::gemm_phase<EpiBrA, OneUnit, true, true>(C.lds, g, S, E); }
        { pg8::Gemm g{WSP(const bf16_t, WS_YSSD) + (size_t)SEQ * 2048, WSP(const bf16_t, WS_WBS + L * SZ_WBS), 256, 1024, 2048}; EpiBrB E{WSP(const bf16_t, WS_G), WSP(const float, WS_Z), WSP(bf16_t, WS_Q), SEQ};
          pg8::gemm_phase<EpiBrB, OneUnit, true, true>(C.lds, g, S, E); }
        flag_publish(cnt + 64, C.tid);
    } else if (kind == 1) {
        flag_wait(cnt + 64, 4u, C.tid);
        OneUnit S{0, idx};
        pg8::Gemm g{WSP(const bf16_t, WS_Q) + (size_t)SEQ * 1024, WSP(const bf16_t, WS_WOUT + L * SZ_WOUT), 256, 1024, 1024};
        EpiRes E{WSP(float, WS_X), WSP(bf16_t, WS_XB), WSP(float, WS_PART) + (size_t)(2 * L + 1) * MT, SEQ};
        pg8::gemm_phase<EpiRes, OneUnit, true, true>(C.lds, g, S, E);
        flag_publish(cnt + 128, C.tid);
    } else if (kind == 2) {
        flag_wait(cnt + 128, 4u, C.tid);
        OneUnit S{0, idx};
        pg8::Gemm g{WSP(const bf16_t, WS_XB) + (size_t)SEQ * 1024, WSP(const bf16_t, WS_WGU + L * SZ_WGU), 256, 5632, 1024};
        EpiGU E{WSP(const float, WS_PART) + (size_t)(2 * L + 1) * MT, WSP(bf16_t, WS_ACTS), SEQ, SEQ};
        pg8::gemm_phase<EpiGU, OneUnit, true, true>(C.lds, g, S, E);
        flag_publish(cnt + 192, C.tid);
    } else {
        flag_wait(cnt + 192, 22u, C.tid);
        OneUnit S{0, idx};
        pg8::Gemm g{WSP(const bf16_t, WS_ACTS), WSP(const bf16_t, WS_WD + L * SZ_WD), 256, 1024, DFF};
        EpiRes E{WSP(float, WS_X), WSP(bf16_t, WS_XB), WSP(float, WS_PART) + (size_t)(2 * L + 2) * MT, SEQ};
        pg8::gemm_phase<EpiRes, OneUnit, true, true>(C.lds, g, S, E);
    }
    __syncthreads();
}

__device__ __forceinline__ void phase_mix(Ctx& C, int L, int rep) {
    unsigned* counter = WSP(unsigned, WS_CTL) + 64 * (1 + L + 4 * rep);
    unsigned* cntA = WSP(unsigned, WS_CTL) + 64 * (20 + 4 * L);
    volatile LAS int* slot = (volatile LAS int*)(C.lds + LDS_CTL);
    constexpr int N_SMP = 64, N_S3S = 64, N_MID = 1024 + 34, N_S3 = 2048, N_ALL = N_SMP + N_S3S + N_MID + N_S3;
    for (;;) {
        __syncthreads();
        if (C.tid == 0) slot[0] = (int)atomicAdd(counter, 1u);
        __syncthreads();
        const int item = slot[0];
        if (item >= N_ALL) break;
        { int t_ = threadIdx.x; asm volatile("" : "+v"(t_)); C.tid = t_; C.lane = t_ & 63; C.wid = __builtin_amdgcn_readfirstlane(t_ >> 6); }
        if (item < N_SMP) { AttnUnit u; u.sample = 1; u.b = item >> 3; u.h = item & 7; u.qrow0 = SEQ + 16 * u.b; u.NT = 65; u.ncache = 64; u.krow0 = SEQ + 16 * u.b; u.kvalid = 16; u.nt_base = 65;
            attn_unit(C, L, u, rep); flag_publish(cntA, C.tid); }
        else if (item < N_SMP + N_S3S) { const int j = 2048 + (item - N_SMP); ssd_s3_unit(C, L, j >> 3, j & 7); flag_publish(cntA, C.tid); }
        else if (item < N_SMP + N_S3S + N_MID) { const int mi = item - N_SMP - N_S3S; int j = -1, kind = -1, idx = 0;
            if (mi < 400) j = mi; else if (mi < 404) { kind = 0; idx = mi - 400; } else if (mi < 560) j = mi - 4; else if (mi < 564) { kind = 1; idx = mi - 560; }
            else if (mi < 720) j = mi - 8; else if (mi < 742) { kind = 2; idx = mi - 720; } else if (mi < 880) j = mi - 30; else if (mi < 884) { kind = 3; idx = mi - 880; } else j = mi - 34;
            if (kind >= 0) chain_item(C, L, kind, idx);
            else {
                __syncthreads();
                if (C.tid == 0) { unsigned* hc = WSP(unsigned, WS_CTL) + 64 * (40 + 8 * L); int hsel = (int)(my_xcc_id() & 7u), rsel = -1;
                    for (int k = 0; k < 8; ++k) { const int hh_ = (hsel + k) & 7; if (__hip_atomic_load(hc + 64 * hh_, __ATOMIC_RELAXED, __HIP_MEMORY_SCOPE_AGENT) < 128u) { const unsigned r_ = atomicAdd(hc + 64 * hh_, 1u); if (r_ < 128u) { hsel = hh_; rsel = (int)r_; break; } } }
                    slot[1] = hsel; slot[2] = rsel; }
                __syncthreads();
                const int hsel = slot[1], rsel = slot[2];
                if (rsel >= 0) { const int qb = 127 - rsel; j = hsel; AttnUnit u; u.sample = 0; u.b = 0; u.h = j & 7; u.qrow0 = 128 * qb; u.NT = 2 * qb + 2; u.ncache = 0; u.krow0 = 0; u.kvalid = 64; u.nt_base = 2 * qb + 1; attn_unit(C, L, u, rep); } } }
        else { const int j = item - N_SMP - N_S3S - N_MID; ssd_s3_unit(C, L, j >> 3, j & 7); }
    }
}

__device__ __forceinline__ void phase_final(Ctx& C) {
    const float* X = WSP(const float, WS_X); const float* PART = WSP(const float, WS_PART); const float* nw = C.in[25];
    const int gw = C.bid * 8 + C.wid, NGW = C.G * 8;
    for (int row = gw; row < MV; row += NGW) { const float rs = rstd1(PART + 4 * MT, row, 1e-6f);
#pragma unroll
        for (int j = 0; j < 4; ++j) { const int col = 4 * C.lane + 256 * j; const f32x4 x = *(const f32x4*)(X + (size_t)row * 1024 + col); const f32x4 w = *(const f32x4*)(nw + col);
            *(f32x4*)(C.out + O_YP + (size_t)row * 1024 + col) = (x * rs) * w; } }
}

#define XB_TMO      128
#define XB_XCNT(j)  (256  + 64 * (j))
#define XB_XSUB(j)  (1280 + 64 * (j))
#define XB_XGEN(j)  (2304 + 64 * (j))
#define XB_TOP      3328
#define XB_TOPGEN   3392
#define XCD_BAR_WORDS 3456
#define XB_SPIN_CAP (1u << 23)

__device__ __forceinline__ unsigned xb_ld(unsigned* p)              { return __hip_atomic_load(p, __ATOMIC_RELAXED, __HIP_MEMORY_SCOPE_AGENT); }
__device__ __forceinline__ unsigned xb_add(unsigned* p, unsigned v) { return __hip_atomic_fetch_add(p, v, __ATOMIC_RELAXED, __HIP_MEMORY_SCOPE_AGENT); }
__device__ __forceinline__ unsigned xb_xcc_id() { return (unsigned)__builtin_amdgcn_s_getreg((3 << 11) | 20) & 0xFu; }
#define XB_SPIN(cond, bar) do { unsigned _sp = 0; while (cond) { __builtin_amdgcn_s_sleep(1); \
    if ((++_sp & 255u) == 0u) { if (xb_ld(&(bar)[XB_TMO])) break; if (_sp > XB_SPIN_CAP) { atomicAdd(&(bar)[XB_TMO], 1u); break; } } } } while (0)

struct XcdBarrier {
    unsigned* bar; unsigned x;
    volatile LAS unsigned* st;
};

__device__ __forceinline__ XcdBarrier xcd_barrier_post(unsigned* bar, volatile LAS unsigned* st) {
    XcdBarrier b; b.bar = bar; b.x = xb_xcc_id(); b.st = st;
    if (threadIdx.x == 0) (void)xb_add(&bar[XB_XCNT(b.x)], 1u);
    return b;
}
__device__ __forceinline__ void xcd_barrier_complete(unsigned* bar, unsigned x, unsigned& nloc, unsigned& nx) {
    const unsigned G = gridDim.x * gridDim.y * gridDim.z;
    unsigned sum, cnt, mine, sp = 0u;
    for (;;) {
        sum = 0u; cnt = 0u; mine = 0u;
#pragma unroll
        for (unsigned j = 0; j < 16; ++j) { const unsigned c = xb_ld(&bar[XB_XCNT(j)]); sum += c; cnt += (c > 0u) ? 1u : 0u; mine = (j == x) ? c : mine; }
        if (sum == G) break;
        __builtin_amdgcn_s_sleep(1);
        if ((++sp & 255u) == 0u) { if (xb_ld(&bar[XB_TMO])) break; if (sp > XB_SPIN_CAP) { atomicAdd(&bar[XB_TMO], 1u); break; } }
    }
    nloc = mine > 0u ? mine : 1u; nx = cnt > 0u ? cnt : 1u;
}

__device__ __forceinline__ void xcd_barrier(const XcdBarrier& b) {
    asm volatile("s_waitcnt vmcnt(0)" ::: "memory");
    __syncthreads();
    if (threadIdx.x == 0) {
        unsigned* bar = b.bar;
        __builtin_amdgcn_s_waitcnt(0);
        unsigned nloc = b.st[0], nx = b.st[1];
        if (nloc == 0u) { xcd_barrier_complete(bar, b.x, nloc, nx); b.st[0] = nloc; b.st[1] = nx; }
        const unsigned old = xb_add(&bar[XB_XSUB(b.x)], 1u);
        const unsigned gen = old / nloc;
        if (old + 1u == (gen + 1u) * nloc) {
            __builtin_amdgcn_fence(__ATOMIC_RELEASE, "agent");
            asm volatile("s_waitcnt vmcnt(0)" ::: "memory");
            const unsigned og = xb_add(&bar[XB_TOP], 1u);
            const unsigned tg = og / nx;
            if (og + 1u == (tg + 1u) * nx) xb_add(&bar[XB_TOPGEN], 1u);
            else XB_SPIN(xb_ld(&bar[XB_TOPGEN]) == tg, bar);
            __builtin_amdgcn_fence(__ATOMIC_ACQUIRE, "agent");
            xb_add(&bar[XB_XGEN(b.x)], 1u);
            asm volatile("s_waitcnt vmcnt(0)" ::: "memory");
        } else {
            XB_SPIN(xb_ld(&bar[XB_XGEN(b.x)]) == gen, bar);
            __builtin_amdgcn_fence(__ATOMIC_ACQUIRE, "agent");
            asm volatile("s_waitcnt vmcnt(0)" ::: "memory");
        }
    }
    __syncthreads();
}

constexpr int N_PHASES = 18;
__global__ void __launch_bounds__(512, 2) mk_fwd(Args a) {
    extern __shared__ __attribute__((aligned(16))) unsigned char lds_raw[];
    Ctx C;
    C.lds = (LAS unsigned char*)lds_raw; C.G = gridDim.x; C.bid = blockIdx.x;
#pragma unroll
    for (int i = 0; i < 26; ++i) C.in[i] = a.in[i];
    C.out = a.out; C.ws = a.ws;
    cg::grid_group grid = cg::this_grid();
    if (threadIdx.x < 64) ((LAS unsigned*)(C.lds + LDS_CTL))[threadIdx.x] = 0u;
    __syncthreads();
    XcdBarrier xbar = xcd_barrier_post(WSP(unsigned, WS_CTL) + 4096, (volatile LAS unsigned*)(C.lds + LDS_CTL + 32));
#pragma unroll 1
    for (int ph = a.ph_lo; ph < a.ph_hi; ++ph) {
        if (ph == a.ph_lo + 1) { grid.sync(); } else if (ph > a.ph_lo) { xcd_barrier(xbar); }
        { int t_ = threadIdx.x; asm volatile("" : "+v"(t_)); C.tid = t_; C.lane = t_ & 63; C.wid = __builtin_amdgcn_readfirstlane(t_ >> 6); }
        if (ph == 0) { if (!(MK_SKIP & 1024)) phase_p0(C); continue; }
        if (ph == N_PHASES - 1) { phase_final(C); continue; }
        const int L = (ph - 1) >> 3, sub = (ph - 1) & 7;
        if (sub == 0) {
            pg8::Gemm g{WSP(const bf16_t, WS_XB), WSP(const bf16_t, WS_WIN + L * SZ_WIN), MT, NINP, 1024}; pg8::StaticOrder S; S.init(MT, NINP, C.G, C.bid);
            EpiIn E{WSP(const float, WS_PART) + (size_t)(2 * L) * MT, WSP(bf16_t, WS_Q), WSP(bf16_t, WS_K), WSP(bf16_t, WS_VT), WSP(bf16_t, WS_Z), WSP(bf16_t, WS_XBC), WSP(bf16_t, WS_G), WSP(float, WS_DT), C.out, L, WSP(bf16_t, WS_HIST)};
            if (!(MK_SKIP & 1)) pg8::gemm_phase<EpiIn, pg8::StaticOrder, true, true>(C.lds, g, S, E);
            if (MK_PROBE & 2) { grid.sync(); pg8::gemm_phase<EpiIn, pg8::StaticOrder, true, true>(C.lds, g, S, E); }
            if (MK_PROBE & 1024) { grid.sync(); EpiNull EN{WSP(float, WS_END - 64)}; pg8::gemm_phase<EpiNull, pg8::StaticOrder, true, true>(C.lds, g, S, EN); }
        } else if (sub == 1) {
            for (int uidx = C.bid; uidx < NCHUNK * 8; uidx += C.G) { { int t_ = threadIdx.x; asm volatile("" : "+v"(t_)); C.tid = t_; C.lane = t_ & 63; C.wid = __builtin_amdgcn_readfirstlane(t_ >> 6); } conv_unit(C, L, uidx >> 3, uidx & 7); }
            if (!(MK_SKIP & 4)) cache_convert(C, L);
            xcd_barrier(xbar);
            for (int uidx = C.bid * 8 + C.wid; uidx < NCHUNK * 32; uidx += C.G * 8) { { int t_ = threadIdx.x; asm volatile("" : "+v"(t_)); C.tid = t_; C.lane = t_ & 63; C.wid = __builtin_amdgcn_readfirstlane(t_ >> 6); } ssd_s1_wave(C, L, uidx >> 5, uidx & 31); }
            if (MK_PROBE & 512) { grid.sync(); for (int uidx = C.bid * 8 + C.wid; uidx < NCHUNK * 32; uidx += C.G * 8) { { int t_ = threadIdx.x; asm volatile("" : "+v"(t_)); C.tid = t_; C.lane = t_ & 63; C.wid = __builtin_amdgcn_readfirstlane(t_ >> 6); } ssd_s1_wave(C, L, uidx >> 5, uidx & 31); } }
        } else if (sub == 2) {
            if (!(MK_SKIP & 8)) ssd_scan(C, L);
        } else if (sub == 3) {
            phase_mix(C, L, 0);
            if (MK_PROBE & 1) { grid.sync(); phase_mix(C, L, 1); }
        } else if (sub == 4) {
            pg8::StaticOrder S; S.init(SEQ, 1024, C.G, C.bid);
            { pg8::Gemm g{WSP(const bf16_t, WS_ATT), WSP(const bf16_t, WS_WBA + L * SZ_WBA), SEQ, 1024, 1024}; EpiBrA E{WSP(const bf16_t, WS_G), WSP(float, WS_Z), 0};
              if (!(MK_SKIP & 64)) pg8::gemm_phase<EpiBrA, pg8::StaticOrder, true, true>(C.lds, g, S, E); }
            { pg8::Gemm g{WSP(const bf16_t, WS_YSSD), WSP(const bf16_t, WS_WBS + L * SZ_WBS), SEQ, 1024, 2048}; EpiBrB E{WSP(const bf16_t, WS_G), WSP(const float, WS_Z), WSP(bf16_t, WS_Q), 0};
              if (!(MK_SKIP & 128)) pg8::gemm_phase<EpiBrB, pg8::StaticOrder, true, true>(C.lds, g, S, E); }
        } else if (sub == 5) {
            pg8::Gemm g{WSP(const bf16_t, WS_Q), WSP(const bf16_t, WS_WOUT + L * SZ_WOUT), SEQ, 1024, 1024}; pg8::StaticOrder S; S.init(SEQ, 1024, C.G, C.bid);
            EpiRes E{WSP(float, WS_X), WSP(bf16_t, WS_XB), WSP(float, WS_PART) + (size_t)(2 * L + 1) * MT, 0};
            if (!(MK_SKIP & 256)) pg8::gemm_phase<EpiRes, pg8::StaticOrder, true, true>(C.lds, g, S, E);
        } else if (sub == 6) {
            pg8::Gemm g{WSP(const bf16_t, WS_XB), WSP(const bf16_t, WS_WGU + L * SZ_WGU), SEQ, 5632, 1024}; pg8::StaticOrder S; S.init(SEQ, 5632, C.G, C.bid);
            EpiGU E{WSP(const float, WS_PART) + (size_t)(2 * L + 1) * MT, WSP(bf16_t, WS_XBC), 0, 0};
            if (!(MK_SKIP & 512)) pg8::gemm_phase<EpiGU, pg8::StaticOrder, true, true>(C.lds, g, S, E);
            if (MK_PROBE & 4) { grid.sync(); pg8::gemm_phase<EpiGU, pg8::StaticOrder, true, true>(C.lds, g, S, E); }
        } else {
            pg8::Gemm g{WSP(const bf16_t, WS_XBC), WSP(const bf16_t, WS_WD + L * SZ_WD), SEQ, 1024, DFF}; pg8::StaticOrder S; S.init(SEQ, 1024, C.G, C.bid);
            EpiRes E{WSP(float, WS_X), WSP(bf16_t, WS_XB), WSP(float, WS_PART) + (size_t)(2 * L + 2) * MT, 0};
            if (!(MK_SKIP & 256)) pg8::gemm_phase<EpiRes, pg8::StaticOrder, true, true>(C.lds, g, S, E);
        }
    }
}

extern "C" void kernel_launch(void* const* d_in, const int* in_sizes, int n_in, void* d_out, int out_size, void* d_ws, size_t ws_size, hipStream_t stream) {
    static int grid = 0;
    if (grid == 0) {
        if (n_in != 26 || (size_t)out_size != O_END || ws_size < WS_END) { fprintf(stderr, "kernel_launch: unexpected shapes (n_in %d, out %d, ws %zu)\n", n_in, out_size, ws_size); grid = -1; return; }
        int dev = 0, cus = 0, per_cu = 0;
        hipGetDevice(&dev); hipDeviceGetAttribute(&cus, hipDeviceAttributeMultiprocessorCount, dev);
        if (hipFuncSetAttribute((const void*)mk_fwd, hipFuncAttributeMaxDynamicSharedMemorySize, LDS_BYTES) != hipSuccess) { fprintf(stderr, "kernel_launch: hipFuncSetAttribute failed\n"); grid = -1; return; }
        if (hipOccupancyMaxActiveBlocksPerMultiprocessor(&per_cu, (const void*)mk_fwd, 512, LDS_BYTES) != hipSuccess || per_cu < 1) per_cu = 1;
        (void)hipGetLastError();
        grid = cus * per_cu;
    }
    if (grid < 0) return;
    hipMemsetAsync((char*)d_ws + WS_CTL, 0, CTL_BYTES, stream);
    Args a{};
    for (int i = 0; i < 26; ++i) a.in[i] = (const float*)d_in[i];
    a.out = (float*)d_out; a.ws = (unsigned char*)d_ws;
#if MK_MULTI
    for (int ph = 0; ph < N_PHASES; ++ph) { a.ph_lo = ph; a.ph_hi = ph + 1; hipLaunchKernelGGL(mk_fwd, dim3(grid), dim3(512), LDS_BYTES, stream, a); }
#else
    a.ph_lo = 0; a.ph_hi = N_PHASES;
    void* args[] = {&a};
    hipError_t e = hipLaunchCooperativeKernel((const void*)mk_fwd, dim3(grid), dim3(512), args, LDS_BYTES, stream);
    if (e != hipSuccess) fprintf(stderr, "cooperative launch failed: %s (grid %d)\n", hipGetErrorString(e), grid);
#endif
}
```

```cpp
#include <hip/hip_runtime.h>
#include <hip/hip_cooperative_groups.h>
#include <cstdio>
#include <cstdint>
#include <cmath>
namespace cg = cooperative_groups;
#ifndef MK_MULTI
#define MK_MULTI 0
#endif
#ifndef MK_SKIP
#define MK_SKIP 0
#endif
#ifndef MK_PROBE
#define MK_PROBE 0
#endif
#ifndef MK_SGB
#define MK_SGB 0
#endif
namespace pg8 {
#define PG8_LAS __attribute__((address_space(3)))
typedef unsigned short bf16_t;
typedef short bf16x8 __attribute__((ext_vector_type(8)));
typedef float f32x4 __attribute__((ext_vector_type(4)));
typedef unsigned u32x4 __attribute__((ext_vector_type(4)));
constexpr int BM = 256, BK = 64, HALF = 128, HTB = HALF * BK * 2  , STAGE_BYTES = 8 * HTB, NXCD = 8, WGM = 8;

__host__ __device__ __forceinline__ int lds_byte(int r, int c) { const int st = (r >> 4) * 2 + (c >> 5), rr = r & 15, cc = c & 31, ob = rr * 64 + cc * 2; return st * 1024 + (ob ^ (((ob >> 9) & 1) << 5)); }
__host__ __device__ __forceinline__ void stage_rc(int b, int& R, int& C) { const int st = b / 1024, sb = b % 1024, swz = sb ^ (((sb >> 9) & 1) << 5); R = (st >> 1) * 16 + swz / 64; C = (st & 1) * 32 + (swz % 64) / 2; }
__host__ __device__ __forceinline__ int perm32(int rho) { const int n = rho >> 4, i = rho & 15; return 8 * (i >> 2) + 4 * n + (i & 3); }

struct Unit { int pm, pn; };
struct Gemm { const bf16_t* A; const bf16_t* Bt; int M, N, K; };

struct StaticOrder {
    int nM, nN, nwg, G, c;
    __host__ __device__ void init(int M, int N, int G_, int c_) { nM = M / BM; nN = N / BM; nwg = nM * nN; G = G_; c = c_; }
    __host__ __device__ bool next(int i, Unit& u) const {
        const long L = (long)i * G + c; if (L >= nwg) return false;
        int wgid = (int)L; { const int q = nwg / NXCD, r = nwg % NXCD, xcd = wgid % NXCD, off = wgid / NXCD; wgid = (xcd < r ? xcd * (q + 1) : r * (q + 1) + (xcd - r) * q) + off; }
        const int nig = WGM * nN, gid = wgid / nig, fm = gid * WGM, gsz = (nM - fm) < WGM ? (nM - fm) : WGM;
        u.pm = fm + ((wgid % nig) % gsz); u.pn = (wgid % nig) / gsz; return true;
    }
    __device__ __forceinline__ void a_ready(const Unit&) const {}
    __device__ __forceinline__ void done(const Unit&) const {}
};

template <class Epi, class Sched, bool ALIGN_EPI = false, bool SP2 = false>
__device__ __forceinline__ void gemm_phase(PG8_LAS unsigned char* lds, const Gemm g, const Sched& S, const Epi& E) {
    int tid_ = threadIdx.x; asm volatile("" : "+v"(tid_)); const int tid = tid_, wid = __builtin_amdgcn_readfirstlane(tid >> 6), lane = tid & 63, wr = wid >> 2, wc = wid & 3, fr = lane & 15, fq = lane >> 4;
    const int K = g.K, nt = K / BK;
    unsigned voffA[2], voffB[2];
#pragma unroll
    for (int i = 0; i < 2; ++i) { int R, C; stage_rc(tid * 16 + i * 8192, R, C); const int Rb = Epi::PERM ? ((R & ~31) + perm32(R & 31)) : R;
        voffA[i] = (unsigned)(R * K + C) * 2u; voffB[i] = (unsigned)(Rb * K + C) * 2u; }
    const size_t kstep = (size_t)(BK * 2);
    const size_t hstep = (size_t)HALF * K * 2;
    const size_t tstep = 2 * hstep;
    const unsigned ldsw = (unsigned)wid * 1024u;
    const int aoff = lds_byte(wr * 64 + fr, fq * 8), boff = lds_byte(wc * 32 + fr, fq * 8);
#define PG8_SA(b, h) (((b) * 2 + (h)) * HTB)
#define PG8_SB(b, h) ((4 + (b) * 2 + (h)) * HTB)
#define PG8_STAGE(bufoff, gbase, voff) do { _Pragma("unroll") for (int _i = 0; _i < 2; ++_i) \
        __builtin_amdgcn_global_load_lds((const unsigned*)((const char*)(gbase) + (voff)[_i]), (PG8_LAS unsigned*)(lds + (bufoff) + ldsw + _i * 8192), 16, 0, 0); } while (0)
#define PG8_LDA(dst, b, h) do { _Pragma("unroll") for (int m = 0; m < 4; ++m) _Pragma("unroll") for (int k = 0; k < 2; ++k) dst[m][k] = *(const PG8_LAS bf16x8*)(lds + PG8_SA(b, h) + aoff + m * 2048 + k * 1024); } while (0)
#define PG8_LDB(dst, b, h) do { _Pragma("unroll") for (int n = 0; n < 2; ++n) _Pragma("unroll") for (int k = 0; k < 2; ++k) dst[n][k] = *(const PG8_LAS bf16x8*)(lds + PG8_SB(b, h) + boff + n * 2048 + k * 1024); } while (0)
#define PG8_MMA(ai, bj, At, Bt) do { __builtin_amdgcn_s_setprio(1); _Pragma("unroll") for (int m = 0; m < 4; ++m) _Pragma("unroll") for (int n = 0; n < 2; ++n) _Pragma("unroll") for (int k = 0; k < 2; ++k) \
        acc[ai][bj][m][n] = __builtin_amdgcn_mfma_f32_16x16x32_bf16(Bt[n][k], At[m][k], acc[ai][bj][m][n], 0, 0, 0); __builtin_amdgcn_s_setprio(0); } while (0)
#define PG8_WAIT_V(n) asm volatile("s_waitcnt vmcnt(" #n ")" ::: "memory")
#define PG8_WAIT_L(n) asm volatile("s_waitcnt lgkmcnt(" #n ")" ::: "memory")
#define PG8_BAR __builtin_amdgcn_s_barrier()
#define PG8_SCHED __builtin_amdgcn_sched_barrier(0)
    Unit cur, nxt; int ui = 0;
    if (!S.next(0, cur)) return;
    f32x4 acc[2][2][4][2];
#pragma unroll
    for (int a = 0; a < 2; ++a)
#pragma unroll
        for (int b = 0; b < 2; ++b)
#pragma unroll
            for (int m = 0; m < 4; ++m)
#pragma unroll
                for (int n = 0; n < 2; ++n) acc[a][b][m][n] = (f32x4){0.f, 0.f, 0.f, 0.f};
    bf16x8 At[4][2], B0[2][2], B1[2][2];
    const char* cA = (const char*)g.A + (size_t)cur.pm * tstep; const char* cB = (const char*)g.Bt + (size_t)cur.pn * tstep;
    S.a_ready(cur);
    if constexpr (SP2) {
        PG8_STAGE(PG8_SB(0, 0), cB, voffB); PG8_STAGE(PG8_SB(0, 1), cB + hstep, voffB); PG8_STAGE(PG8_SA(0, 0), cA, voffA); PG8_STAGE(PG8_SA(0, 1), cA + hstep, voffA);
        if (wr == 1) PG8_BAR;
        PG8_WAIT_V(2); PG8_BAR;
        PG8_STAGE(PG8_SB(1, 0), cB + kstep, voffB); PG8_STAGE(PG8_SA(1, 0), cA + kstep, voffA); PG8_STAGE(PG8_SB(1, 1), cB + hstep + kstep, voffB);
        PG8_WAIT_V(6); PG8_BAR;
    } else {
        PG8_STAGE(PG8_SB(0, 0), cB, voffB); PG8_STAGE(PG8_SA(0, 0), cA, voffA); PG8_STAGE(PG8_SB(0, 1), cB + hstep, voffB); PG8_STAGE(PG8_SA(0, 1), cA + hstep, voffA);
        if (wr == 1) PG8_BAR;
        PG8_WAIT_V(4); PG8_BAR;
        PG8_STAGE(PG8_SB(1, 0), cB + kstep, voffB); PG8_STAGE(PG8_SA(1, 0), cA + kstep, voffA); PG8_STAGE(PG8_SB(1, 1), cB + hstep + kstep, voffB);
        PG8_WAIT_V(6); PG8_BAR;
    }
    for (;;) {
        const bool has_next = S.next(ui + 1, nxt);
        const char* nA = has_next ? (const char*)g.A + (size_t)nxt.pm * tstep : cA; const char* nB = has_next ? (const char*)g.Bt + (size_t)nxt.pn * tstep : cB;
        for (int t = 0; t < nt; t += 2) {
            const bool last = (t == nt - 2);
            const char* a1 = cA + (size_t)(t + 1) * kstep;
            const char* a2 = last ? nA : cA + (size_t)(t + 2) * kstep; const char* b2 = last ? nB : cB + (size_t)(t + 2) * kstep;
            const char* a3 = a2 + kstep; const char* b3 = b2 + kstep;
            if (last && has_next) S.a_ready(nxt);
            if constexpr (SP2) {
            PG8_LDB(B0, 0, 0); PG8_LDB(B1, 0, 1); PG8_SCHED; PG8_LDA(At, 0, 0); PG8_STAGE(PG8_SA(1, 1), a1 + hstep, voffA);
            PG8_WAIT_V(8); PG8_WAIT_L(0); PG8_BAR; PG8_MMA(0, 0, At, B0); PG8_MMA(0, 1, At, B1); PG8_BAR; PG8_SCHED;
            PG8_LDA(At, 0, 1); PG8_STAGE(PG8_SB(0, 0), b2, voffB); PG8_STAGE(PG8_SB(0, 1), b2 + hstep, voffB); PG8_STAGE(PG8_SA(0, 0), a2, voffA);
            PG8_WAIT_V(8); PG8_WAIT_L(0); PG8_BAR; PG8_MMA(1, 0, At, B0); PG8_MMA(1, 1, At, B1); PG8_BAR; PG8_SCHED;
            PG8_LDB(B0, 1, 0); PG8_LDB(B1, 1, 1); PG8_SCHED; PG8_LDA(At, 1, 0); PG8_STAGE(PG8_SA(0, 1), a2 + hstep, voffA);
            PG8_WAIT_V(8); PG8_WAIT_L(0); PG8_BAR; PG8_MMA(0, 0, At, B0); PG8_MMA(0, 1, At, B1); PG8_BAR; PG8_SCHED;
            PG8_LDA(At, 1, 1); PG8_STAGE(PG8_SB(1, 0), b3, voffB); PG8_STAGE(PG8_SB(1, 1), b3 + hstep, voffB); PG8_STAGE(PG8_SA(1, 0), a3, voffA);
            PG8_WAIT_V(8); PG8_WAIT_L(0); PG8_BAR; PG8_MMA(1, 0, At, B0); PG8_MMA(1, 1, At, B1); PG8_BAR; PG8_SCHED;
            } else {
            PG8_LDB(B0, 0, 0); PG8_SCHED; PG8_LDA(At, 0, 0); PG8_STAGE(PG8_SA(1, 1), a1 + hstep, voffA);
            PG8_WAIT_L(8); PG8_BAR; PG8_WAIT_L(0); PG8_MMA(0, 0, At, B0); PG8_BAR; PG8_SCHED;
            PG8_LDB(B1, 0, 1); PG8_STAGE(PG8_SB(0, 0), b2, voffB);
            PG8_BAR; PG8_WAIT_L(0); PG8_MMA(0, 1, At, B1); PG8_BAR;
            PG8_LDA(At, 0, 1); PG8_STAGE(PG8_SA(0, 0), a2, voffA);
            PG8_BAR; PG8_WAIT_L(0); PG8_MMA(1, 0, At, B0); PG8_BAR; PG8_SCHED;
            PG8_STAGE(PG8_SB(0, 1), b2 + hstep, voffB);
            PG8_WAIT_V(6); PG8_BAR; PG8_MMA(1, 1, At, B1); PG8_BAR;
            PG8_LDB(B0, 1, 0); PG8_SCHED; PG8_LDA(At, 1, 0); PG8_STAGE(PG8_SA(0, 1), a2 + hstep, voffA);
            PG8_WAIT_L(8); PG8_BAR; PG8_WAIT_L(0); PG8_MMA(0, 0, At, B0); PG8_BAR; PG8_SCHED;
            PG8_LDB(B1, 1, 1); PG8_STAGE(PG8_SB(1, 0), b3, voffB);
            PG8_BAR; PG8_WAIT_L(0); PG8_MMA(0, 1, At, B1); PG8_BAR;
            PG8_LDA(At, 1, 1); PG8_STAGE(PG8_SA(1, 0), a3, voffA);
            PG8_BAR; PG8_WAIT_L(0); PG8_MMA(1, 0, At, B0); PG8_BAR; PG8_SCHED;
            PG8_STAGE(PG8_SB(1, 1), b3 + hstep, voffB);
            PG8_WAIT_V(6); PG8_BAR; PG8_MMA(1, 1, At, B1); PG8_BAR;
            }
        }
        if constexpr (ALIGN_EPI) { if (wr == 0) PG8_BAR; }
        if constexpr (!Epi::AFTER_DRAIN) { E(acc, cur, wr, wc, fr, fq); S.done(cur); }
        if (!has_next) break;
#pragma unroll
        for (int a = 0; a < 2; ++a)
#pragma unroll
            for (int b = 0; b < 2; ++b)
#pragma unroll
                for (int m = 0; m < 4; ++m)
#pragma unroll
                    for (int n = 0; n < 2; ++n) acc[a][b][m][n] = (f32x4){0.f, 0.f, 0.f, 0.f};
        cur = nxt; cA = nA; cB = nB; ++ui;
        if constexpr (ALIGN_EPI) { if (wr == 1) PG8_BAR; }
    }
    PG8_WAIT_V(0);
    if constexpr (!ALIGN_EPI) { if (wr == 0) PG8_BAR; }
    PG8_BAR;
    if constexpr (Epi::AFTER_DRAIN) { E.fused(acc, cur, wr, wc, fr, fq, lds, wid, lane); S.done(cur); }
#undef PG8_SA
#undef PG8_SB
#undef PG8_STAGE
#undef PG8_LDA
#undef PG8_LDB
#undef PG8_MMA
#undef PG8_WAIT_V
#undef PG8_WAIT_L
#undef PG8_BAR
#undef PG8_SCHED
}
}

#define LAS __attribute__((address_space(3)))
typedef unsigned short bf16_t;
typedef short bf16x8 __attribute__((ext_vector_type(8)));
typedef float f32x4 __attribute__((ext_vector_type(4)));
typedef float f32x16 __attribute__((ext_vector_type(16)));
typedef unsigned u32x4 __attribute__((ext_vector_type(4)));
typedef unsigned u32x2 __attribute__((ext_vector_type(2)));

constexpr int DM = 1024, SEQ = 16384, NSMP = 128, MV = SEQ + NSMP, MT = 16640;
constexpr int NIN = 11296, NINP = 11520, DFF = 2816, DIN = 2048, CONVD = 4096;
constexpr int NCHUNK = 264;
constexpr size_t HPN = 32 * 64 * 128;
constexpr int PAST = 4096;

constexpr size_t O_YP = 0, O_YS = O_YP + (size_t)SEQ * DM, O_KP = O_YS + (size_t)NSMP * DM, O_VP = O_KP + 2ull * SEQ * DM,
                 O_CP = O_VP + 2ull * SEQ * DM, O_SP = O_CP + 2ull * 3 * CONVD, O_KS = O_SP + 2ull * HPN, O_VS = O_KS + 2ull * NSMP * DM,
                 O_CS = O_VS + 2ull * NSMP * DM, O_SS = O_CS + 2ull * 8 * 3 * CONVD, O_END = O_SS + 2ull * 8 * HPN;

constexpr size_t MiB = 1ull << 20;
constexpr size_t SZ_WIN = (size_t)NINP * 1024 * 2, SZ_WBA = 1024ull * 1024 * 2, SZ_WBS = 1024ull * 2048 * 2, SZ_WOUT = SZ_WBA,
                 SZ_WGU = 5632ull * 1024 * 2, SZ_WD = 1024ull * DFF * 2;
constexpr size_t WS_CTL = 0, CTL_BYTES = 65536;
constexpr size_t WS_WIN = 1 * MiB, WS_WBA = WS_WIN + 2 * SZ_WIN, WS_WBS = WS_WBA + 2 * SZ_WBA, WS_WOUT = WS_WBS + 2 * SZ_WBS,
                 WS_WGU = WS_WOUT + 2 * SZ_WOUT, WS_WD = WS_WGU + 2 * SZ_WGU, WS_WEND = WS_WD + 2 * SZ_WD;
constexpr size_t WS_KC = (WS_WEND + MiB - 1) / MiB * MiB;
constexpr size_t WS_VTC = WS_KC + 8ull * PAST * 1024 * 2;
constexpr size_t WS_X = WS_VTC + 8ull * PAST * 1024 * 2;
constexpr size_t WS_XB = WS_X + (size_t)MT * 1024 * 4;
constexpr size_t WS_PART = WS_XB + (size_t)MT * 1024 * 2;
constexpr size_t WS_Q = WS_PART + (size_t)MT * 16 * 4;
constexpr size_t WS_K = WS_Q + (size_t)MT * 1024 * 2;
constexpr size_t WS_VT = WS_K + (size_t)MT * 1024 * 2;
constexpr size_t WS_Z = WS_VT + (size_t)MT * 1024 * 2;
constexpr size_t WS_XBC = WS_Z + (size_t)MT * 2048 * 2;
constexpr size_t WS_G = WS_XBC + (size_t)MT * 4096 * 2;
constexpr size_t WS_DT = WS_G + (size_t)MT * 2048 * 2;
constexpr size_t WS_CS = WS_DT + (size_t)MT * 32 * 4;
constexpr size_t WS_CDEC = WS_CS + (size_t)NCHUNK * HPN * 2;
constexpr size_t WS_ATT = WS_CDEC + 65536;
constexpr size_t WS_YSSD = WS_ATT + (size_t)MT * 1024 * 2;
constexpr size_t WS_HIST = WS_YSSD + (size_t)MT * 2048 * 2;
constexpr size_t WS_XTG = WS_HIST + 256ull * 3 * 4096 * 2;
constexpr size_t WS_BTG = WS_XTG + (size_t)NCHUNK * 2048 * 64 * 2;
constexpr size_t WS_ACTS = WS_BTG + (size_t)NCHUNK * 1024 * 64 * 2;
constexpr size_t WS_DTA = WS_ACTS + 256ull * DFF * 2;
constexpr size_t WS_ACSG = WS_DTA + (size_t)NCHUNK * 32 * 64 * 4;
constexpr size_t WS_END = WS_ACSG + (size_t)NCHUNK * 32 * 64 * 4;
static_assert(WS_END <= 1024ull * MiB, "workspace map must fit 1 GiB");

constexpr int LDS_CTL = 131072, LDS_BYTES = 131072 + 1024;
constexpr int AT_KROW = 272, AT_VROW = 144, AT_KSZ = 64 * AT_KROW, AT_VSZ = 128 * AT_VROW, AT_STAGE = AT_KSZ + AT_VSZ;
constexpr int SD_DT = 0, SD_ACS = 1024, SD_RS = 2048, SD_BT = 4096, SD_XT = SD_BT + 128 * 144, SD_CM = SD_XT + 256 * 144, SD_BM = SD_CM + 64 * 272, SD_END = SD_BM + 64 * 272;
static_assert(SD_END <= 131072 && 2 * AT_STAGE <= 131072, "lds");

struct Args { const float* in[26]; float* out; unsigned char* ws; int ph_lo, ph_hi; };

__device__ __forceinline__ unsigned pk_bf16(float lo, float hi) {
    typedef float f2 __attribute__((ext_vector_type(2))); typedef __bf16 b2 __attribute__((ext_vector_type(2)));
    f2 v = {lo, hi}; b2 b = __builtin_convertvector(v, b2); return __builtin_bit_cast(unsigned, b);
}
__device__ __forceinline__ float bf_lo(unsigned u) { return __uint_as_float(u << 16); }
__device__ __forceinline__ float bf_hi(unsigned u) { return __uint_as_float(u & 0xffff0000u); }
__device__ __forceinline__ float fexp2(float x) { return __builtin_amdgcn_exp2f(x); }
__device__ __forceinline__ float fexp(float x) { return __builtin_amdgcn_exp2f(x * 1.4426950408889634f); }
__device__ __forceinline__ float frcp(float x) { return __builtin_amdgcn_rcpf(x); }
__device__ __forceinline__ float silu_f(float x) { return x * frcp(1.0f + fexp(-x)); }
__device__ __forceinline__ float sigmoid_f(float x) { return frcp(1.0f + fexp(-x)); }
__device__ __forceinline__ float wave_sum(float v) {
#pragma unroll
    for (int o = 1; o < 64; o <<= 1) v += __shfl_xor(v, o);
    return v;
}
__device__ __forceinline__ unsigned my_xcc_id() { return (unsigned)__builtin_amdgcn_s_getreg((3 << 11) | 20) & 0xFu; }
__device__ __forceinline__ int sig5(int i) { return (i & ~12) | ((i & 4) << 1) | ((i & 8) >> 1); }
__device__ __forceinline__ float rstd1(const float* rss, int row, float eps) { return 1.0f / sqrtf(rss[row] * (1.0f / 1024.0f) + eps); }
__device__ __forceinline__ float rstd_row(const float* part, int row, float eps) {
    const f32x4* p = (const f32x4*)(part + (size_t)row * 16);
    const f32x4 a = p[0], b = p[1], c = p[2], d = p[3];
    const float s = ((a.x + a.y) + (a.z + a.w)) + ((b.x + b.y) + (b.z + b.w)) + ((c.x + c.y) + (c.z + c.w)) + ((d.x + d.y) + (d.z + d.w));
    return 1.0f / sqrtf(s * (1.0f / 1024.0f) + eps);
}
__device__ __forceinline__ float max3f(float a, float b, float c) { float r; asm("v_max3_f32 %0, %1, %2, %3" : "=v"(r) : "v"(a), "v"(b), "v"(c)); return r; }
#define MFMA32(a, b, c) __builtin_amdgcn_mfma_f32_32x32x16_bf16((a), (b), (c), 0, 0, 0)

#define EPI_LOOP_ROWS _Pragma("unroll") for (int ai = 0; ai < 2; ++ai) _Pragma("unroll") for (int m = 0; m < 4; ++m)
#define EPI_LOOP_COLS _Pragma("unroll") for (int bj = 0; bj < 2; ++bj) _Pragma("unroll") for (int n = 0; n < 2; ++n)

struct EpiIn {
    static constexpr bool PERM = true, AFTER_DRAIN = false;
    const float* part; bf16_t *Q, *K, *VT, *Z, *XBC, *G; float* DT; float* out; int layer; bf16_t* HIST;
    __device__ __forceinline__ void operator()(const pg8::f32x4 (&acc)[2][2][4][2], const pg8::Unit& u, int wr, int wc, int fr, int fq) const {
        const int pn = u.pn; const int cb = pn * 256 + wc * 32 + 8 * fq;
        float rsv[2][4];
#pragma unroll
        for (int ai = 0; ai < 2; ++ai)
#pragma unroll
            for (int m = 0; m < 4; ++m) rsv[ai][m] = part[u.pm * 256 + ai * 128 + wr * 64 + m * 16 + fr];
#pragma unroll
        for (int ai = 0; ai < 2; ++ai)
#pragma unroll
            for (int m = 0; m < 4; ++m) rsv[ai][m] = 1.0f / sqrtf(rsv[ai][m] * (1.0f / 1024.0f) + 1e-6f);
        EPI_LOOP_ROWS {
            const int row = u.pm * 256 + ai * 128 + wr * 64 + m * 16 + fr;
            const float rs = rsv[ai][m];
#pragma unroll
            for (int bj = 0; bj < 2; ++bj) {
                const pg8::f32x4 v0 = acc[ai][bj][m][0] * rs, v1 = acc[ai][bj][m][1] * rs; const int col = cb + bj * 128;
                if (pn < 4) {
                    const float sc = 0.125f * 1.4426950408889634f;
                    u32x4 w; w.x = pk_bf16(v0[0] * sc, v0[1] * sc); w.y = pk_bf16(v0[2] * sc, v0[3] * sc); w.z = pk_bf16(v1[0] * sc, v1[1] * sc); w.w = pk_bf16(v1[2] * sc, v1[3] * sc);
                    *(u32x4*)(Q + (size_t)row * 1024 + col) = w;
                } else if (pn < 8) {
                    const int c = col - 1024; u32x4 w; w.x = pk_bf16(v0[0], v0[1]); w.y = pk_bf16(v0[2], v0[3]); w.z = pk_bf16(v1[0], v1[1]); w.w = pk_bf16(v1[2], v1[3]);
                    *(u32x4*)(K + (size_t)row * 1024 + c) = w;
                    float* o = nullptr;
                    if (row < SEQ) o = out + O_KP + ((size_t)layer * SEQ + row) * 1024 + c; else if (row < MV) o = out + O_KS + ((size_t)layer * NSMP + (row - SEQ)) * 1024 + c;
                    if (o) { *(pg8::f32x4*)o = v0; *(pg8::f32x4*)(o + 4) = v1; }
                } else if (pn < 12) {
                    const int c = col - 2048;
                    const unsigned w0 = pk_bf16(v0[0], v0[1]), w1 = pk_bf16(v0[2], v0[3]), w2 = pk_bf16(v1[0], v1[1]), w3 = pk_bf16(v1[2], v1[3]);
                    VT[(size_t)(c + 0) * MT + row] = (bf16_t)(w0 & 0xffffu); VT[(size_t)(c + 1) * MT + row] = (bf16_t)(w0 >> 16);
                    VT[(size_t)(c + 2) * MT + row] = (bf16_t)(w1 & 0xffffu); VT[(size_t)(c + 3) * MT + row] = (bf16_t)(w1 >> 16);
                    VT[(size_t)(c + 4) * MT + row] = (bf16_t)(w2 & 0xffffu); VT[(size_t)(c + 5) * MT + row] = (bf16_t)(w2 >> 16);
                    VT[(size_t)(c + 6) * MT + row] = (bf16_t)(w3 & 0xffffu); VT[(size_t)(c + 7) * MT + row] = (bf16_t)(w3 >> 16);
                    float* o = nullptr;
                    if (row < SEQ) o = out + O_VP + ((size_t)layer * SEQ + row) * 1024 + c; else if (row < MV) o = out + O_VS + ((size_t)layer * NSMP + (row - SEQ)) * 1024 + c;
                    if (o) { *(pg8::f32x4*)o = v0; *(pg8::f32x4*)(o + 4) = v1; }
                } else if (pn < 20) {
                    const int c = col - 3072; u32x4 w; w.x = pk_bf16(v0[0], v0[1]); w.y = pk_bf16(v0[2], v0[3]); w.z = pk_bf16(v1[0], v1[1]); w.w = pk_bf16(v1[2], v1[3]);
                    *(u32x4*)(Z + (size_t)row * 2048 + c) = w;
                } else if (pn < 36) {
                    const int c = col - 5120; u32x4 w; w.x = pk_bf16(v0[0], v0[1]); w.y = pk_bf16(v0[2], v0[3]); w.z = pk_bf16(v1[0], v1[1]); w.w = pk_bf16(v1[2], v1[3]);
                    *(u32x4*)(XBC + (size_t)row * 4096 + c) = w;
                    if (row < SEQ && (row & 63) >= 61) *(u32x4*)(HIST + ((size_t)(row >> 6) * 3 + ((row & 63) - 61)) * 4096 + c) = w;
                    float* o = nullptr;
                    if (row >= SEQ - 3 && row < SEQ) o = out + O_CP + ((size_t)layer * 3 + (row - (SEQ - 3))) * 4096 + c;
                    else if (row >= SEQ && row < MV) { const int s = row - SEQ, t = s & 15; if (t >= 13) o = out + O_CS + (((size_t)layer * 8 + (s >> 4)) * 3 + (t - 13)) * 4096 + c; }
                    if (o) { *(pg8::f32x4*)o = v0; *(pg8::f32x4*)(o + 4) = v1; }
                } else if (pn < 44) {
                    const int c = col - 9216; u32x4 w; w.x = pk_bf16(sigmoid_f(v0[0]), sigmoid_f(v0[1])); w.y = pk_bf16(sigmoid_f(v0[2]), sigmoid_f(v0[3]));
                    w.z = pk_bf16(sigmoid_f(v1[0]), sigmoid_f(v1[1])); w.w = pk_bf16(sigmoid_f(v1[2]), sigmoid_f(v1[3]));
                    *(u32x4*)(G + (size_t)row * 2048 + c) = w;
                } else {
                    const int c = col - 11264;
                    if (c < 32) { *(pg8::f32x4*)(DT + (size_t)row * 32 + c) = v0; *(pg8::f32x4*)(DT + (size_t)row * 32 + c + 4) = v1; }
                }
            }
        }
    }
};

struct EpiNull {
    static constexpr bool PERM = false, AFTER_DRAIN = false; float* sink;
    __device__ __forceinline__ void operator()(const pg8::f32x4 (&acc)[2][2][4][2], const pg8::Unit& u, int wr, int wc, int fr, int fq) const {
        pg8::f32x4 s = acc[0][0][0][0];
        EPI_LOOP_ROWS { EPI_LOOP_COLS { s += acc[ai][bj][m][n]; } }
        if (s[0] == 123456.789f) sink[0] = s[1] + s[2] + s[3];
    }
};
struct EpiBrA {
    static constexpr bool PERM = false, AFTER_DRAIN = false;
    const bf16_t* G; float* MF; int row0;
    __device__ __forceinline__ void operator()(const pg8::f32x4 (&acc)[2][2][4][2], const pg8::Unit& u, int wr, int wc, int fr, int fq) const {
        const int cb = u.pn * 256 + wc * 32 + 4 * fq;
        EPI_LOOP_ROWS { const int row = row0 + u.pm * 256 + ai * 128 + wr * 64 + m * 16 + fr;
            EPI_LOOP_COLS { const int col = cb + bj * 128 + n * 16; const u32x2 g = *(const u32x2*)(G + (size_t)row * 2048 + col);
                pg8::f32x4 v = acc[ai][bj][m][n]; v[0] *= bf_lo(g.x); v[1] *= bf_hi(g.x); v[2] *= bf_lo(g.y); v[3] *= bf_hi(g.y);
                *(pg8::f32x4*)(MF + (size_t)row * 1024 + col) = v; } }
    }
};
struct EpiBrB {
    static constexpr bool PERM = false, AFTER_DRAIN = false;
    const bf16_t* G; const float* MF; bf16_t* MB; int row0;
    __device__ __forceinline__ void operator()(const pg8::f32x4 (&acc)[2][2][4][2], const pg8::Unit& u, int wr, int wc, int fr, int fq) const {
        const int cb = u.pn * 256 + wc * 32 + 4 * fq;
        EPI_LOOP_ROWS { const int row = row0 + u.pm * 256 + ai * 128 + wr * 64 + m * 16 + fr;
            EPI_LOOP_COLS { const int col = cb + bj * 128 + n * 16; const u32x2 g = *(const u32x2*)(G + (size_t)row * 2048 + 1024 + col);
                const pg8::f32x4 a = acc[ai][bj][m][n]; const pg8::f32x4 o = *(const pg8::f32x4*)(MF + (size_t)row * 1024 + col);
                u32x2 w; w.x = pk_bf16(o[0] + a[0] * bf_lo(g.x), o[1] + a[1] * bf_hi(g.x)); w.y = pk_bf16(o[2] + a[2] * bf_lo(g.y), o[3] + a[3] * bf_hi(g.y));
                *(u32x2*)(MB + (size_t)row * 1024 + col) = w; } }
    }
};
struct EpiRes {
    static constexpr bool PERM = false, AFTER_DRAIN = false;
    float* X; bf16_t* XB; float* part; int row0;
    __device__ __forceinline__ void operator()(const pg8::f32x4 (&acc)[2][2][4][2], const pg8::Unit& u, int wr, int wc, int fr, int fq) const {
        const int cb = u.pn * 256 + wc * 32 + 4 * fq;
        EPI_LOOP_ROWS { const int row = row0 + u.pm * 256 + ai * 128 + wr * 64 + m * 16 + fr; float ss = 0.f;
            EPI_LOOP_COLS { const int col = cb + bj * 128 + n * 16; float* xp = X + (size_t)row * 1024 + col;
                const pg8::f32x4 x = *(const pg8::f32x4*)xp + acc[ai][bj][m][n];
                *(pg8::f32x4*)xp = x; u32x2 w; w.x = pk_bf16(x[0], x[1]); w.y = pk_bf16(x[2], x[3]); *(u32x2*)(XB + (size_t)row * 1024 + col) = w;
                ss += (x[0] * x[0] + x[1] * x[1]) + (x[2] * x[2] + x[3] * x[3]); }
            ss += __shfl_xor(ss, 16); ss += __shfl_xor(ss, 32);
            if (fq == 0) atomicAdd(part + row, ss); }
    }
};
struct EpiGU {
    static constexpr bool PERM = true, AFTER_DRAIN = false;
    const float* part; bf16_t* ACT; int row0; int act_sub;
    __device__ __forceinline__ void operator()(const pg8::f32x4 (&acc)[2][2][4][2], const pg8::Unit& u, int wr, int wc, int fr, int fq) const {
        const int cb = u.pn * 128 + wc * 32 + 8 * fq;
        float rsv[2][4];
#pragma unroll
        for (int ai = 0; ai < 2; ++ai)
#pragma unroll
            for (int m = 0; m < 4; ++m) rsv[ai][m] = part[row0 + u.pm * 256 + ai * 128 + wr * 64 + m * 16 + fr];
#pragma unroll
        for (int ai = 0; ai < 2; ++ai)
#pragma unroll
            for (int m = 0; m < 4; ++m) rsv[ai][m] = 1.0f / sqrtf(rsv[ai][m] * (1.0f / 1024.0f) + 1e-6f);
        EPI_LOOP_ROWS { const int row = row0 - act_sub + u.pm * 256 + ai * 128 + wr * 64 + m * 16 + fr; const float rs = rsv[ai][m];
            const pg8::f32x4 g0 = acc[ai][0][m][0] * rs, g1 = acc[ai][0][m][1] * rs, u0 = acc[ai][1][m][0] * rs, u1 = acc[ai][1][m][1] * rs;
            u32x4 w; w.x = pk_bf16(silu_f(g0[0]) * u0[0], silu_f(g0[1]) * u0[1]); w.y = pk_bf16(silu_f(g0[2]) * u0[2], silu_f(g0[3]) * u0[3]);
            w.z = pk_bf16(silu_f(g1[0]) * u1[0], silu_f(g1[1]) * u1[1]); w.w = pk_bf16(silu_f(g1[2]) * u1[2], silu_f(g1[3]) * u1[3]);
            *(u32x4*)(ACT + (size_t)row * DFF + cb) = w; }
    }
};

struct Ctx {
    LAS unsigned char* lds; int tid, lane, wid, G, bid;
    const float* in[26]; float* out; unsigned char* ws;
};
#define WSP(T, off) ((T*)(C.ws + (off)))

struct TItem { const float* W; int N, k0, n0; bf16_t* WT; size_t dst_row0; int Kd; const float* kscale; };
struct TRegs { float tv[32]; f32x4 s0, s1; };
__device__ __forceinline__ void tr_load(const TItem& t, TRegs& r, int lane) {
#pragma unroll
    for (int i = 0; i < 32; ++i) r.tv[i] = t.W[(size_t)(t.k0 + 2 * i + (lane >> 5)) * t.N + t.n0 + (lane & 31)];
    if (t.kscale) { r.s0 = *(const f32x4*)(t.kscale + t.k0 + 8 * (lane & 7)); r.s1 = *(const f32x4*)(t.kscale + t.k0 + 8 * (lane & 7) + 4); }
    else { r.s0 = (f32x4){1.f, 1.f, 1.f, 1.f}; r.s1 = r.s0; }
}
__device__ __forceinline__ void tr_finish(const TItem& t, const TRegs& r, LAS float* scr, int lane) {
#pragma unroll
    for (int i = 0; i < 32; ++i) scr[(2 * i + (lane >> 5)) * 33 + (lane & 31)] = r.tv[i];
    asm volatile("s_waitcnt lgkmcnt(0)" ::: "memory");
    const int c = lane & 7;
#pragma unroll
    for (int j = 0; j < 4; ++j) { const int n = (lane >> 3) + 8 * j; const LAS float* s = scr + (8 * c) * 33 + n;
        u32x4 o; o.x = pk_bf16(s[0 * 33] * r.s0.x, s[1 * 33] * r.s0.y); o.y = pk_bf16(s[2 * 33] * r.s0.z, s[3 * 33] * r.s0.w);
        o.z = pk_bf16(s[4 * 33] * r.s1.x, s[5 * 33] * r.s1.y); o.w = pk_bf16(s[6 * 33] * r.s1.z, s[7 * 33] * r.s1.w);
        *(u32x4*)(t.WT + (t.dst_row0 + n) * (size_t)t.Kd + t.k0 + 8 * c) = o; }
    asm volatile("s_waitcnt lgkmcnt(0)" ::: "memory");
}
__device__ __forceinline__ bool p0_item(const Ctx& C, int it, TItem& t) {
    constexpr int I_IN = 16 * 353, I_BA = 16 * 32, I_BS = 32 * 32, I_OUT = 16 * 32, I_GU = 16 * 176, I_D = 44 * 32, I_L = I_IN + I_BA + I_BS + I_OUT + I_GU + I_D;
    if (it >= 2 * I_L) return false;
    const int L = it / I_L; int r = it % I_L; t.kscale = nullptr;
    if (r < I_IN) { const int kb = r / 353, nb = r % 353, n0 = 32 * nb;
        t.W = C.in[7] + (size_t)L * 1024 * NIN; t.N = NIN; t.k0 = 64 * kb; t.n0 = n0; t.WT = WSP(bf16_t, WS_WIN + L * SZ_WIN);
        t.dst_row0 = n0 < 9216 ? n0 : (n0 < 9248 ? 11264 + (n0 - 9216) : 9216 + (n0 - 9248)); t.Kd = 1024; t.kscale = C.in[6] + L * 1024; return true; }
    r -= I_IN;
    if (r < I_BA) { t.W = C.in[19] + (size_t)L * 1024 * 1024; t.N = 1024; t.k0 = 64 * (r / 32); t.n0 = 32 * (r % 32); t.WT = WSP(bf16_t, WS_WBA + L * SZ_WBA); t.dst_row0 = t.n0; t.Kd = 1024; return true; }
    r -= I_BA;
    if (r < I_BS) { t.W = C.in[20] + (size_t)L * 2048 * 1024; t.N = 1024; t.k0 = 64 * (r / 32); t.n0 = 32 * (r % 32); t.WT = WSP(bf16_t, WS_WBS + L * SZ_WBS); t.dst_row0 = t.n0; t.Kd = 2048; return true; }
    r -= I_BS;
    if (r < I_OUT) { t.W = C.in[21] + (size_t)L * 1024 * 1024; t.N = 1024; t.k0 = 64 * (r / 32); t.n0 = 32 * (r % 32); t.WT = WSP(bf16_t, WS_WOUT + L * SZ_WOUT); t.dst_row0 = t.n0; t.Kd = 1024; return true; }
    r -= I_OUT;
    if (r < I_GU) { const int kb = r / 176, nb = r % 176, n0 = 32 * nb; const int ch = n0 % DFF;
        t.W = C.in[23] + (size_t)L * 1024 * 5632; t.N = 5632; t.k0 = 64 * kb; t.n0 = n0; t.WT = WSP(bf16_t, WS_WGU + L * SZ_WGU);
        t.dst_row0 = 256 * (ch / 128) + (ch % 128) + (n0 >= DFF ? 128 : 0); t.Kd = 1024; t.kscale = C.in[22] + L * 1024; return true; }
    r -= I_GU;
    t.W = C.in[24] + (size_t)L * DFF * 1024; t.N = 1024; t.k0 = 64 * (r / 32); t.n0 = 32 * (r % 32); t.WT = WSP(bf16_t, WS_WD + L * SZ_WD); t.dst_row0 = t.n0; t.Kd = DFF; return true;
}

__device__ __forceinline__ void phase_p0(Ctx& C) {
    LAS float* scr = (LAS float*)(C.lds + C.wid * 8704);
    const int gw = C.bid * 8 + C.wid, NGW = C.G * 8;
    {   TItem cur, nxt; TRegs ra, rb; int it = gw;
        bool have = p0_item(C, it, cur); if (have) tr_load(cur, ra, C.lane);
        while (have) { it += NGW; const bool hn = p0_item(C, it, nxt); if (hn) tr_load(nxt, rb, C.lane);
            tr_finish(cur, ra, scr, C.lane); cur = nxt; ra = rb; have = hn; } }
    {   const int nz = 2 * (NINP - NIN) * 1024 / 8;
        for (int i = C.bid * 512 + C.tid; i < nz; i += C.G * 512) { const int L = i / ((NINP - NIN) * 128), r = i % ((NINP - NIN) * 128);
            *(u32x4*)(WSP(bf16_t, WS_WIN + L * SZ_WIN) + (size_t)NIN * 1024 + (size_t)r * 8) = (u32x4){0u, 0u, 0u, 0u}; } }
    float* X = WSP(float, WS_X); bf16_t* XB = WSP(bf16_t, WS_XB); float* PART = WSP(float, WS_PART);
    for (int mrow = gw; mrow < MT; mrow += NGW) {
        f32x4 v[4]; float ss = 0.f;
#pragma unroll
        for (int j = 0; j < 4; ++j) {
            if (mrow < SEQ) v[j] = *(const f32x4*)(C.in[0] + (size_t)mrow * 1024 + 4 * C.lane + 256 * j);
            else if (mrow < MV) v[j] = *(const f32x4*)(C.in[1] + (size_t)(mrow - SEQ) * 1024 + 4 * C.lane + 256 * j);
            else v[j] = (f32x4){0.f, 0.f, 0.f, 0.f};
            ss += (v[j].x * v[j].x + v[j].y * v[j].y) + (v[j].z * v[j].z + v[j].w * v[j].w);
            *(f32x4*)(X + (size_t)mrow * 1024 + 4 * C.lane + 256 * j) = v[j];
            u32x2 w; w.x = pk_bf16(v[j].x, v[j].y); w.y = pk_bf16(v[j].z, v[j].w);
            *(u32x2*)(XB + (size_t)mrow * 1024 + 4 * C.lane + 256 * j) = w;
        }
        ss = wave_sum(ss);
        if (C.lane < 5) PART[(size_t)C.lane * MT + mrow] = (C.lane == 0) ? ss : 0.f;
    }
}

__device__ __forceinline__ void cache_convert(Ctx& C, int L) {
    const float* ck = C.in[2] + (size_t)L * 8 * PAST * 1024; bf16_t* KC = WSP(bf16_t, WS_KC);
    const int ntask = 8 * PAST * 1024 / 8;
    {   const int stride = C.G * 512;
        for (int i0 = C.bid * 512 + C.tid; i0 < ntask; i0 += 4 * stride) { f32x4 a[4], b[4];
#pragma unroll
            for (int j = 0; j < 4; ++j) { const int i = i0 + j * stride; if (i < ntask) { a[j] = *(const f32x4*)(ck + (size_t)i * 8); b[j] = *(const f32x4*)(ck + (size_t)i * 8 + 4); } }
#pragma unroll
            for (int j = 0; j < 4; ++j) { const int i = i0 + j * stride; if (i < ntask) { u32x4 o; o.x = pk_bf16(a[j].x, a[j].y); o.y = pk_bf16(a[j].z, a[j].w); o.z = pk_bf16(b[j].x, b[j].y); o.w = pk_bf16(b[j].z, b[j].w);
                *(u32x4*)(KC + (size_t)i * 8) = o; } } } }
    LAS float* scr = (LAS float*)(C.lds + C.wid * 8704);
    const int gw = C.bid * 8 + C.wid, NGW = C.G * 8;
    {   TItem cur, nxt; TRegs ra, rb; int it = gw;
#define CV_ITEM(IT, T) ((IT) < 8 * 2048 ? ((T).W = C.in[3] + ((size_t)L * 8 + (IT) / 2048) * PAST * 1024, (T).N = 1024, (T).k0 = 64 * (((IT) % 2048) / 32), (T).n0 = 32 * ((IT) % 32), \
            (T).WT = WSP(bf16_t, WS_VTC) + (size_t)((IT) / 2048) * 1024 * PAST, (T).dst_row0 = (size_t)(T).n0, (T).Kd = PAST, (T).kscale = nullptr, true) : false)
        bool have = CV_ITEM(it, cur); if (have) tr_load(cur, ra, C.lane);
        while (have) { it += NGW; const bool hn = CV_ITEM(it, nxt); if (hn) tr_load(nxt, rb, C.lane);
            tr_finish(cur, ra, scr, C.lane); cur = nxt; ra = rb; have = hn; }
#undef CV_ITEM
    }
}

struct ChunkInfo { int base, Lc, mode; const float* hist; };
__device__ __forceinline__ ChunkInfo chunk_info(const Ctx& C, int L, int c) {
    ChunkInfo ci;
    if (c < 256) { ci.base = 64 * c; ci.Lc = 64; ci.mode = (c == 0) ? 1 : 0; ci.hist = nullptr; }
    else { const int b = c - 256; ci.base = SEQ + 16 * b; ci.Lc = 16; ci.mode = 2; ci.hist = C.in[4] + ((size_t)L * 8 + b) * 3 * CONVD; }
    return ci;
}
__device__ __forceinline__ void conv_t8(const bf16_t* XBC, const ChunkInfo& ci, const float* cw, const float* cbias, int col, int l0, float (&o0)[8], float (&o1)[8]) {
    float i0[11], i1[11];
#pragma unroll
    for (int i = 0; i < 11; ++i) { const int rr = l0 - 3 + i;
        if (rr >= 0 || ci.mode == 0) { const unsigned v = *(const unsigned*)(XBC + (size_t)(ci.base + rr) * 4096 + col); i0[i] = bf_lo(v); i1[i] = bf_hi(v); }
        else if (ci.mode == 1) { i0[i] = 0.f; i1[i] = 0.f; }
        else { const float* hp = ci.hist + (size_t)(3 + rr) * 4096 + col; i0[i] = hp[0]; i1[i] = hp[1]; } }
    float w0[4], w1[4];
#pragma unroll
    for (int j = 0; j < 4; ++j) { w0[j] = cw[j * 4096 + col]; w1[j] = cw[j * 4096 + col + 1]; }
    const float b0 = cbias[col], b1 = cbias[col + 1];
#pragma unroll
    for (int k = 0; k < 8; ++k) { float a0 = b0, a1 = b1;
#pragma unroll
        for (int j = 0; j < 4; ++j) { a0 += w0[j] * i0[k + j]; a1 += w1[j] * i1[k + j]; }
        o0[k] = silu_f(a0); o1[k] = silu_f(a1); }
}
__device__ __forceinline__ void conv_n8(const bf16_t* XBC, const ChunkInfo& ci, const float* cw, const float* cbias, int col, int l, float (&o)[8]) {
    { const f32x4 b0 = *(const f32x4*)(cbias + col), b1 = *(const f32x4*)(cbias + col + 4);
      o[0] = b0.x; o[1] = b0.y; o[2] = b0.z; o[3] = b0.w; o[4] = b1.x; o[5] = b1.y; o[6] = b1.z; o[7] = b1.w; }
#pragma unroll
    for (int j = 0; j < 4; ++j) { const int rr = l - 3 + j; float x[8];
        if (rr >= 0 || ci.mode == 0) { const u32x4 v = *(const u32x4*)(XBC + (size_t)(ci.base + rr) * 4096 + col);
            x[0] = bf_lo(v.x); x[1] = bf_hi(v.x); x[2] = bf_lo(v.y); x[3] = bf_hi(v.y); x[4] = bf_lo(v.z); x[5] = bf_hi(v.z); x[6] = bf_lo(v.w); x[7] = bf_hi(v.w); }
        else if (ci.mode == 1) {
#pragma unroll
            for (int q = 0; q < 8; ++q) x[q] = 0.f; }
        else { const float* hp = ci.hist + (size_t)(3 + rr) * 4096 + col; const f32x4 h0 = *(const f32x4*)hp, h1 = *(const f32x4*)(hp + 4);
            x[0] = h0.x; x[1] = h0.y; x[2] = h0.z; x[3] = h0.w; x[4] = h1.x; x[5] = h1.y; x[6] = h1.z; x[7] = h1.w; }
        const f32x4 wa = *(const f32x4*)(cw + j * 4096 + col), wb = *(const f32x4*)(cw + j * 4096 + col + 4);
        o[0] += wa.x * x[0]; o[1] += wa.y * x[1]; o[2] += wa.z * x[2]; o[3] += wa.w * x[3]; o[4] += wb.x * x[4]; o[5] += wb.y * x[5]; o[6] += wb.z * x[6]; o[7] += wb.w * x[7]; }
#pragma unroll
    for (int q = 0; q < 8; ++q) o[q] = silu_f(o[q]);
}
__device__ __forceinline__ void ssd_dt_acs(Ctx& C, int L, const ChunkInfo& ci, int c, int g, bool write_cdec) {
    if (C.wid < 4) { const int h = 4 * g + C.wid, l = C.lane;
        const float raw = WSP(const float, WS_DT)[(size_t)(ci.base + l) * 32 + h] + C.in[15][L * 32 + h];
        float dt = raw > 20.f ? raw : log1pf(expf(raw)); if (l >= ci.Lc) dt = 0.f;
        const float A = -expf(C.in[16][L * 32 + h]); float a = dt * A;
#pragma unroll
        for (int o = 1; o < 64; o <<= 1) { const float t = __shfl_up(a, o); if (l >= o) a += t; }
        ((LAS float*)(C.lds + SD_DT))[C.wid * 64 + l] = dt; ((LAS float*)(C.lds + SD_ACS))[C.wid * 64 + l] = a;
        if (write_cdec && l == 63) WSP(float, WS_CDEC)[c * 32 + h] = expf(a);
    }
}
__device__ __forceinline__ void st8_bf16(LAS unsigned char* p, const float (&o)[8]) {
    u32x4 w; w.x = pk_bf16(o[0], o[1]); w.y = pk_bf16(o[2], o[3]); w.z = pk_bf16(o[4], o[5]); w.w = pk_bf16(o[6], o[7]); *(LAS u32x4*)p = w;
}

__device__ __forceinline__ void conv_unit(Ctx& C, int L, int c, int slab) {
    const ChunkInfo ci = chunk_info(C, L, c);
    bf16_t* XBC = WSP(bf16_t, WS_XBC); const bf16_t* HIST = WSP(const bf16_t, WS_HIST);
    const float* cw = C.in[13] + (size_t)L * 4 * CONVD; const float* cbias = C.in[14] + (size_t)L * CONVD;
    const int col0 = slab * 512;
    {   u32x4 v[8];
#pragma unroll
        for (int k = 0; k < 8; ++k) { const int idx = C.tid + 512 * k; v[k] = *(const u32x4*)(XBC + (size_t)(ci.base + (idx >> 6)) * 4096 + col0 + (idx & 63) * 8); }
        if (C.tid < 192) { const int r = C.tid >> 6, c16 = C.tid & 63; u32x4 hv;
            if (ci.mode == 1) hv = (u32x4){0u, 0u, 0u, 0u};
            else if (ci.mode == 0) hv = *(const u32x4*)(HIST + ((size_t)(c - 1) * 3 + r) * 4096 + col0 + c16 * 8);
            else { const float* hp = ci.hist + (size_t)r * 4096 + col0 + c16 * 8; const f32x4 a = *(const f32x4*)hp, b = *(const f32x4*)(hp + 4);
                hv.x = pk_bf16(a.x, a.y); hv.y = pk_bf16(a.z, a.w); hv.z = pk_bf16(b.x, b.y); hv.w = pk_bf16(b.z, b.w); }
            *(LAS u32x4*)(C.lds + r * 1024 + c16 * 16) = hv; }
#pragma unroll
        for (int k = 0; k < 8; ++k) { const int idx = C.tid + 512 * k; *(LAS u32x4*)(C.lds + (3 + (idx >> 6)) * 1024 + (idx & 63) * 16) = v[k]; }
    }
    __syncthreads();
#pragma unroll 1
    for (int i = 0; i < 4; ++i) { const int task = C.tid + 512 * i, p = task & 255, lb = task >> 8, l0 = 8 * lb, col = col0 + 2 * p;
        float i0[11], i1[11];
#pragma unroll
        for (int k = 0; k < 11; ++k) { const unsigned v = *(const LAS unsigned*)(C.lds + (l0 + k) * 1024 + p * 4); i0[k] = bf_lo(v); i1[k] = bf_hi(v); }
        float w0[4], w1[4];
#pragma unroll
        for (int j = 0; j < 4; ++j) { const float2 w = *(const float2*)(cw + j * 4096 + col); w0[j] = w.x; w1[j] = w.y; }
        const float2 bb = *(const float2*)(cbias + col);
        float o0[8], o1[8];
#pragma unroll
        for (int k = 0; k < 8; ++k) { float a0 = bb.x, a1 = bb.y;
#pragma unroll
            for (int j = 0; j < 4; ++j) { a0 += w0[j] * i0[k + j]; a1 += w1[j] * i1[k + j]; }
            o0[k] = silu_f(a0); o1[k] = silu_f(a1); }
        if (slab < 6) {
            const int ch_ = (slab < 4) ? col : col - 2048;
            bf16_t* dst = ((slab < 4) ? WSP(bf16_t, WS_XTG) + (size_t)c * 2048 * 64 : WSP(bf16_t, WS_BTG) + (size_t)c * 1024 * 64) + ((((size_t)(ch_ >> 5)) * 4 + (lb >> 1)) * 64 + (lb & 1) * 32 + (ch_ & 31)) * 8;
            u32x4 w; w.x = pk_bf16(o0[0], o0[1]); w.y = pk_bf16(o0[2], o0[3]); w.z = pk_bf16(o0[4], o0[5]); w.w = pk_bf16(o0[6], o0[7]); *(u32x4*)dst = w;
            w.x = pk_bf16(o1[0], o1[1]); w.y = pk_bf16(o1[2], o1[3]); w.z = pk_bf16(o1[4], o1[5]); w.w = pk_bf16(o1[6], o1[7]); *(u32x4*)(dst + 8) = w;
        }
        if (slab >= 4) {
#pragma unroll
            for (int k = 0; k < 8; ++k) if (l0 + k < ci.Lc) *(unsigned*)(XBC + (size_t)(ci.base + l0 + k) * 4096 + col) = pk_bf16(o0[k], o1[k]);
        }
    }
    __syncthreads();
}

__device__ __forceinline__ void ssd_s1_wave(Ctx& C, int L, int c, int h) {
    const ChunkInfo ci = chunk_info(C, L, c);
    const int l = C.lane, q32 = C.lane & 31, hi = C.lane >> 5, g = h >> 2;
    const float raw = WSP(const float, WS_DT)[(size_t)(ci.base + l) * 32 + h] + C.in[15][L * 32 + h];
    float dt = raw > 20.f ? raw : log1pf(expf(raw)); if (l >= ci.Lc) dt = 0.f;
    const float A = -expf(C.in[16][L * 32 + h]); float a = dt * A;
#pragma unroll
    for (int o = 1; o < 64; o <<= 1) { const float t = __shfl_up(a, o); if (l >= o) a += t; }
    WSP(float, WS_DTA)[((size_t)c * 32 + h) * 64 + l] = dt; WSP(float, WS_ACSG)[((size_t)c * 32 + h) * 64 + l] = a;
    const float aend = __shfl(a, 63);
    const float w = dt * fexp(aend - a);
    if (l == 63) WSP(float, WS_CDEC)[c * 32 + h] = expf(a);
    const bf16_t* xt = WSP(const bf16_t, WS_XTG) + (size_t)c * 2048 * 64 + ((size_t)(2 * h) * 4 * 64 + C.lane) * 8;
    const bf16_t* bt = WSP(const bf16_t, WS_BTG) + (size_t)c * 1024 * 64 + ((size_t)(4 * g) * 4 * 64 + C.lane) * 8;
    f32x16 acc[2][4];
#pragma unroll
    for (int ph = 0; ph < 2; ++ph)
#pragma unroll
        for (int nt = 0; nt < 4; ++nt) acc[ph][nt] = (f32x16){};
#pragma unroll
    for (int ks = 0; ks < 4; ++ks) {
        float wv[8];
#pragma unroll
        for (int j = 0; j < 8; ++j) wv[j] = __shfl(w, 16 * ks + 8 * hi + j);
        bf16x8 bfr[2];
#pragma unroll
        for (int ph = 0; ph < 2; ++ph) { const u32x4 r = *(const u32x4*)(xt + (ph * 4 + ks) * 512);
            u32x4 o; o.x = pk_bf16(bf_lo(r.x) * wv[0], bf_hi(r.x) * wv[1]); o.y = pk_bf16(bf_lo(r.y) * wv[2], bf_hi(r.y) * wv[3]);
            o.z = pk_bf16(bf_lo(r.z) * wv[4], bf_hi(r.z) * wv[5]); o.w = pk_bf16(bf_lo(r.w) * wv[6], bf_hi(r.w) * wv[7]); bfr[ph] = __builtin_bit_cast(bf16x8, o); }
#pragma unroll
        for (int nt = 0; nt < 4; ++nt) { const bf16x8 afr = *(const bf16x8*)(bt + (nt * 4 + ks) * 512);
            acc[0][nt] = MFMA32(afr, bfr[0], acc[0][nt]); acc[1][nt] = MFMA32(afr, bfr[1], acc[1][nt]); }
    }
#pragma unroll
    for (int ph = 0; ph < 2; ++ph) { bf16_t* dst = WSP(bf16_t, WS_CS) + ((size_t)c * 32 + h) * 8192;
#pragma unroll
        for (int nt = 0; nt < 4; ++nt)
#pragma unroll
            for (int rq = 0; rq < 4; ++rq) { u32x2 o; o.x = pk_bf16(acc[ph][nt][4 * rq], acc[ph][nt][4 * rq + 1]); o.y = pk_bf16(acc[ph][nt][4 * rq + 2], acc[ph][nt][4 * rq + 3]);
                *(u32x2*)(dst + ((ph * 8 + 2 * nt + (rq >> 1)) * 64 + (rq & 1) * 32 + q32) * 8 + 4 * hi) = o; } }
}

__device__ __forceinline__ void ssd_s1_unit(Ctx& C, int L, int c, int g) {
    const ChunkInfo ci = chunk_info(C, L, c);
    const bf16_t* XBC = WSP(const bf16_t, WS_XBC); const float* cw = C.in[13] + (size_t)L * 4 * CONVD; const float* cbias = C.in[14] + (size_t)L * CONVD;
    ssd_dt_acs(C, L, ci, c, g, true);
    __syncthreads();
    {
        const int cp = C.tid & 63, lb = C.tid >> 6; float o0[8], o1[8];
        conv_t8(XBC, ci, cw, cbias, 2048 + g * 128 + 2 * cp, 8 * lb, o0, o1);
        st8_bf16(C.lds + SD_BT + (2 * cp) * 144 + lb * 16, o0); st8_bf16(C.lds + SD_BT + (2 * cp + 1) * 144 + lb * 16, o1);
    }
#pragma unroll 1
    for (int i = 0; i < 2; ++i) {
        const int task = C.tid + 512 * i, cp = task & 127, lb = task >> 7, hh = cp >> 5; float o0[8], o1[8];
        conv_t8(XBC, ci, cw, cbias, g * 256 + 2 * cp, 8 * lb, o0, o1);
        const LAS float* dts = (const LAS float*)(C.lds + SD_DT) + hh * 64 + 8 * lb; const LAS float* acs = (const LAS float*)(C.lds + SD_ACS) + hh * 64;
        const float aend = acs[63];
#pragma unroll
        for (int k = 0; k < 8; ++k) { const float w = dts[k] * fexp(aend - acs[8 * lb + k]); o0[k] *= w; o1[k] *= w; }
        st8_bf16(C.lds + SD_XT + (2 * cp) * 144 + lb * 16, o0); st8_bf16(C.lds + SD_XT + (2 * cp + 1) * 144 + lb * 16, o1);
    }
    __syncthreads();
    {   const int hh = C.wid >> 1, ph = C.wid & 1, q32 = C.lane & 31, hi = C.lane >> 5, h = 4 * g + hh;
        f32x16 acc[4];
#pragma unroll
        for (int nt = 0; nt < 4; ++nt) acc[nt] = (f32x16){};
#pragma unroll
        for (int ks = 0; ks < 4; ++ks) { const bf16x8 bfr = *(const LAS bf16x8*)(C.lds + SD_XT + (hh * 64 + ph * 32 + q32) * 144 + ks * 32 + hi * 16);
#pragma unroll
            for (int nt = 0; nt < 4; ++nt) { const bf16x8 afr = *(const LAS bf16x8*)(C.lds + SD_BT + (nt * 32 + q32) * 144 + ks * 32 + hi * 16); acc[nt] = MFMA32(afr, bfr, acc[nt]); } }
        bf16_t* dst = WSP(bf16_t, WS_CS) + (((size_t)c * 32 + h) * 64 + ph * 32 + q32) * 128;
#pragma unroll
        for (int nt = 0; nt < 4; ++nt)
#pragma unroll
            for (int rq = 0; rq < 4; ++rq) { u32x2 w; w.x = pk_bf16(acc[nt][4 * rq], acc[nt][4 * rq + 1]); w.y = pk_bf16(acc[nt][4 * rq + 2], acc[nt][4 * rq + 3]);
                *(u32x2*)(dst + 32 * nt + 8 * rq + 4 * hi) = w; }
    }
    __syncthreads();
}

__device__ __forceinline__ void ssd_scan(Ctx& C, int L) {
    bf16_t* CS = WSP(bf16_t, WS_CS); const float* CDEC = WSP(const float, WS_CDEC);
    for (int gid = C.bid * 512 + C.tid; gid < (int)(HPN / 2); gid += C.G * 512) {
        const int h = gid >> 12; float s0 = 0.f, s1 = 0.f; unsigned* p = (unsigned*)CS + gid;
#pragma unroll 1
        for (int c0 = 0; c0 < 256; c0 += 16) { unsigned v[16]; float d[16];
#pragma unroll
            for (int j = 0; j < 16; ++j) { v[j] = p[(size_t)(c0 + j) * (HPN / 2)]; d[j] = CDEC[(c0 + j) * 32 + h]; }
#pragma unroll
            for (int j = 0; j < 16; ++j) { p[(size_t)(c0 + j) * (HPN / 2)] = pk_bf16(s0, s1); s0 = d[j] * s0 + bf_lo(v[j]); s1 = d[j] * s1 + bf_hi(v[j]); } }
        const int e_ = 2 * (gid & 4095), lane_ = (e_ >> 3) & 63;
        const size_t nat = (size_t)h * 8192 + (size_t)(32 * (e_ >> 12) + (lane_ & 31)) * 128 + 16 * ((e_ >> 9) & 7) + 8 * (lane_ >> 5) + (e_ & 7);
        float* o = C.out + O_SP + (size_t)L * HPN + nat; o[0] = s0; o[1] = s1;
#pragma unroll
        for (int b = 0; b < 8; ++b) { const float* ip = C.in[5] + ((size_t)L * 8 + b) * HPN + nat; const float i0 = ip[0], i1 = ip[1];
            unsigned* q = p + (size_t)(256 + b) * (HPN / 2); const unsigned v = *q; const float d = CDEC[(256 + b) * 32 + h];
            *q = pk_bf16(i0, i1);
            float* os = C.out + O_SS + ((size_t)L * 8 + b) * HPN + nat; os[0] = d * i0 + bf_lo(v); os[1] = d * i1 + bf_hi(v); }
    }
}

__device__ __forceinline__ void ssd_s3_unit(Ctx& C, int L, int c, int g) {
    const ChunkInfo ci = chunk_info(C, L, c);
    const bf16_t* XBC = WSP(const bf16_t, WS_XBC); const float* cw = C.in[13] + (size_t)L * 4 * CONVD; const float* cbias = C.in[14] + (size_t)L * CONVD;
    const int hh = C.wid >> 1, ph = C.wid & 1, q32 = C.lane & 31, hi = C.lane >> 5, h = 4 * g + hh;
    const int chb = h * 64 + ph * 32 + 4 * hi;
    bf16x8 pf[8], xf[3][2]; u32x2 zf[2][4];
    {   const bf16_t* prev = WSP(const bf16_t, WS_CS) + ((size_t)c * 32 + h) * 8192 + ((size_t)(ph * 8) * 64 + C.lane) * 8;
#pragma unroll
        for (int ks = 0; ks < 8; ++ks) pf[ks] = *(const bf16x8*)(prev + ks * 512);
#pragma unroll
        for (int tile = 0; tile < 3; ++tile)
#pragma unroll
            for (int sp = 0; sp < 2; ++sp) xf[tile][sp] = *(const bf16x8*)(WSP(const bf16_t, WS_XTG) + (size_t)c * 2048 * 64 + ((size_t)((2 * h + ph) * 4 + 2 * (tile >> 1) + sp) * 64 + C.lane) * 8);
#pragma unroll
        for (int lh = 0; lh < 2; ++lh)
#pragma unroll
            for (int rq = 0; rq < 4; ++rq) zf[lh][rq] = *(const u32x2*)(WSP(const bf16_t, WS_Z) + (size_t)(ci.base + lh * 32 + q32) * 2048 + chb + 8 * rq);
    }
    if (C.tid < 256) { const size_t o = ((size_t)c * 32 + 4 * g + (C.tid >> 6)) * 64 + (C.tid & 63); const float dtv = WSP(const float, WS_DTA)[o], av = WSP(const float, WS_ACSG)[o];
        ((LAS float*)(C.lds + SD_DT))[C.tid] = dtv; ((LAS float*)(C.lds + SD_ACS))[C.tid] = av; }
#pragma unroll
    for (int i = 0; i < 2; ++i) {
        const int task = C.tid + 512 * i, c8 = task & 15, l = task >> 4;
        const u32x4 vc = *(const u32x4*)(XBC + (size_t)(ci.base + l) * 4096 + 3072 + g * 128 + c8 * 8), vb = *(const u32x4*)(XBC + (size_t)(ci.base + l) * 4096 + 2048 + g * 128 + c8 * 8);
        *(LAS u32x4*)(C.lds + SD_CM + l * 272 + c8 * 16) = vc; *(LAS u32x4*)(C.lds + SD_BM + ((l & 32) | sig5(l & 31)) * 272 + c8 * 16) = vb;
    }
    __syncthreads();
    const LAS float* dts = (const LAS float*)(C.lds + SD_DT) + hh * 64; const LAS float* acs = (const LAS float*)(C.lds + SD_ACS) + hh * 64;
    f32x16 acc[2]; acc[0] = (f32x16){}; acc[1] = (f32x16){};
    {
#pragma unroll
        for (int ks = 0; ks < 8; ++ks) { const bf16x8 afr = pf[ks];
#pragma unroll
            for (int lh = 0; lh < 2; ++lh) { const bf16x8 bfr = *(const LAS bf16x8*)(C.lds + SD_CM + (lh * 32 + q32) * 272 + ks * 32 + hi * 16); acc[lh] = MFMA32(afr, bfr, acc[lh]); } }
#pragma unroll
        for (int lh = 0; lh < 2; ++lh) { const float e = fexp(acs[lh * 32 + q32]);
#pragma unroll
            for (int r = 0; r < 16; ++r) acc[lh][r] *= e; }
    }
    const float Dh = C.in[17][L * 32 + h];
#pragma unroll
    for (int tile = 0; tile < 3; ++tile) {
        const int sh = tile >> 1, lh = (tile + 1) >> 1;
        f32x16 T = (f32x16){};
#pragma unroll
        for (int ks = 0; ks < 8; ++ks) { const bf16x8 afr = *(const LAS bf16x8*)(C.lds + SD_BM + (sh * 32 + q32) * 272 + ks * 32 + hi * 16);
            const bf16x8 bfr = *(const LAS bf16x8*)(C.lds + SD_CM + (lh * 32 + q32) * 272 + ks * 32 + hi * 16); T = MFMA32(afr, bfr, T); }
        const int l = lh * 32 + q32; const float al = acs[l];
        unsigned pk[8];
#pragma unroll
        for (int r2 = 0; r2 < 8; ++r2) { float mv[2];
#pragma unroll
            for (int q = 0; q < 2; ++q) { const int r = 2 * r2 + q; const int s = sh * 32 + 16 * (r >> 3) + 8 * hi + (r & 7);
                float w = 0.f; if (s <= l) w = fexp(al - acs[s]) * dts[s];
                mv[q] = T[r] * w + ((s == l) ? Dh : 0.f); }
            pk[r2] = pk_bf16(mv[0], mv[1]); }
#pragma unroll
        for (int sp = 0; sp < 2; ++sp) { const bf16x8 afr = xf[tile][sp];
            const u32x4 bw = {pk[4 * sp], pk[4 * sp + 1], pk[4 * sp + 2], pk[4 * sp + 3]};
            acc[lh] = MFMA32(afr, __builtin_bit_cast(bf16x8, bw), acc[lh]); }
    }
#pragma unroll
    for (int lh = 0; lh < 2; ++lh) { const int l = lh * 32 + q32; float ss = 0.f;
#pragma unroll
        for (int rq = 0; rq < 4; ++rq) { const u32x2 z = zf[lh][rq];
            acc[lh][4 * rq + 0] *= silu_f(bf_lo(z.x)); acc[lh][4 * rq + 1] *= silu_f(bf_hi(z.x)); acc[lh][4 * rq + 2] *= silu_f(bf_lo(z.y)); acc[lh][4 * rq + 3] *= silu_f(bf_hi(z.y));
#pragma unroll
            for (int q = 0; q < 4; ++q) ss += acc[lh][4 * rq + q] * acc[lh][4 * rq + q]; }
        ss += __shfl_xor(ss, 32);
        if (hi == 0) ((LAS float*)(C.lds + SD_RS))[C.wid * 64 + l] = ss; }
    __syncthreads();
    const float* nw = C.in[18] + (size_t)L * DIN; bf16_t* Y = WSP(bf16_t, WS_YSSD);
#pragma unroll
    for (int lh = 0; lh < 2; ++lh) { const int l = lh * 32 + q32; float tot = 0.f;
#pragma unroll
        for (int w = 0; w < 8; ++w) tot += ((const LAS float*)(C.lds + SD_RS))[w * 64 + l];
        const float rs = 1.0f / sqrtf(tot * (1.0f / 256.0f) + 1e-5f);
        if (l < ci.Lc) {
#pragma unroll
            for (int rq = 0; rq < 4; ++rq) { const f32x4 wv = *(const f32x4*)(nw + chb + 8 * rq);
                u32x2 o; o.x = pk_bf16(acc[lh][4 * rq] * rs * wv.x, acc[lh][4 * rq + 1] * rs * wv.y); o.y = pk_bf16(acc[lh][4 * rq + 2] * rs * wv.z, acc[lh][4 * rq + 3] * rs * wv.w);
                *(u32x2*)(Y + (size_t)(ci.base + l) * 2048 + chb + 8 * rq) = o; } } }
    __syncthreads();
}

struct AttnUnit { int qrow0, h, NT, ncache, krow0, kvalid, b, nt_base, sample; };
constexpr int AT_ST = 32768;
__device__ __forceinline__ void attn_unit(Ctx& C, int L, const AttnUnit u, const int rep) {
    const int mp = C.wid >> 2, wq = C.wid & 3, q32 = C.lane & 31, hi = C.lane >> 5;
    const bf16_t* Qb = WSP(const bf16_t, WS_Q); const bf16_t* Kb = WSP(const bf16_t, WS_K); const bf16_t* VT = WSP(const bf16_t, WS_VT);
    const bf16_t* KC = WSP(const bf16_t, WS_KC); const bf16_t* VTC = WSP(const bf16_t, WS_VTC);
    float lam; const float lam_init = (L == 0) ? 0.2f : 0.35550906f;
    { const float s1 = wave_sum(C.in[8][L * 64 + C.lane] * C.in[9][L * 64 + C.lane]), s2 = wave_sum(C.in[10][L * 64 + C.lane] * C.in[11][L * 64 + C.lane]);
      lam = expf(s1) - expf(s2) + lam_init; }
    const bool active = u.sample ? (wq == 0) : true;
    const int ntw = u.sample ? u.NT : (u.nt_base + (wq >> 1));
    bf16x8 qf[4];
    { const bf16_t* qp = Qb + (size_t)(u.qrow0 + 32 * wq + q32) * 1024 + u.h * 128 + mp * 64 + hi * 8;
#pragma unroll
      for (int ds = 0; ds < 4; ++ds) qf[ds] = *(const bf16x8*)(qp + ds * 16); }
    asm volatile("" : "+v"(qf[0]), "+v"(qf[1]), "+v"(qf[2]), "+v"(qf[3]));
    f32x16 O[4];
#pragma unroll
    for (int eb = 0; eb < 4; ++eb) O[eb] = (f32x16){};
    float m_run = 0.f, l_run = 0.f; f32x16 negm = (f32x16){};
    int koff[2], ve[2], vc[2];
#pragma unroll
    for (int i = 0; i < 2; ++i) { const int j = C.wid + 8 * i;
        const int r = 4 * j + (C.lane >> 4), c = (C.lane & 15) ^ (r & 15); koff[i] = ((r & 32) | sig5(r & 31)) * 1024 + c * 8;
        const int e = 8 * j + (C.lane >> 3), cv = (C.lane & 7) ^ ((e >> 1) & 7); ve[i] = e; vc[i] = cv * 8; }
    int kso[4], vso[4];
#pragma unroll
    for (int ds = 0; ds < 4; ++ds) { kso[ds] = ((mp * 8 + ds * 2 + hi) ^ (q32 & 15)) * 16; vso[ds] = ((ds * 2 + hi) ^ ((q32 >> 1) & 7)) * 16; }
#define AT_ISSUE(t, st) do { const int t_ = (t); \
        const bf16_t* kp_ = (t_ < u.ncache) ? KC + ((size_t)u.b * PAST + 64 * t_) * 1024 + u.h * 128 : Kb + ((size_t)u.krow0 + 64 * (t_ - u.ncache)) * 1024 + u.h * 128; \
        const bf16_t* vp_; int vs_; \
        if (t_ < u.ncache) { vp_ = VTC + ((size_t)u.b * 1024 + u.h * 128) * PAST + 64 * t_; vs_ = PAST; } else { vp_ = VT + (size_t)(u.h * 128) * MT + u.krow0 + 64 * (t_ - u.ncache); vs_ = MT; } \
        if (t_ < u.ncache) {   \
        _Pragma("unroll") for (int i_ = 0; i_ < 2; ++i_) { \
            __builtin_amdgcn_global_load_lds((const unsigned*)(kp_ + koff[i_]), (LAS unsigned*)(C.lds + (st) * AT_ST + (C.wid + 8 * i_) * 1024), 16, 0, 2); \
            __builtin_amdgcn_global_load_lds((const unsigned*)(vp_ + (size_t)ve[i_] * vs_ + vc[i_]), (LAS unsigned*)(C.lds + (st) * AT_ST + 16384 + (C.wid + 8 * i_) * 1024), 16, 0, 2); } } else { \
        _Pragma("unroll") for (int i_ = 0; i_ < 2; ++i_) { \
            __builtin_amdgcn_global_load_lds((const unsigned*)(kp_ + koff[i_]), (LAS unsigned*)(C.lds + (st) * AT_ST + (C.wid + 8 * i_) * 1024), 16, 0, 0); \
            __builtin_amdgcn_global_load_lds((const unsigned*)(vp_ + (size_t)ve[i_] * vs_ + vc[i_]), (LAS unsigned*)(C.lds + (st) * AT_ST + 16384 + (C.wid + 8 * i_) * 1024), 16, 0, 0); } } } while (0)
    AT_ISSUE(0, 0); AT_ISSUE(1, 1); if (u.NT > 2) AT_ISSUE(2, 2);
    int st_cur = 0;
#pragma unroll 1
    for (int t = 0; t < u.NT; ++t) {
        if (t + 2 < u.NT) asm volatile("s_waitcnt vmcnt(8)\n\ts_barrier" ::: "memory");
        else if (t + 1 < u.NT) asm volatile("s_waitcnt vmcnt(4)\n\ts_barrier" ::: "memory");
        else asm volatile("s_waitcnt vmcnt(0)\n\ts_barrier" ::: "memory");
        if (t + 3 < u.NT) AT_ISSUE(t + 3, (st_cur + 3) & 3);
        if (active && t < ntw) {
            const LAS unsigned char* kb = C.lds + st_cur * AT_ST + q32 * 256;
            const LAS unsigned char* vb = C.lds + st_cur * AT_ST + 16384 + q32 * 128;
            bf16x8 ka[8];
#pragma unroll
            for (int ds = 0; ds < 4; ++ds) { ka[ds] = *(const LAS bf16x8*)(kb + kso[ds]); ka[4 + ds] = *(const LAS bf16x8*)(kb + 8192 + kso[ds]); }
            f32x16 S0 = MFMA32(ka[0], qf[0], negm);
#pragma unroll
            for (int ds = 1; ds < 4; ++ds) S0 = MFMA32(ka[ds], qf[ds], S0);
            f32x16 S1 = MFMA32(ka[4], qf[0], negm);
#pragma unroll
            for (int ds = 1; ds < 4; ++ds) S1 = MFMA32(ka[4 + ds], qf[ds], S1);
            bf16x8 va[4];
#pragma unroll
            for (int eb = 0; eb < 4; ++eb) va[eb] = *(const LAS bf16x8*)(vb + eb * 4096 + vso[0]);
            float mx = max3f(S0[0], S0[1], S0[2]);
#pragma unroll
            for (int r = 3; r < 15; r += 2) mx = max3f(mx, S0[r], S0[r + 1]);
            mx = max3f(mx, S0[15], S0[15]);
#pragma unroll
            for (int r = 0; r < 16; ++r) S0[r] = fexp2(S0[r]);
            float mx1 = max3f(S1[0], S1[1], S1[2]);
#pragma unroll
            for (int r = 3; r < 15; r += 2) mx1 = max3f(mx1, S1[r], S1[r + 1]);
            mx = max3f(mx, mx1, S1[15]);
            mx = max3f(mx, __shfl_xor(mx, 32), mx);
            if (t == 0 || __any(mx > 8.0f)) {
                const float dl = (t == 0) ? mx : fmaxf(mx, 0.f);
                m_run += dl;
                const float f = fexp2(-dl); l_run *= f;
#pragma unroll
                for (int r = 0; r < 16; ++r) { S0[r] *= f; S1[r] -= dl; negm[r] = -m_run; }
#pragma unroll
                for (int eb = 0; eb < 4; ++eb)
#pragma unroll
                    for (int r = 0; r < 16; ++r) O[eb][r] *= f;
            }
            if (t == u.NT - 1 && u.kvalid < 64) {
#pragma unroll
                for (int r = 0; r < 16; ++r) { const int kv = 16 * (r >> 3) + 8 * hi + (r & 7); if (kv >= u.kvalid) S0[r] = 0.f; if (kv + 32 >= u.kvalid) S1[r] = -INFINITY; } }
            u32x4 pk[4];
#pragma unroll
            for (int sp = 0; sp < 2; ++sp)
                pk[sp] = (u32x4){pk_bf16(S0[8 * sp], S0[8 * sp + 1]), pk_bf16(S0[8 * sp + 2], S0[8 * sp + 3]), pk_bf16(S0[8 * sp + 4], S0[8 * sp + 5]), pk_bf16(S0[8 * sp + 6], S0[8 * sp + 7])};
#pragma unroll
            for (int eb = 0; eb < 4; ++eb) O[eb] = MFMA32(va[eb], __builtin_bit_cast(bf16x8, pk[0]), O[eb]);
#pragma unroll
            for (int eb = 0; eb < 4; ++eb) va[eb] = *(const LAS bf16x8*)(vb + eb * 4096 + vso[1]);
#pragma unroll
            for (int r = 0; r < 16; ++r) S1[r] = fexp2(S1[r]);
#pragma unroll
            for (int eb = 0; eb < 4; ++eb) O[eb] = MFMA32(va[eb], __builtin_bit_cast(bf16x8, pk[1]), O[eb]);
#pragma unroll
            for (int eb = 0; eb < 4; ++eb) va[eb] = *(const LAS bf16x8*)(vb + eb * 4096 + vso[2]);
#pragma unroll
            for (int sp = 0; sp < 2; ++sp)
                pk[2 + sp] = (u32x4){pk_bf16(S1[8 * sp], S1[8 * sp + 1]), pk_bf16(S1[8 * sp + 2], S1[8 * sp + 3]), pk_bf16(S1[8 * sp + 4], S1[8 * sp + 5]), pk_bf16(S1[8 * sp + 6], S1[8 * sp + 7])};
#pragma unroll
            for (int eb = 0; eb < 4; ++eb) O[eb] = MFMA32(va[eb], __builtin_bit_cast(bf16x8, pk[2]), O[eb]);
#pragma unroll
            for (int eb = 0; eb < 4; ++eb) va[eb] = *(const LAS bf16x8*)(vb + eb * 4096 + vso[3]);
            float sum = 0.f, sum2 = 0.f;
#pragma unroll
            for (int r = 0; r < 16; ++r) { sum += S0[r]; sum2 += S1[r]; }
            l_run += sum + sum2;
#pragma unroll
            for (int eb = 0; eb < 4; ++eb) O[eb] = MFMA32(va[eb], __builtin_bit_cast(bf16x8, pk[3]), O[eb]);
#if MK_SGB
#pragma unroll
            for (int i_ = 0; i_ < 16; ++i_) { __builtin_amdgcn_sched_group_barrier(0x008, 1, 0); __builtin_amdgcn_sched_group_barrier(0x100, 1, 0); __builtin_amdgcn_sched_group_barrier(0x002, 5, 0); }
#endif
        }
        st_cur = (st_cur + 1) & 3;
    }
#undef AT_ISSUE
    asm volatile("s_waitcnt lgkmcnt(0)\n\ts_barrier" ::: "memory");
    const float ltot = l_run + __shfl_xor(l_run, 32); const float inv = 1.0f / ltot;
    LAS float* EX = (LAS float*)C.lds + wq * 4096;
    if (mp == 1 && active) {
#pragma unroll
        for (int eb = 0; eb < 4; ++eb)
#pragma unroll
            for (int r = 0; r < 16; ++r) EX[(32 * eb + 8 * (r >> 2) + 4 * hi + (r & 3)) * 32 + q32] = O[eb][r] * inv;
    }
    __syncthreads();
    if (mp == 0 && active) {
        float ss = 0.f;
#pragma unroll
        for (int eb = 0; eb < 4; ++eb)
#pragma unroll
            for (int r = 0; r < 16; ++r) { const float d = O[eb][r] * inv - lam * EX[(32 * eb + 8 * (r >> 2) + 4 * hi + (r & 3)) * 32 + q32]; O[eb][r] = d; ss += d * d; }
        ss += __shfl_xor(ss, 32);
        const float rs = (1.0f / sqrtf(ss * (1.0f / 128.0f) + 1e-5f)) * (1.0f - lam_init);
        const float* sw = C.in[12] + L * 128;
        if (!u.sample || q32 < 16) {
            bf16_t* dst = WSP(bf16_t, WS_ATT) + (size_t)(u.qrow0 + 32 * wq + q32) * 1024 + u.h * 128 + 4 * hi;
#pragma unroll
            for (int eb = 0; eb < 4; ++eb)
#pragma unroll
                for (int rq = 0; rq < 4; ++rq) { const f32x4 wv = *(const f32x4*)(sw + 32 * eb + 8 * rq + 4 * hi);
                    u32x2 o; o.x = pk_bf16(O[eb][4 * rq] * rs * wv.x, O[eb][4 * rq + 1] * rs * wv.y); o.y = pk_bf16(O[eb][4 * rq + 2] * rs * wv.z, O[eb][4 * rq + 3] * rs * wv.w);
                    *(u32x2*)(dst + 32 * eb + 8 * rq) = o; }
        }
    }
    __syncthreads();
}

struct OneUnit { int pm, pn;
    __device__ __forceinline__ bool next(int i, pg8::Unit& u) const { if (i) return false; u.pm = pm; u.pn = pn; return true; }
    __device__ __forceinline__ void a_ready(const pg8::Unit&) const {}
    __device__ __forceinline__ void done(const pg8::Unit&) const {} };
__device__ __forceinline__ void flag_publish(unsigned* cnt, int tid) {
    asm volatile("s_waitcnt vmcnt(0)" ::: "memory"); __syncthreads();
    if (tid == 0) { __builtin_amdgcn_fence(__ATOMIC_RELEASE, "agent"); asm volatile("s_waitcnt vmcnt(0)" ::: "memory"); __hip_atomic_fetch_add(cnt, 1u, __ATOMIC_RELAXED, __HIP_MEMORY_SCOPE_AGENT); }
}
__device__ __forceinline__ void flag_wait(unsigned* cnt, unsigned target, int tid) {
    if (tid == 0) { unsigned sp = 0; while (__hip_atomic_load(cnt, __ATOMIC_RELAXED, __HIP_MEMORY_SCOPE_AGENT) < target) { __builtin_amdgcn_s_sleep(16); if (++sp > (1u << 24)) break; } }
    __syncthreads();
    __builtin_amdgcn_fence(__ATOMIC_ACQUIRE, "agent"); asm volatile("s_waitcnt vmcnt(0)" ::: "memory");
    __syncthreads();
}
__device__ __forceinline__ void chain_item(Ctx& C, int L, int kind, int idx) {
    unsigned* cnt = WSP(unsigned, WS_CTL) + 64 * (20 + 4 * L);
    if (kind == 0) {
        flag_wait(cnt, 128u, C.tid);
        OneUnit S{0, idx};
        { pg8::Gemm g{WSP(const bf16_t, WS_ATT) + (size_t)SEQ * 1024, WSP(const bf16_t, WS_WBA + L * SZ_WBA), 256, 1024, 1024}; EpiBrA E{WSP(const bf16_t, WS_G), WSP(float, WS_Z), SEQ};
          pg8::gemm_phase<EpiBrA, OneUnit, true, true>(C.lds, g, S, E); }
        { pg8::Gemm g{WSP(const bf16_t, WS_YSSD) + (size_t)SEQ * 2048, WSP(const bf16_t, WS_WBS + L * SZ_WBS), 256, 1024, 2048}; EpiBrB E{WSP(const bf16_t, WS_G), WSP(const float, WS_Z), WSP(bf16_t, WS_Q), SEQ};
          pg8::gemm_phase<EpiBrB, OneUnit, true, true>(C.lds, g, S, E); }
        flag_publish(cnt + 64, C.tid);
    } else if (kind == 1) {
        flag_wait(cnt + 64, 4u, C.tid);
        OneUnit S{0, idx};
        pg8::Gemm g{WSP(const bf16_t, WS_Q) + (size_t)SEQ * 1024, WSP(const bf16_t, WS_WOUT + L * SZ_WOUT), 256, 1024, 1024};
        EpiRes E{WSP(float, WS_X), WSP(bf16_t, WS_XB), WSP(float, WS_PART) + (size_t)(2 * L + 1) * MT, SEQ};
        pg8::gemm_phase<EpiRes, OneUnit, true, true>(C.lds, g, S, E);
        flag_publish(cnt + 128, C.tid);
    } else if (kind == 2) {
        flag_wait(cnt + 128, 4u, C.tid);
        OneUnit S{0, idx};
        pg8::Gemm g{WSP(const bf16_t, WS_XB) + (size_t)SEQ * 1024, WSP(const bf16_t, WS_WGU + L * SZ_WGU), 256, 5632, 1024};
        EpiGU E{WSP(const float, WS_PART) + (size_t)(2 * L + 1) * MT, WSP(bf16_t, WS_ACTS), SEQ, SEQ};
        pg8::gemm_phase<EpiGU, OneUnit, true, true>(C.lds, g, S, E);
        flag_publish(cnt + 192, C.tid);
    } else {
        flag_wait(cnt + 192, 22u, C.tid);
        OneUnit S{0, idx};
        pg8::Gemm g{WSP(const bf16_t, WS_ACTS), WSP(const bf16_t, WS_WD + L * SZ_WD), 256, 1024, DFF};
        EpiRes E{WSP(float, WS_X), WSP(bf16_t, WS_XB), WSP(float, WS_PART) + (size_t)(2 * L + 2) * MT, SEQ};
        pg8::gemm_phase<EpiRes, OneUnit, true, true>(C.lds, g, S, E);
    }
    __syncthreads();
}

__device__ __forceinline__ void phase_mix(Ctx& C, int L, int rep) {
    unsigned* counter = WSP(unsigned, WS_CTL) + 64 * (1 + L + 4 * rep);
    unsigned* cntA = WSP(unsigned, WS_CTL) + 64 * (20 + 4 * L);
    volatile LAS int* slot = (volatile LAS int*)(C.lds + LDS_CTL);
    constexpr int N_SMP = 64, N_S3S = 64, N_MID = 1024 + 34, N_S3 = 2048, N_ALL = N_SMP + N_S3S + N_MID + N_S3;
    for (;;) {
        __syncthreads();
        if (C.tid == 0) slot[0] = (int)atomicAdd(counter, 1u);
        __syncthreads();
        const int item = slot[0];
        if (item >= N_ALL) break;
        { int t_ = threadIdx.x; asm volatile("" : "+v"(t_)); C.tid = t_; C.lane = t_ & 63; C.wid = __builtin_amdgcn_readfirstlane(t_ >> 6); }
        if (item < N_SMP) { AttnUnit u; u.sample = 1; u.b = item >> 3; u.h = item & 7; u.qrow0 = SEQ + 16 * u.b; u.NT = 65; u.ncache = 64; u.krow0 = SEQ + 16 * u.b; u.kvalid = 16; u.nt_base = 65;
            attn_unit(C, L, u, rep); flag_publish(cntA, C.tid); }
        else if (item < N_SMP + N_S3S) { const int j = 2048 + (item - N_SMP); ssd_s3_unit(C, L, j >> 3, j & 7); flag_publish(cntA, C.tid); }
        else if (item < N_SMP + N_S3S + N_MID) { const int mi = item - N_SMP - N_S3S; int j = -1, kind = -1, idx = 0;
            if (mi < 400) j = mi; else if (mi < 404) { kind = 0; idx = mi - 400; } else if (mi < 560) j = mi - 4; else if (mi < 564) { kind = 1; idx = mi - 560; }
            else if (mi < 720) j = mi - 8; else if (mi < 742) { kind = 2; idx = mi - 720; } else if (mi < 880) j = mi - 30; else if (mi < 884) { kind = 3; idx = mi - 880; } else j = mi - 34;
            if (kind >= 0) chain_item(C, L, kind, idx);
            else {
                __syncthreads();
                if (C.tid == 0) { unsigned* hc = WSP(unsigned, WS_CTL) + 64 * (40 + 8 * L); int hsel = (int)(my_xcc_id() & 7u), rsel = -1;
                    for (int k = 0; k < 8; ++k) { const int hh_ = (hsel + k) & 7; if (__hip_atomic_load(hc + 64 * hh_, __ATOMIC_RELAXED, __HIP_MEMORY_SCOPE_AGENT) < 128u) { const unsigned r_ = atomicAdd(hc + 64 * hh_, 1u); if (r_ < 128u) { hsel = hh_; rsel = (int)r_; break; } } }
                    slot[1] = hsel; slot[2] = rsel; }
                __syncthreads();
                const int hsel = slot[1], rsel = slot[2];
                if (rsel >= 0) { const int qb = 127 - rsel; j = hsel; AttnUnit u; u.sample = 0; u.b = 0; u.h = j & 7; u.qrow0 = 128 * qb; u.NT = 2 * qb + 2; u.ncache = 0; u.krow0 = 0; u.kvalid = 64; u.nt_base = 2 * qb + 1; attn_unit(C, L, u, rep); } } }
        else { const int j = item - N_SMP - N_S3S - N_MID; ssd_s3_unit(C, L, j >> 3, j & 7); }
    }
}

__device__ __forceinline__ void phase_final(Ctx& C) {
    const float* X = WSP(const float, WS_X); const float* PART = WSP(const float, WS_PART); const float* nw = C.in[25];
    const int gw = C.bid * 8 + C.wid, NGW = C.G * 8;
    for (int row = gw; row < MV; row += NGW) { const float rs = rstd1(PART + 4 * MT, row, 1e-6f);
#pragma unroll
        for (int j = 0; j < 4; ++j) { const int col = 4 * C.lane + 256 * j; const f32x4 x = *(const f32x4*)(X + (size_t)row * 1024 + col); const f32x4 w = *(const f32x4*)(nw + col);
            *(f32x4*)(C.out + O_YP + (size_t)row * 1024 + col) = (x * rs) * w; } }
}

#define XB_TMO      128
#define XB_XCNT(j)  (256  + 64 * (j))
#define XB_XSUB(j)  (1280 + 64 * (j))
#define XB_XGEN(j)  (2304 + 64 * (j))
#define XB_TOP      3328
#define XB_TOPGEN   3392
#define XCD_BAR_WORDS 3456
#define XB_SPIN_CAP (1u << 23)

__device__ __forceinline__ unsigned xb_ld(unsigned* p)              { return __hip_atomic_load(p, __ATOMIC_RELAXED, __HIP_MEMORY_SCOPE_AGENT); }
__device__ __forceinline__ unsigned xb_add(unsigned* p, unsigned v) { return __hip_atomic_fetch_add(p, v, __ATOMIC_RELAXED, __HIP_MEMORY_SCOPE_AGENT); }
__device__ __forceinline__ unsigned xb_xcc_id() { return (unsigned)__builtin_amdgcn_s_getreg((3 << 11) | 20) & 0xFu; }
#define XB_SPIN(cond, bar) do { unsigned _sp = 0; while (cond) { __builtin_amdgcn_s_sleep(1); \
    if ((++_sp & 255u) == 0u) { if (xb_ld(&(bar)[XB_TMO])) break; if (_sp > XB_SPIN_CAP) { atomicAdd(&(bar)[XB_TMO], 1u); break; } } } } while (0)

struct XcdBarrier {
    unsigned* bar; unsigned x;
    volatile LAS unsigned* st;
};

__device__ __forceinline__ XcdBarrier xcd_barrier_post(unsigned* bar, volatile LAS unsigned* st) {
    XcdBarrier b; b.bar = bar; b.x = xb_xcc_id(); b.st = st;
    if (threadIdx.x == 0) (void)xb_add(&bar[XB_XCNT(b.x)], 1u);
    return b;
}
__device__ __forceinline__ void xcd_barrier_complete(unsigned* bar, unsigned x, unsigned& nloc, unsigned& nx) {
    const unsigned G = gridDim.x * gridDim.y * gridDim.z;
    unsigned sum, cnt, mine, sp = 0u;
    for (;;) {
        sum = 0u; cnt = 0u; mine = 0u;
#pragma unroll
        for (unsigned j = 0; j < 16; ++j) { const unsigned c = xb_ld(&bar[XB_XCNT(j)]); sum += c; cnt += (c > 0u) ? 1u : 0u; mine = (j == x) ? c : mine; }
        if (sum == G) break;
        __builtin_amdgcn_s_sleep(1);
        if ((++sp & 255u) == 0u) { if (xb_ld(&bar[XB_TMO])) break; if (sp > XB_SPIN_CAP) { atomicAdd(&bar[XB_TMO], 1u); break; } }
    }
    nloc = mine > 0u ? mine : 1u; nx = cnt > 0u ? cnt : 1u;
}

__device__ __forceinline__ void xcd_barrier(const XcdBarrier& b) {
    asm volatile("s_waitcnt vmcnt(0)" ::: "memory");
    __syncthreads();
    if (threadIdx.x == 0) {
        unsigned* bar = b.bar;
        __builtin_amdgcn_s_waitcnt(0);
        unsigned nloc = b.st[0], nx = b.st[1];
        if (nloc == 0u) { xcd_barrier_complete(bar, b.x, nloc, nx); b.st[0] = nloc; b.st[1] = nx; }
        const unsigned old = xb_add(&bar[XB_XSUB(b.x)], 1u);
        const unsigned gen = old / nloc;
        if (old + 1u == (gen + 1u) * nloc) {
            __builtin_amdgcn_fence(__ATOMIC_RELEASE, "agent");
            asm volatile("s_waitcnt vmcnt(0)" ::: "memory");
            const unsigned og = xb_add(&bar[XB_TOP], 1u);
            const unsigned tg = og / nx;
            if (og + 1u == (tg + 1u) * nx) xb_add(&bar[XB_TOPGEN], 1u);
            else XB_SPIN(xb_ld(&bar[XB_TOPGEN]) == tg, bar);
            __builtin_amdgcn_fence(__ATOMIC_ACQUIRE, "agent");
            xb_add(&bar[XB_XGEN(b.x)], 1u);
            asm volatile("s_waitcnt vmcnt(0)" ::: "memory");
        } else {
            XB_SPIN(xb_ld(&bar[XB_XGEN(b.x)]) == gen, bar);
            __builtin_amdgcn_fence(__ATOMIC_ACQUIRE, "agent");
            asm volatile("s_waitcnt vmcnt(0)" ::: "memory");
        }
    }
    __syncthreads();
}

constexpr int N_PHASES = 18;
__global__ void __launch_bounds__(512, 2) mk_fwd(Args a) {
    extern __shared__ __attribute__((aligned(16))) unsigned char lds_raw[];
    Ctx C;
    C.lds = (LAS unsigned char*)lds_raw; C.G = gridDim.x; C.bid = blockIdx.x;
#pragma unroll
    for (int i = 0; i < 26; ++i) C.in[i] = a.in[i];
    C.out = a.out; C.ws = a.ws;
    cg::grid_group grid = cg::this_grid();
    if (threadIdx.x < 64) ((LAS unsigned*)(C.lds + LDS_CTL))[threadIdx.x] = 0u;
    __syncthreads();
    XcdBarrier xbar = xcd_barrier_post(WSP(unsigned, WS_CTL) + 4096, (volatile LAS unsigned*)(C.lds + LDS_CTL + 32));
#pragma unroll 1
    for (int ph = a.ph_lo; ph < a.ph_hi; ++ph) {
        if (ph == a.ph_lo + 1) { grid.sync(); } else if (ph > a.ph_lo) { xcd_barrier(xbar); }
        { int t_ = threadIdx.x; asm volatile("" : "+v"(t_)); C.tid = t_; C.lane = t_ & 63; C.wid = __builtin_amdgcn_readfirstlane(t_ >> 6); }
        if (ph == 0) { if (!(MK_SKIP & 1024)) phase_p0(C); continue; }
        if (ph == N_PHASES - 1) { phase_final(C); continue; }
        const int L = (ph - 1) >> 3, sub = (ph - 1) & 7;
        if (sub == 0) {
            pg8::Gemm g{WSP(const bf16_t, WS_XB), WSP(const bf16_t, WS_WIN + L * SZ_WIN), MT, NINP, 1024}; pg8::StaticOrder S; S.init(MT, NINP, C.G, C.bid);
            EpiIn E{WSP(const float, WS_PART) + (size_t)(2 * L) * MT, WSP(bf16_t, WS_Q), WSP(bf16_t, WS_K), WSP(bf16_t, WS_VT), WSP(bf16_t, WS_Z), WSP(bf16_t, WS_XBC), WSP(bf16_t, WS_G), WSP(float, WS_DT), C.out, L, WSP(bf16_t, WS_HIST)};
            if (!(MK_SKIP & 1)) pg8::gemm_phase<EpiIn, pg8::StaticOrder, true, true>(C.lds, g, S, E);
            if (MK_PROBE & 2) { grid.sync(); pg8::gemm_phase<EpiIn, pg8::StaticOrder, true, true>(C.lds, g, S, E); }
            if (MK_PROBE & 1024) { grid.sync(); EpiNull EN{WSP(float, WS_END - 64)}; pg8::gemm_phase<EpiNull, pg8::StaticOrder, true, true>(C.lds, g, S, EN); }
        } else if (sub == 1) {
            for (int uidx = C.bid; uidx < NCHUNK * 8; uidx += C.G) { { int t_ = threadIdx.x; asm volatile("" : "+v"(t_)); C.tid = t_; C.lane = t_ & 63; C.wid = __builtin_amdgcn_readfirstlane(t_ >> 6); } conv_unit(C, L, uidx >> 3, uidx & 7); }
            if (!(MK_SKIP & 4)) cache_convert(C, L);
            xcd_barrier(xbar);
            for (int uidx = C.bid * 8 + C.wid; uidx < NCHUNK * 32; uidx += C.G * 8) { { int t_ = threadIdx.x; asm volatile("" : "+v"(t_)); C.tid = t_; C.lane = t_ & 63; C.wid = __builtin_amdgcn_readfirstlane(t_ >> 6); } ssd_s1_wave(C, L, uidx >> 5, uidx & 31); }
            if (MK_PROBE & 512) { grid.sync(); for (int uidx = C.bid * 8 + C.wid; uidx < NCHUNK * 32; uidx += C.G * 8) { { int t_ = threadIdx.x; asm volatile("" : "+v"(t_)); C.tid = t_; C.lane = t_ & 63; C.wid = __builtin_amdgcn_readfirstlane(t_ >> 6); } ssd_s1_wave(C, L, uidx >> 5, uidx & 31); } }
        } else if (sub == 2) {
            if (!(MK_SKIP & 8)) ssd_scan(C, L);
        } else if (sub == 3) {
            phase_mix(C, L, 0);
            if (MK_PROBE & 1) { grid.sync(); phase_mix(C, L, 1); }
        } else if (sub == 4) {
            pg8::StaticOrder S; S.init(SEQ, 1024, C.G, C.bid);
            { pg8::Gemm g{WSP(const bf16_t, WS_ATT), WSP(const bf16_t, WS_WBA + L * SZ_WBA), SEQ, 1024, 1024}; EpiBrA E{WSP(const bf16_t, WS_G), WSP(float, WS_Z), 0};
              if (!(MK_SKIP & 64)) pg8::gemm_phase<EpiBrA, pg8::StaticOrder, true, true>(C.lds, g, S, E); }
            { pg8::Gemm g{WSP(const bf16_t, WS_YSSD), WSP(const bf16_t, WS_WBS + L * SZ_WBS), SEQ, 1024, 2048}; EpiBrB E{WSP(const bf16_t, WS_G), WSP(const float, WS_Z), WSP(bf16_t, WS_Q), 0};
              if (!(MK_SKIP & 128)) pg8::gemm_phase<EpiBrB, pg8::StaticOrder, true, true>(C.lds, g, S, E); }
        } else if (sub == 5) {
            pg8::Gemm g{WSP(const bf16_t, WS_Q), WSP(const bf16_t, WS_WOUT + L * SZ_WOUT), SEQ, 1024, 1024}; pg8::StaticOrder S; S.init(SEQ, 1024, C.G, C.bid);
            EpiRes E{WSP(float, WS_X), WSP(bf16_t, WS_XB), WSP(float, WS_PART) + (size_t)(2 * L + 1) * MT, 0};
            if (!(MK_SKIP & 256)) pg8::gemm_phase<EpiRes, pg8::StaticOrder, true, true>(C.lds, g, S, E);
        } else if (sub == 6) {
            pg8::Gemm g{WSP(const bf16_t, WS_XB), WSP(const bf16_t, WS_WGU + L * SZ_WGU), SEQ, 5632, 1024}; pg8::StaticOrder S; S.init(SEQ, 5632, C.G, C.bid);
            EpiGU E{WSP(const float, WS_PART) + (size_t)(2 * L + 1) * MT, WSP(bf16_t, WS_XBC), 0, 0};
            if (!(MK_SKIP & 512)) pg8::gemm_phase<EpiGU, pg8::StaticOrder, true, true>(C.lds, g, S, E);
            if (MK_PROBE & 4) { grid.sync(); pg8::gemm_phase<EpiGU, pg8::StaticOrder, true, true>(C.lds, g, S, E); }
        } else {
            pg8::Gemm g{WSP(const bf16_t, WS_XBC), WSP(const bf16_t, WS_WD + L * SZ_WD), SEQ, 1024, DFF}; pg8::StaticOrder S; S.init(SEQ, 1024, C.G, C.bid);
            EpiRes E{WSP(float, WS_X), WSP(bf16_t, WS_XB), WSP(float, WS_PART) + (size_t)(2 * L + 2) * MT, 0};
            if (!(MK_SKIP & 256)) pg8::gemm_phase<EpiRes, pg8::StaticOrder, true, true>(C.lds, g, S, E);
        }
    }
}

extern "C" void kernel_launch(void* const* d_in, const int* in_sizes, int n_in, void* d_out, int out_size, void* d_ws, size_t ws_size, hipStream_t stream) {
    static int grid = 0;
    if (grid == 0) {
        if (n_in != 26 || (size_t)out_size != O_END || ws_size < WS_END) { fprintf(stderr, "kernel_launch: unexpected shapes (n_in %d, out %d, ws %zu)\n", n_in, out_size, ws_size); grid = -1; return; }
        int dev = 0, cus = 0, per_cu = 0;
        hipGetDevice(&dev); hipDeviceGetAttribute(&cus, hipDeviceAttributeMultiprocessorCount, dev);
        if (hipFuncSetAttribute((const void*)mk_fwd, hipFuncAttributeMaxDynamicSharedMemorySize, LDS_BYTES) != hipSuccess) { fprintf(stderr, "kernel_launch: hipFuncSetAttribute failed\n"); grid = -1; return; }
        if (hipOccupancyMaxActiveBlocksPerMultiprocessor(&per_cu, (const void*)mk_fwd, 512, LDS_BYTES) != hipSuccess || per_cu < 1) per_cu = 1;
        (void)hipGetLastError();
        grid = cus * per_cu;
    }
    if (grid < 0) return;
    hipMemsetAsync((char*)d_ws + WS_CTL, 0, CTL_BYTES, stream);
    Args a{};
    for (int i = 0; i < 26; ++i) a.in[i] = (const float*)d_in[i];
    a.out = (float*)d_out; a.ws = (unsigned char*)d_ws;
#if MK_MULTI
    for (int ph = 0; ph < N_PHASES; ++ph) { a.ph_lo = ph; a.ph_hi = ph + 1; hipLaunchKernelGGL(mk_fwd, dim3(grid), dim3(512), LDS_BYTES, stream, a); }
#else
    a.ph_lo = 0; a.ph_hi = N_PHASES;
    void* args[] = {&a};
    hipError_t e = hipLaunchCooperativeKernel((const void*)mk_fwd, dim3(grid), dim3(512), args, LDS_BYTES, stream);
    if (e != hipSuccess) fprintf(stderr, "cooperative launch failed: %s (grid %d)\n", hipGetErrorString(e), grid);
#endif
}
```
